# Optimizing an MI355X kernel written in HIP

```python
import math
import jax, jax.numpy as jnp
from jax import lax
import numpy as np

D_MODEL = 1024
BATCH = 8
SEQ = 4096
DEPTH = 4

CHUNK = 64
N_MIXERS = 2
N_GDN_LAYERS = (DEPTH + N_MIXERS - 1) // N_MIXERS
N_SB_LAYERS = DEPTH // N_MIXERS

GDN_HEAD_DIM = 128
GDN_QK_HEADS = D_MODEL // GDN_HEAD_DIM
GDN_V_HEADS = 2 * GDN_QK_HEADS
GDN_KEY_DIM = GDN_QK_HEADS * GDN_HEAD_DIM
GDN_VAL_DIM = GDN_V_HEADS * GDN_HEAD_DIM
GDN_CONV_DIM = 2 * GDN_KEY_DIM + GDN_VAL_DIM
GDN_IN_DIM = GDN_CONV_DIM + GDN_VAL_DIM + 2 * GDN_V_HEADS
CONV_WIDTH = 4

SB_HEAD_DIM = 64
SB_HEADS = D_MODEL // SB_HEAD_DIM
Q_BLOCK = 128

FFN_HIDDEN = -(-(8 * D_MODEL) // (3 * 256)) * 256
EPS = 1e-6

kernel_name = "hybrid_gdn_stickbreaking_trunk"


def rmsnorm(x, w):
    xf = x.astype(jnp.float32)
    y = xf * lax.rsqrt(jnp.mean(xf * xf, axis=-1, keepdims=True) + EPS)
    return (y * w.astype(jnp.float32)).astype(x.dtype)


def l2norm(x):
    xf = x.astype(jnp.float32)
    return xf * lax.rsqrt(jnp.sum(xf * xf, axis=-1, keepdims=True) + EPS)


def causal_depthwise_conv(x, w):
    T = x.shape[1]
    xp = jnp.pad(x, ((0, 0), (CONV_WIDTH - 1, 0), (0, 0)))
    out = xp[:, 0:T, :] * w[:, 0]
    for j in range(1, CONV_WIDTH):
        out = out + xp[:, j:j + T, :] * w[:, j]
    return out


def _to_chunks(x, n_chunks):
    B, T, H = x.shape[:3]
    y = x.reshape((B, n_chunks, CHUNK, H) + x.shape[3:])
    return jnp.moveaxis(y, 3, 2)


def gated_delta_rule_chunked(q, k, v, g, beta):
    B, T, H, dk = q.shape
    dv = v.shape[-1]
    n = T // CHUNK
    q = q * (dk ** -0.5)
    qc, kc, vc = _to_chunks(q, n), _to_chunks(k, n), _to_chunks(v, n)
    gc = jnp.cumsum(_to_chunks(g, n), axis=-1)
    bc = _to_chunks(beta, n)
    k_beta = kc * bc[..., None]
    v_beta = vc * bc[..., None]

    incl = jnp.tril(jnp.ones((CHUNK, CHUNK), dtype=bool))
    strict = jnp.tril(jnp.ones((CHUNK, CHUNK), dtype=bool), -1)
    decay = jnp.exp(jnp.where(incl, gc[..., :, None] - gc[..., None, :], -jnp.inf))

    L = jnp.where(strict, jnp.einsum('bnhid,bnhjd->bnhij', k_beta, kc) * decay, 0.0)
    eye = jnp.eye(CHUNK, dtype=jnp.float32)
    rhs = jnp.concatenate([v_beta, k_beta * jnp.exp(gc)[..., None]], axis=-1)
    sol = lax.linalg.triangular_solve(L + eye, rhs, left_side=True, lower=True,
                                      unit_diagonal=True)
    u = sol[..., :dv]
    w = sol[..., dv:]
    attn_intra = jnp.einsum('bnhid,bnhjd->bnhij', qc, kc) * decay

    def step(S, xs):
        q_i, k_i, u_i, w_i, g_i, a_i = xs
        v_new = u_i - jnp.einsum('bhcd,bhde->bhce', w_i, S)
        o = (jnp.einsum('bhcd,bhde->bhce', q_i * jnp.exp(g_i)[..., None], S)
             + jnp.einsum('bhij,bhje->bhie', a_i, v_new))
        g_last = g_i[..., -1]
        k_dec = k_i * jnp.exp(g_last[..., None] - g_i)[..., None]
        S = S * jnp.exp(g_last)[..., None, None] + jnp.einsum('bhcd,bhce->bhde', k_dec, v_new)
        return S, o

    xs = tuple(jnp.moveaxis(t, 1, 0) for t in (qc, kc, u, w, gc, attn_intra))
    S0 = jnp.zeros((B, H, dk, dv), jnp.float32)
    _, o = lax.scan(step, S0, xs)
    return o.transpose(1, 0, 3, 2, 4).reshape(B, T, H, dv)


def gdn_mixer(h, w_in, conv_w, a_log, dt_bias, norm_w, w_out):
    B, T, _ = h.shape
    proj = h @ w_in
    qkv = proj[..., :GDN_CONV_DIM]
    z = proj[..., GDN_CONV_DIM:GDN_CONV_DIM + GDN_VAL_DIM]
    b = proj[..., GDN_CONV_DIM + GDN_VAL_DIM:GDN_CONV_DIM + GDN_VAL_DIM + GDN_V_HEADS]
    a = proj[..., GDN_CONV_DIM + GDN_VAL_DIM + GDN_V_HEADS:]
    qkv = jax.nn.silu(causal_depthwise_conv(qkv, conv_w))
    q = qkv[..., :GDN_KEY_DIM].reshape(B, T, GDN_QK_HEADS, GDN_HEAD_DIM)
    k = qkv[..., GDN_KEY_DIM:2 * GDN_KEY_DIM].reshape(B, T, GDN_QK_HEADS, GDN_HEAD_DIM)
    v = qkv[..., 2 * GDN_KEY_DIM:].reshape(B, T, GDN_V_HEADS, GDN_HEAD_DIM).astype(jnp.float32)
    rep = GDN_V_HEADS // GDN_QK_HEADS
    q = jnp.repeat(l2norm(q), rep, axis=2)
    k = jnp.repeat(l2norm(k), rep, axis=2)
    beta = jax.nn.sigmoid(b.astype(jnp.float32))
    g = -jnp.exp(a_log.astype(jnp.float32)) * jax.nn.softplus(
        a.astype(jnp.float32) + dt_bias.astype(jnp.float32))
    o = gated_delta_rule_chunked(q, k, v, g, beta)
    o = o * lax.rsqrt(jnp.mean(o * o, axis=-1, keepdims=True) + EPS) * norm_w.astype(jnp.float32)
    o = o * jax.nn.silu(z.reshape(B, T, GDN_V_HEADS, GDN_HEAD_DIM).astype(jnp.float32))
    return o.reshape(B, T, GDN_VAL_DIM).astype(h.dtype) @ w_out


def stick_breaking_mixer(h, w_qkv, w_o):
    B, T, _ = h.shape
    qkv = (h @ w_qkv).reshape(B, T, 3, SB_HEADS, SB_HEAD_DIM)
    q, k, v = qkv[:, :, 0], qkv[:, :, 1], qkv[:, :, 2]
    scale = SB_HEAD_DIM ** -0.5
    outs = []
    for blk in range(T // Q_BLOCK):
        t0 = blk * Q_BLOCK
        t1 = t0 + Q_BLOCK
        qb, kb, vb = q[:, t0:t1], k[:, :t1], v[:, :t1]
        z = jnp.einsum('bthd,bshd->bhts', qb, kb).astype(jnp.float32) * scale
        t_idx = t0 + jnp.arange(Q_BLOCK)[:, None]
        s_idx = jnp.arange(t1)[None, :]
        causal = s_idx < t_idx
        log_keep = jnp.where(causal, jax.nn.log_sigmoid(-z), 0.0)
        log_rest = lax.cumsum(log_keep, axis=3, reverse=True) - log_keep
        att = jnp.where(causal, jnp.exp(jax.nn.log_sigmoid(z) + log_rest), 0.0)
        outs.append(jnp.einsum('bhts,bshd->bthd', att.astype(v.dtype), vb))
    o = jnp.concatenate(outs, axis=1).reshape(B, T, SB_HEADS * SB_HEAD_DIM)
    return o @ w_o


def swiglu(h, w_gate, w_up, w_down):
    return (jax.nn.silu(h @ w_gate) * (h @ w_up)) @ w_down


def setup_inputs(seed: int = 0) -> dict:
    key = jax.random.key(seed)
    ks = jax.random.split(key, 20)
    nrm = jax.random.normal
    f32 = jnp.float32
    x = nrm(ks[0], (BATCH, SEQ, D_MODEL), f32)
    gdn_w_in = nrm(ks[1], (N_GDN_LAYERS, D_MODEL, GDN_IN_DIM), f32) * D_MODEL ** -0.5
    gdn_conv_w = nrm(ks[2], (N_GDN_LAYERS, GDN_CONV_DIM, CONV_WIDTH), f32) * CONV_WIDTH ** -0.5
    gdn_a_log = jnp.log(jax.random.uniform(ks[3], (N_GDN_LAYERS, GDN_V_HEADS), f32, 1.0, 16.0))
    dt = jnp.exp(jax.random.uniform(ks[4], (N_GDN_LAYERS, GDN_V_HEADS), f32,
                                    math.log(1e-3), math.log(1e-1)))
    gdn_dt_bias = dt + jnp.log(-jnp.expm1(-dt))
    gdn_norm_w = 1.0 + 0.02 * nrm(ks[5], (N_GDN_LAYERS, GDN_HEAD_DIM), f32)
    gdn_w_out = nrm(ks[6], (N_GDN_LAYERS, GDN_VAL_DIM, D_MODEL), f32) * GDN_VAL_DIM ** -0.5
    sb_w_qkv = nrm(ks[7], (N_SB_LAYERS, D_MODEL, 3 * D_MODEL), f32) * D_MODEL ** -0.5
    sb_w_o = nrm(ks[8], (N_SB_LAYERS, D_MODEL, D_MODEL), f32) * D_MODEL ** -0.5
    mix_norm_w = 1.0 + 0.02 * nrm(ks[9], (DEPTH, D_MODEL), f32)
    ffn_norm_w = 1.0 + 0.02 * nrm(ks[10], (DEPTH, D_MODEL), f32)
    ffn_w_gate = nrm(ks[11], (DEPTH, D_MODEL, FFN_HIDDEN), f32) * D_MODEL ** -0.5
    ffn_w_up = nrm(ks[12], (DEPTH, D_MODEL, FFN_HIDDEN), f32) * D_MODEL ** -0.5
    ffn_w_down = nrm(ks[13], (DEPTH, FFN_HIDDEN, D_MODEL), f32) * FFN_HIDDEN ** -0.5
    final_norm_w = 1.0 + 0.02 * nrm(ks[14], (D_MODEL,), f32)
    return {"x": x, "gdn_w_in": gdn_w_in, "gdn_conv_w": gdn_conv_w, "gdn_a_log": gdn_a_log,
            "gdn_dt_bias": gdn_dt_bias, "gdn_norm_w": gdn_norm_w, "gdn_w_out": gdn_w_out,
            "sb_w_qkv": sb_w_qkv, "sb_w_o": sb_w_o, "mix_norm_w": mix_norm_w,
            "ffn_norm_w": ffn_norm_w, "ffn_w_gate": ffn_w_gate, "ffn_w_up": ffn_w_up,
            "ffn_w_down": ffn_w_down, "final_norm_w": final_norm_w}


def reference(x, gdn_w_in, gdn_conv_w, gdn_a_log, gdn_dt_bias, gdn_norm_w, gdn_w_out,
              sb_w_qkv, sb_w_o, mix_norm_w, ffn_norm_w, ffn_w_gate, ffn_w_up, ffn_w_down,
              final_norm_w):
    for i in range(DEPTH):
        j = i // N_MIXERS
        h = rmsnorm(x, mix_norm_w[i])
        if i % N_MIXERS == 0:
            x = x + gdn_mixer(h, gdn_w_in[j], gdn_conv_w[j], gdn_a_log[j], gdn_dt_bias[j],
                              gdn_norm_w[j], gdn_w_out[j])
        else:
            x = x + stick_breaking_mixer(h, sb_w_qkv[j], sb_w_o[j])
        h = rmsnorm(x, ffn_norm_w[i])
        x = x + swiglu(h, ffn_w_gate[i], ffn_w_up[i], ffn_w_down[i])
    return rmsnorm(x, final_norm_w)
```

```cpp
#include <hip/hip_runtime.h>
#include <hip/hip_cooperative_groups.h>
#include <cstdio>
#include <cstdint>
namespace cg = cooperative_groups;
namespace pg8 {
#define PG8_LAS __attribute__((address_space(3)))
typedef unsigned short bf16_t;
typedef short bf16x8 __attribute__((ext_vector_type(8)));
typedef float f32x4 __attribute__((ext_vector_type(4)));
typedef unsigned u32x4 __attribute__((ext_vector_type(4)));
constexpr int BM = 256, BK = 64, HALF = 128, HTB = HALF * BK * 2  , STAGE_BYTES = 8 * HTB, NXCD = 8, WGM = 8;

__host__ __device__ __forceinline__ int lds_byte(int r, int c) { const int st = (r >> 4) * 2 + (c >> 5), rr = r & 15, cc = c & 31, ob = rr * 64 + cc * 2; return st * 1024 + (ob ^ (((ob >> 9) & 1) << 5)); }
__host__ __device__ __forceinline__ void stage_rc(int b, int& R, int& C) { const int st = b / 1024, sb = b % 1024, swz = sb ^ (((sb >> 9) & 1) << 5); R = (st >> 1) * 16 + swz / 64; C = (st & 1) * 32 + (swz % 64) / 2; }
__host__ __device__ __forceinline__ int perm32(int rho) { const int n = rho >> 4, i = rho & 15; return 8 * (i >> 2) + 4 * n + (i & 3); }

struct Unit { int pm, pn; };
struct Gemm { const bf16_t* A; const bf16_t* Bt; int M, N, K, lda; };

struct StaticOrder {
    int nM, nN, nwg, G, c;
    __host__ __device__ void init(int M, int N, int G_, int c_) { nM = M / BM; nN = N / BM; nwg = nM * nN; G = G_; c = c_; }
    __host__ __device__ bool next(int i, Unit& u) const {
        const long L = (long)i * G + c; if (L >= nwg) return false;
        int wgid = (int)L; { const int q = nwg / NXCD, r = nwg % NXCD, xcd = wgid % NXCD, off = wgid / NXCD; wgid = (xcd < r ? xcd * (q + 1) : r * (q + 1) + (xcd - r) * q) + off; }
        const int nig = WGM * nN, gid = wgid / nig, fm = gid * WGM, gsz = (nM - fm) < WGM ? (nM - fm) : WGM;
        u.pm = fm + ((wgid % nig) % gsz); u.pn = (wgid % nig) / gsz; return true;
    }
    __device__ __forceinline__ void a_ready(const Unit&) const {}
    __device__ __forceinline__ void done(const Unit&) const {}
};

__device__ __forceinline__ unsigned cvt_pk_bf16(float lo, float hi) { unsigned r; asm volatile("v_cvt_pk_bf16_f32 %0, %1, %2" : "=v"(r) : "v"(lo), "v"(hi)); return r; }
typedef float f32x2 __attribute__((ext_vector_type(2)));
template <class Epi, class Sched, bool ALIGN_EPI = false, bool SP2 = false>
__device__ __forceinline__ void gemm_phase(PG8_LAS unsigned char* lds, const Gemm g, const Sched& S, const Epi& E) {
    int tid_l = threadIdx.x; asm volatile("" : "+v"(tid_l));
    const int tid = tid_l, wid = __builtin_amdgcn_readfirstlane(tid >> 6), lane = tid & 63, wr = wid >> 2, wc = wid & 3, fr = lane & 15, fq = lane >> 4;
    const int K = g.K, nt = K / BK;
    unsigned voffA[2], voffB[2];
#pragma unroll
    for (int i = 0; i < 2; ++i) { int R, C; stage_rc(tid * 16 + i * 8192, R, C); const int Rb = Epi::PERM ? ((R & ~31) + perm32(R & 31)) : R;
        voffA[i] = (unsigned)(R * g.lda + C) * 2u; voffB[i] = (unsigned)(Rb * K + C) * 2u; }
    const size_t kstep = (size_t)(BK * 2);
    const size_t hstepA = (size_t)HALF * g.lda * 2, hstepB = (size_t)HALF * K * 2;
    const size_t tstepA = 2 * hstepA, tstepB = 2 * hstepB;
    const unsigned ldsw = (unsigned)wid * 1024u;
    const int aoff = lds_byte(wr * 64 + fr, fq * 8), boff = lds_byte(wc * 32 + fr, fq * 8);
#define PG8_SA(b, h) (((b) * 2 + (h)) * HTB)
#define PG8_SB(b, h) ((4 + (b) * 2 + (h)) * HTB)
#define PG8_STAGE(bufoff, gbase, voff) do { _Pragma("unroll") for (int _i = 0; _i < 2; ++_i) \
        __builtin_amdgcn_global_load_lds((const unsigned*)((const char*)(gbase) + (voff)[_i]), (PG8_LAS unsigned*)(lds + (bufoff) + ldsw + _i * 8192), 16, 0, 0); } while (0)
#define PG8_LDA(dst, b, h) do { _Pragma("unroll") for (int m = 0; m < 4; ++m) _Pragma("unroll") for (int k = 0; k < 2; ++k) dst[m][k] = *(const PG8_LAS bf16x8*)(lds + PG8_SA(b, h) + aoff + m * 2048 + k * 1024); } while (0)
#define PG8_LDB(dst, b, h) do { _Pragma("unroll") for (int n = 0; n < 2; ++n) _Pragma("unroll") for (int k = 0; k < 2; ++k) dst[n][k] = *(const PG8_LAS bf16x8*)(lds + PG8_SB(b, h) + boff + n * 2048 + k * 1024); } while (0)
#define PG8_MMA(ai, bj, At, Bt) do { __builtin_amdgcn_s_setprio(1); _Pragma("unroll") for (int m = 0; m < 4; ++m) _Pragma("unroll") for (int n = 0; n < 2; ++n) _Pragma("unroll") for (int k = 0; k < 2; ++k) \
        acc[ai][bj][m][n] = __builtin_amdgcn_mfma_f32_16x16x32_bf16(Bt[n][k], At[m][k], acc[ai][bj][m][n], 0, 0, 0); __builtin_amdgcn_s_setprio(0); } while (0)
#define PG8_WAIT_V(n) asm volatile("s_waitcnt vmcnt(" #n ")" ::: "memory")
#define PG8_WAIT_L(n) asm volatile("s_waitcnt lgkmcnt(" #n ")" ::: "memory")
#define PG8_BAR __builtin_amdgcn_s_barrier()
#define PG8_SCHED __builtin_amdgcn_sched_barrier(0)
    Unit cur, nxt; int ui = 0;
    if (!S.next(0, cur)) return;
    f32x4 acc[2][2][4][2];
#pragma unroll
    for (int a = 0; a < 2; ++a)
#pragma unroll
        for (int b = 0; b < 2; ++b)
#pragma unroll
            for (int m = 0; m < 4; ++m)
#pragma unroll
                for (int n = 0; n < 2; ++n) acc[a][b][m][n] = (f32x4){0.f, 0.f, 0.f, 0.f};
    bf16x8 At[4][2], B0[2][2], B1[2][2];
    const char* cA = (const char*)g.A + (size_t)cur.pm * tstepA; const char* cB = (const char*)g.Bt + (size_t)cur.pn * tstepB;
    S.a_ready(cur);
    if constexpr (SP2) {
        PG8_STAGE(PG8_SB(0, 0), cB, voffB); PG8_STAGE(PG8_SB(0, 1), cB + hstepB, voffB); PG8_STAGE(PG8_SA(0, 0), cA, voffA); PG8_STAGE(PG8_SA(0, 1), cA + hstepA, voffA);
        if (wr == 1) PG8_BAR;
        PG8_WAIT_V(2); PG8_BAR;
        PG8_STAGE(PG8_SB(1, 0), cB + kstep, voffB); PG8_STAGE(PG8_SA(1, 0), cA + kstep, voffA); PG8_STAGE(PG8_SB(1, 1), cB + hstepB + kstep, voffB);
        PG8_WAIT_V(6); PG8_BAR;
    } else {
        PG8_STAGE(PG8_SB(0, 0), cB, voffB); PG8_STAGE(PG8_SA(0, 0), cA, voffA); PG8_STAGE(PG8_SB(0, 1), cB + hstepB, voffB); PG8_STAGE(PG8_SA(0, 1), cA + hstepA, voffA);
        if (wr == 1) PG8_BAR;
        PG8_WAIT_V(4); PG8_BAR;
        PG8_STAGE(PG8_SB(1, 0), cB + kstep, voffB); PG8_STAGE(PG8_SA(1, 0), cA + kstep, voffA); PG8_STAGE(PG8_SB(1, 1), cB + hstepB + kstep, voffB);
        PG8_WAIT_V(6); PG8_BAR;
    }
    for (;;) {
        const bool has_next = S.next(ui + 1, nxt);
        const char* nA = has_next ? (const char*)g.A + (size_t)nxt.pm * tstepA : cA; const char* nB = has_next ? (const char*)g.Bt + (size_t)nxt.pn * tstepB : cB;
        for (int t = 0; t < nt; t += 2) {
            const bool last = (t == nt - 2);
            const char* a1 = cA + (size_t)(t + 1) * kstep;
            const char* a2 = last ? nA : cA + (size_t)(t + 2) * kstep; const char* b2 = last ? nB : cB + (size_t)(t + 2) * kstep;
            const char* a3 = a2 + kstep; const char* b3 = b2 + kstep;
            if (last && has_next) S.a_ready(nxt);
            if constexpr (SP2) {
            PG8_LDB(B0, 0, 0); PG8_LDB(B1, 0, 1); PG8_SCHED; PG8_LDA(At, 0, 0); PG8_STAGE(PG8_SA(1, 1), a1 + hstepA, voffA);
            PG8_WAIT_V(8); PG8_WAIT_L(0); PG8_BAR; PG8_MMA(0, 0, At, B0); PG8_MMA(0, 1, At, B1); PG8_BAR; PG8_SCHED;
            PG8_LDA(At, 0, 1); PG8_STAGE(PG8_SB(0, 0), b2, voffB); PG8_STAGE(PG8_SB(0, 1), b2 + hstepB, voffB); PG8_STAGE(PG8_SA(0, 0), a2, voffA);
            PG8_WAIT_V(8); PG8_WAIT_L(0); PG8_BAR; PG8_MMA(1, 0, At, B0); PG8_MMA(1, 1, At, B1); PG8_BAR; PG8_SCHED;
            PG8_LDB(B0, 1, 0); PG8_LDB(B1, 1, 1); PG8_SCHED; PG8_LDA(At, 1, 0); PG8_STAGE(PG8_SA(0, 1), a2 + hstepA, voffA);
            PG8_WAIT_V(8); PG8_WAIT_L(0); PG8_BAR; PG8_MMA(0, 0, At, B0); PG8_MMA(0, 1, At, B1); PG8_BAR; PG8_SCHED;
            PG8_LDA(At, 1, 1); PG8_STAGE(PG8_SB(1, 0), b3, voffB); PG8_STAGE(PG8_SB(1, 1), b3 + hstepB, voffB); PG8_STAGE(PG8_SA(1, 0), a3, voffA);
            PG8_WAIT_V(8); PG8_WAIT_L(0); PG8_BAR; PG8_MMA(1, 0, At, B0); PG8_MMA(1, 1, At, B1); PG8_BAR; PG8_SCHED;
            } else {
            PG8_LDB(B0, 0, 0); PG8_SCHED; PG8_LDA(At, 0, 0); PG8_STAGE(PG8_SA(1, 1), a1 + hstepA, voffA);
            PG8_WAIT_L(8); PG8_BAR; PG8_WAIT_L(0); PG8_MMA(0, 0, At, B0); PG8_BAR; PG8_SCHED;
            PG8_LDB(B1, 0, 1); PG8_STAGE(PG8_SB(0, 0), b2, voffB);
            PG8_BAR; PG8_WAIT_L(0); PG8_MMA(0, 1, At, B1); PG8_BAR;
            PG8_LDA(At, 0, 1); PG8_STAGE(PG8_SA(0, 0), a2, voffA);
            PG8_BAR; PG8_WAIT_L(0); PG8_MMA(1, 0, At, B0); PG8_BAR; PG8_SCHED;
            PG8_STAGE(PG8_SB(0, 1), b2 + hstepB, voffB);
            PG8_WAIT_V(6); PG8_BAR; PG8_MMA(1, 1, At, B1); PG8_BAR;
            PG8_LDB(B0, 1, 0); PG8_SCHED; PG8_LDA(At, 1, 0); PG8_STAGE(PG8_SA(0, 1), a2 + hstepA, voffA);
            PG8_WAIT_L(8); PG8_BAR; PG8_WAIT_L(0); PG8_MMA(0, 0, At, B0); PG8_BAR; PG8_SCHED;
            PG8_LDB(B1, 1, 1); PG8_STAGE(PG8_SB(1, 0), b3, voffB);
            PG8_BAR; PG8_WAIT_L(0); PG8_MMA(0, 1, At, B1); PG8_BAR;
            PG8_LDA(At, 1, 1); PG8_STAGE(PG8_SA(1, 0), a3, voffA);
            PG8_BAR; PG8_WAIT_L(0); PG8_MMA(1, 0, At, B0); PG8_BAR; PG8_SCHED;
            PG8_STAGE(PG8_SB(1, 1), b3 + hstepB, voffB);
            PG8_WAIT_V(6); PG8_BAR; PG8_MMA(1, 1, At, B1); PG8_BAR;
            }
        }
        if constexpr (ALIGN_EPI) { if (wr == 0) PG8_BAR; }
        if constexpr (!Epi::AFTER_DRAIN) { E(acc, cur, wr, wc, fr, fq); S.done(cur); }
        if (!has_next) break;
#pragma unroll
        for (int a = 0; a < 2; ++a)
#pragma unroll
            for (int b = 0; b < 2; ++b)
#pragma unroll
                for (int m = 0; m < 4; ++m)
#pragma unroll
                    for (int n = 0; n < 2; ++n) acc[a][b][m][n] = (f32x4){0.f, 0.f, 0.f, 0.f};
        cur = nxt; cA = nA; cB = nB; ++ui;
        if constexpr (ALIGN_EPI) { if (wr == 1) PG8_BAR; }
    }
    PG8_WAIT_V(0);
    if constexpr (!ALIGN_EPI) { if (wr == 0) PG8_BAR; }
    PG8_BAR;
    if constexpr (Epi::AFTER_DRAIN) { E.fused(acc, cur, wr, wc, fr, fq, lds, wid, lane); S.done(cur); }
#undef PG8_SA
#undef PG8_SB
#undef PG8_STAGE
#undef PG8_LDA
#undef PG8_LDB
#undef PG8_MMA
#undef PG8_WAIT_V
#undef PG8_WAIT_L
#undef PG8_BAR
#undef PG8_SCHED
}
}

constexpr int M_TOK = 32768, DM = 1024, SEQ = 4096, NB = 8;
constexpr int GDN_N = 6176, GDN_NP = 6400, GDN_PITCH = 6144, FF = 2816;
constexpr float EPS = 1e-6f;
#define LAS __attribute__((address_space(3)))
typedef unsigned short bf16_t;
typedef short bf16x8 __attribute__((ext_vector_type(8)));
typedef float f32x4 __attribute__((ext_vector_type(4)));
typedef float f32x16 __attribute__((ext_vector_type(16)));
typedef unsigned u32x4 __attribute__((ext_vector_type(4)));
typedef unsigned u32x2 __attribute__((ext_vector_type(2)));
using pg8::cvt_pk_bf16;

constexpr size_t MiB = 1u << 20;
constexpr size_t WS_WIN = 1 * MiB, WS_WOUT = 14 * MiB, WS_WGU = 18 * MiB, WS_WDN = 29 * MiB, WS_GB = 36 * MiB, WS_H = 40 * MiB, WS_PROJ = 104 * MiB, WS_END = 488 * MiB;
constexpr int LDS_BYTES = 147456;

__device__ __forceinline__ float bf2f(unsigned short b) { return __uint_as_float(((unsigned)b) << 16); }
__device__ __forceinline__ float bflo(unsigned u) { return __uint_as_float(u << 16); }
__device__ __forceinline__ float bfhi(unsigned u) { return __uint_as_float(u & 0xffff0000u); }
__device__ __forceinline__ float wave_sum(float v) {
#pragma unroll
    for (int o = 1; o < 64; o <<= 1) v += __shfl_xor(v, o);
    return v;
}
__device__ __forceinline__ float silu_f(float v) { return v * __builtin_amdgcn_rcpf(1.f + __expf(-v)); }
__device__ __forceinline__ float softplus_f(float x) { return fmaxf(x, 0.f) + __logf(1.f + __expf(-fabsf(x))); }

struct EpiProj {
    static constexpr bool PERM = true, AFTER_DRAIN = false;
    bf16_t* O; int ldc; int gate_tile; float* gb; const float* a_log; const float* dt_bias;
    __device__ __forceinline__ void operator()(const f32x4 (&acc)[2][2][4][2], const pg8::Unit& u, int wr, int wc, int fr, int fq) const {
        const int row0 = u.pm * 256 + wr * 64 + fr;
        if (u.pn == gate_tile) {
            if (wc == 0) {
                const int c0 = 8 * fq;
#pragma unroll
                for (int ai = 0; ai < 2; ++ai)
#pragma unroll
                    for (int m = 0; m < 4; ++m) {
                        const int row = row0 + ai * 128 + m * 16;
#pragma unroll
                        for (int n = 0; n < 2; ++n) {
                            const f32x4 v = acc[ai][0][m][n]; f32x4 o;
                            const int c = c0 + 4 * n;
                            if (fq < 2) {
#pragma unroll
                                for (int j = 0; j < 4; ++j) o[j] = 1.f / (1.f + __expf(-v[j]));
                            } else {
                                const f32x4 al = *(const f32x4*)(a_log + c - 16), db = *(const f32x4*)(dt_bias + c - 16);
#pragma unroll
                                for (int j = 0; j < 4; ++j) o[j] = -__expf(al[j]) * softplus_f(v[j] + db[j]);
                            }
                            *(f32x4*)(gb + (size_t)row * 32 + c) = o;
                        }
                    }
            }
            return;
        }
        const int col0 = u.pn * 256 + wc * 32 + 8 * fq;
#pragma unroll
        for (int ai = 0; ai < 2; ++ai)
#pragma unroll
            for (int m = 0; m < 4; ++m) { bf16_t* rowp = O + (size_t)(row0 + ai * 128 + m * 16) * ldc + col0;
#pragma unroll
                for (int bj = 0; bj < 2; ++bj) { const f32x4 v0 = acc[ai][bj][m][0], v1 = acc[ai][bj][m][1];
                    u32x4 w; w.x = cvt_pk_bf16(v0[0], v0[1]); w.y = cvt_pk_bf16(v0[2], v0[3]); w.z = cvt_pk_bf16(v1[0], v1[1]); w.w = cvt_pk_bf16(v1[2], v1[3]);
                    *(u32x4*)(rowp + bj * 128) = w; } }
    }
};
struct EpiSwiglu {
    static constexpr bool PERM = true, AFTER_DRAIN = false;
    bf16_t* O; int ldc;
    __device__ __forceinline__ void operator()(const f32x4 (&acc)[2][2][4][2], const pg8::Unit& u, int wr, int wc, int fr, int fq) const {
        const int row0 = u.pm * 256 + wr * 64 + fr, col0 = u.pn * 128 + wc * 32 + 8 * fq;
#pragma unroll
        for (int ai = 0; ai < 2; ++ai)
#pragma unroll
            for (int m = 0; m < 4; ++m) { bf16_t* rowp = O + (size_t)(row0 + ai * 128 + m * 16) * ldc + col0;
                float r[8];
#pragma unroll
                for (int n = 0; n < 2; ++n)
#pragma unroll
                    for (int j = 0; j < 4; ++j) { const float g = acc[ai][0][m][n][j], up = acc[ai][1][m][n][j]; r[4 * n + j] = silu_f(g) * up; }
                u32x4 w; w.x = cvt_pk_bf16(r[0], r[1]); w.y = cvt_pk_bf16(r[2], r[3]); w.z = cvt_pk_bf16(r[4], r[5]); w.w = cvt_pk_bf16(r[6], r[7]);
                *(u32x4*)rowp = w; }
    }
};
struct EpiRes {
    static constexpr bool PERM = false, AFTER_DRAIN = false;
    const float* base; float* out; int ldc;
    __device__ __forceinline__ void operator()(const f32x4 (&acc)[2][2][4][2], const pg8::Unit& u, int wr, int wc, int fr, int fq) const {
        const int row0 = u.pm * 256 + wr * 64 + fr, col0 = u.pn * 256 + wc * 32 + 4 * fq;
#pragma unroll
        for (int ai = 0; ai < 2; ++ai)
#pragma unroll
            for (int m = 0; m < 4; ++m) { const size_t off = (size_t)(row0 + ai * 128 + m * 16) * ldc + col0;
#pragma unroll
                for (int bj = 0; bj < 2; ++bj)
#pragma unroll
                    for (int n = 0; n < 2; ++n) { const f32x4 b = *(const f32x4*)(base + off + bj * 128 + n * 16); *(f32x4*)(out + off + bj * 128 + n * 16) = b + acc[ai][bj][m][n]; } }
    }
};

__device__ __forceinline__ unsigned f2bf(float f) { unsigned u = __float_as_uint(f); return (u + 0x7fffu + ((u >> 16) & 1u)) >> 16; }
__device__ __forceinline__ unsigned pk2(float lo, float hi) { return f2bf(lo) | (f2bf(hi) << 16); }
__device__ __forceinline__ void transpose_item(const float* W, int K, int N, bf16_t* WT, int k0, int n0, int drow0, LAS float* scr, int lane) {
#pragma unroll 8
    for (int i = 0; i < 32; ++i) { const int kk = 2 * i + (lane >> 5); scr[kk * 33 + (lane & 31)] = W[(size_t)(k0 + kk) * N + n0 + (lane & 31)]; }
    asm volatile("s_waitcnt lgkmcnt(0)" ::: "memory");
    const int c = lane & 7;
#pragma unroll
    for (int j = 0; j < 4; ++j) { const int n = (lane >> 3) + 8 * j; const LAS float* s = scr + (8 * c) * 33 + n;
        u32x4 o; o.x = pk2(s[0 * 33], s[1 * 33]); o.y = pk2(s[2 * 33], s[3 * 33]); o.z = pk2(s[4 * 33], s[5 * 33]); o.w = pk2(s[6 * 33], s[7 * 33]);
        *(u32x4*)(WT + (size_t)(drow0 + n) * K + k0 + 8 * c) = o; }
    asm volatile("s_waitcnt lgkmcnt(0)" ::: "memory");
}
__device__ __forceinline__ void conv_plain(const float* W, int K, int N, bf16_t* WT, int item, LAS float* scr, int lane) {
    const int nblk = N / 32, kb = item / nblk, nb = item % nblk;
    transpose_item(W, K, N, WT, 64 * kb, 32 * nb, 32 * nb, scr, lane);
}
__device__ __forceinline__ void conv_gu(const float* W, bf16_t* WT, int item, int up, LAS float* scr, int lane) {
    const int nblk = FF / 32, kb = item / nblk, nb = item % nblk, n0 = 32 * nb;
    transpose_item(W, DM, FF, WT, 64 * kb, n0, (n0 >> 7) * 256 + (n0 & 127) + up * 128, scr, lane);
}
__device__ __forceinline__ void norm_rows(const float* x, const float* w, bf16_t* h, int gw, int NGW, int lane) {
    asm volatile("" : "+v"(lane));
    f32x4 wv[4];
#pragma unroll
    for (int j = 0; j < 4; ++j) wv[j] = *((const f32x4*)w + lane + 64 * j);
    for (int m = gw; m < M_TOK; m += NGW) {
        const f32x4* xr = (const f32x4*)(x + (size_t)m * DM) + lane; f32x4 v[4]; float s = 0.f;
#pragma unroll
        for (int j = 0; j < 4; ++j) { v[j] = xr[64 * j]; s += (v[j].x * v[j].x + v[j].y * v[j].y) + (v[j].z * v[j].z + v[j].w * v[j].w); }
        const float rstd = 1.f / sqrtf(wave_sum(s) * (1.f / DM) + EPS);
        u32x2* o8 = (u32x2*)(h + (size_t)m * DM) + lane;
#pragma unroll
        for (int j = 0; j < 4; ++j) { const f32x4 o = v[j] * rstd * wv[j]; u32x2 p; p.x = cvt_pk_bf16(o.x, o.y); p.y = cvt_pk_bf16(o.z, o.w); o8[64 * j] = p; }
    }
}
__device__ __forceinline__ void final_norm_rows(float* x, const float* w, int gw, int NGW, int lane) {
    f32x4 wv[4];
#pragma unroll
    for (int j = 0; j < 4; ++j) wv[j] = *((const f32x4*)w + lane + 64 * j);
    for (int m = gw; m < M_TOK; m += NGW) {
        f32x4* xr = (f32x4*)(x + (size_t)m * DM) + lane; f32x4 v[4]; float s = 0.f;
#pragma unroll
        for (int j = 0; j < 4; ++j) { v[j] = xr[64 * j]; s += (v[j].x * v[j].x + v[j].y * v[j].y) + (v[j].z * v[j].z + v[j].w * v[j].w); }
        const float rstd = 1.f / sqrtf(wave_sum(s) * (1.f / DM) + EPS);
#pragma unroll
        for (int j = 0; j < 4; ++j) xr[64 * j] = v[j] * rstd * wv[j];
    }
}

__device__ __forceinline__ int crow(int r, int hi) { return (r & 3) + 8 * (r >> 2) + 4 * hi; }

__device__ __forceinline__ void gdn_g1(LAS unsigned char* lds, const bf16_t* __restrict__ proj, const float* __restrict__ gb, const float* __restrict__ convw,
                                        bf16_t* __restrict__ Tbuf, int gw, int NGW, int wave, int lane) {
    asm volatile("" : "+v"(lane));
    LAS float* Lw = (LAS float*)(lds + wave * 16384);
    LAS float* aux = (LAS float*)(lds + 131072 + wave * 1024);
    const int r32 = lane & 31, hi = lane >> 5;
    for (int u = gw; u < NB * 64 * 16; u += NGW) {
        const int hv = u & 15, chunk = (u >> 4) & 63, b = u >> 10, hq = hv >> 1;
        const size_t rowb = (size_t)b * SEQ + chunk * 64;
        {
            float g = gb[(rowb + lane) * 32 + 16 + hv]; const float bt = gb[(rowb + lane) * 32 + hv];
#pragma unroll
            for (int o = 1; o < 64; o <<= 1) { const float t = __shfl_up(g, o); if (lane >= o) g += t; }
            aux[lane] = g; aux[64 + lane] = bt;
        }
        float ss[2] = {0.f, 0.f};
        f32x16 a00 = {}, a10 = {}, a11 = {};
#pragma unroll 1
        for (int kk = 0; kk < 8; ++kk) {
            const int cb = 1024 + hq * 128 + 16 * kk + 8 * hi;
            f32x4 w[8];
#pragma unroll
            for (int e = 0; e < 8; ++e) w[e] = *(const f32x4*)(convw + (size_t)(cb + e) * 4);
            bf16x8 kf[2];
#pragma unroll
            for (int ti = 0; ti < 2; ++ti) {
                const int t = 32 * ti + r32, tin = chunk * 64 + t;
                const bf16_t* p = proj + (rowb + t) * GDN_PITCH + cb;
                u32x4 x3 = *(const u32x4*)p, x2 = {0, 0, 0, 0}, x1 = {0, 0, 0, 0}, x0 = {0, 0, 0, 0};
                if (tin >= 1) x2 = *(const u32x4*)(p - GDN_PITCH);
                if (tin >= 2) x1 = *(const u32x4*)(p - 2 * GDN_PITCH);
                if (tin >= 3) x0 = *(const u32x4*)(p - 3 * GDN_PITCH);
                float o[8];
#pragma unroll
                for (int e2 = 0; e2 < 4; ++e2) {
                    const float c0 = bflo(x0[e2]) * w[2 * e2][0] + bflo(x1[e2]) * w[2 * e2][1] + bflo(x2[e2]) * w[2 * e2][2] + bflo(x3[e2]) * w[2 * e2][3];
                    const float c1 = bfhi(x0[e2]) * w[2 * e2 + 1][0] + bfhi(x1[e2]) * w[2 * e2 + 1][1] + bfhi(x2[e2]) * w[2 * e2 + 1][2] + bfhi(x3[e2]) * w[2 * e2 + 1][3];
                    o[2 * e2] = silu_f(c0); o[2 * e2 + 1] = silu_f(c1);
                    ss[ti] += o[2 * e2] * o[2 * e2] + o[2 * e2 + 1] * o[2 * e2 + 1];
                }
                u32x4 pk; pk.x = cvt_pk_bf16(o[0], o[1]); pk.y = cvt_pk_bf16(o[2], o[3]); pk.z = cvt_pk_bf16(o[4], o[5]); pk.w = cvt_pk_bf16(o[6], o[7]);
                kf[ti] = __builtin_bit_cast(bf16x8, pk);
            }
            a00 = __builtin_amdgcn_mfma_f32_32x32x16_bf16(kf[0], kf[0], a00, 0, 0, 0);
            a10 = __builtin_amdgcn_mfma_f32_32x32x16_bf16(kf[1], kf[0], a10, 0, 0, 0);
            a11 = __builtin_amdgcn_mfma_f32_32x32x16_bf16(kf[1], kf[1], a11, 0, 0, 0);
        }
#pragma unroll
        for (int ti = 0; ti < 2; ++ti) { ss[ti] += __shfl_xor(ss[ti], 32); if (hi == 0) aux[128 + 32 * ti + r32] = __builtin_amdgcn_rsqf(ss[ti] + EPS); }
        asm volatile("s_waitcnt lgkmcnt(0)" ::: "memory");
        {
            const float gcj0 = aux[r32], gcj1 = aux[32 + r32], rnj0 = aux[128 + r32], rnj1 = aux[160 + r32];
#pragma unroll
            for (int r = 0; r < 16; ++r) {
                const int i0 = crow(r, hi), i1 = 32 + i0;
                const float gi0 = aux[i0], gi1 = aux[i1], bi0 = aux[64 + i0], bi1 = aux[64 + i1], ri0 = aux[128 + i0], ri1 = aux[128 + i1];
                Lw[i0 * 64 + r32] = (i0 > r32) ? bi0 * ri0 * rnj0 * a00[r] * __expf(gi0 - gcj0) : 0.f;
                Lw[i1 * 64 + r32] = bi1 * ri1 * rnj0 * a10[r] * __expf(gi1 - gcj0);
                Lw[i1 * 64 + 32 + r32] = (i0 > r32) ? bi1 * ri1 * rnj1 * a11[r] * __expf(gi1 - gcj1) : 0.f;
            }
        }
        asm volatile("s_waitcnt lgkmcnt(0)" ::: "memory");
        float X[64];
#pragma unroll
        for (int i = 0; i < 64; ++i) {
            float xi = (lane == i) ? 1.f : 0.f, xj = 0.f;
#pragma unroll
            for (int g4 = 0; g4 < (i + 3) / 4; ++g4) {
                const f32x4 l = *(const LAS f32x4*)(Lw + i * 64 + 4 * g4);
#pragma unroll
                for (int e = 0; e < 4; ++e) { const int j = 4 * g4 + e; if (j < i) { if (j & 1) xj -= l[e] * X[j]; else xi -= l[e] * X[j]; } }
            }
            X[i] = xi + xj;
            asm volatile("" ::: "memory");
        }
        bf16_t* To = Tbuf + (size_t)((b * 16 + hv) * 64 + chunk) * 4096 + lane;
#pragma unroll
        for (int i = 0; i < 64; ++i) To[i * 64] = (bf16_t)f2bf(X[i]);
        asm volatile("s_waitcnt lgkmcnt(0)" ::: "memory");
    }
}

namespace g2 {
constexpr int QN = 0, KN = 18432, KNT = 35840, VT = 54272, RT = 72704, ST = 91136, TL = 125952, ATT = 135168, AUX = 144384;
constexpr int P128 = 272, P64 = 144;
__device__ __forceinline__ f32x16 mma(f32x16 acc, LAS const unsigned char* A, int ap, LAS const unsigned char* B, int bp, int nk, int r32, int hi) {
    LAS const unsigned char* a = A + r32 * ap + 16 * hi; LAS const unsigned char* b = B + r32 * bp + 16 * hi;
#pragma unroll
    for (int kk = 0; kk < 8; ++kk) if (kk < nk) {
        const bf16x8 av = *(LAS const bf16x8*)(a + 32 * kk), bv = *(LAS const bf16x8*)(b + 32 * kk);
        acc = __builtin_amdgcn_mfma_f32_32x32x16_bf16(av, bv, acc, 0, 0, 0);
    }
    return acc;
}
}
__device__ __forceinline__ void gdn_g2(LAS unsigned char* lds, bf16_t* proj, const float* __restrict__ gb, const float* __restrict__ convw, const float* __restrict__ normw,
                                        const bf16_t* __restrict__ Tbuf, int unit0, int ustride, int tid, int wave, int lane) {
    using namespace g2;
    asm volatile("" : "+v"(lane), "+v"(tid));
    const int r32 = lane & 31, hi = lane >> 5, ti = wave & 1, tj = wave >> 1;
    LAS float* aux = (LAS float*)(lds + AUX);
    LAS unsigned* halo = (LAS unsigned*)(lds + AUX + 1088);
    for (int unit = unit0; unit < NB * 16; unit += ustride) {
        const int b = unit >> 4, hv = unit & 15, hq = hv >> 1;
        const int colq = hq * 128 + 2 * lane, colk = 1024 + colq, colv = 2048 + hv * 128 + 2 * lane, colz = 4096 + hv * 128 + 2 * lane;
        f32x4 wq[2], wk[2], wv[2];
#pragma unroll
        for (int c = 0; c < 2; ++c) { wq[c] = *(const f32x4*)(convw + (size_t)(colq + c) * 4); wk[c] = *(const f32x4*)(convw + (size_t)(colk + c) * 4); wv[c] = *(const f32x4*)(convw + (size_t)(colv + c) * 4); }
        const float nw0 = normw[2 * lane], nw1 = normw[2 * lane + 1];
        f32x16 S0 = {}, S1 = {};
        for (int i = tid; i < 34816 / 4; i += 512) ((LAS unsigned*)(lds + ST))[i] = 0u;
        for (int chunk = 0; chunk < 64; ++chunk) {
            const size_t rowb = (size_t)b * SEQ + chunk * 64;
            {
                unsigned xq[11], xk[11], xv[11];
#pragma unroll
                for (int j = 0; j < 11; ++j) {
                    const int t = 8 * wave - 3 + j;
                    const bool ok = (chunk * 64 + t) >= 0;
                    const bf16_t* p = proj + (size_t)((long)rowb + t) * GDN_PITCH;
                    xq[j] = ok ? *(const unsigned*)(p + colq) : 0u;
                    xk[j] = ok ? *(const unsigned*)(p + colk) : 0u;
                    if (t >= 0) xv[j] = *(const unsigned*)(p + colv);
                    else xv[j] = (chunk > 0) ? halo[((chunk & 1) * 3 + (t + 3)) * 64 + lane] : 0u;
                }
                if (wave == 7) {
#pragma unroll
                    for (int j = 0; j < 3; ++j) halo[((((chunk + 1) & 1)) * 3 + j) * 64 + lane] = xv[8 + j];
                }
                asm volatile("" ::: "memory");
                {
#pragma unroll
                    for (int r = 0; r < 8; ++r) {
                        float q0 = bflo(xq[r]) * wq[0][0] + bflo(xq[r + 1]) * wq[0][1] + bflo(xq[r + 2]) * wq[0][2] + bflo(xq[r + 3]) * wq[0][3];
                        float q1 = bfhi(xq[r]) * wq[1][0] + bfhi(xq[r + 1]) * wq[1][1] + bfhi(xq[r + 2]) * wq[1][2] + bfhi(xq[r + 3]) * wq[1][3];
                        q0 = silu_f(q0); q1 = silu_f(q1);
                        const float rq = 0.08838834764831845f / sqrtf(wave_sum(q0 * q0 + q1 * q1) + EPS);
                        *(LAS unsigned*)(lds + QN + (8 * wave + r) * P128 + 4 * lane) = cvt_pk_bf16(q0 * rq, q1 * rq);
                    }
                }
                asm volatile("" ::: "memory");
                {
                    float k0[8], k1[8];
#pragma unroll
                    for (int r = 0; r < 8; ++r) {
                        float a0 = bflo(xk[r]) * wk[0][0] + bflo(xk[r + 1]) * wk[0][1] + bflo(xk[r + 2]) * wk[0][2] + bflo(xk[r + 3]) * wk[0][3];
                        float a1 = bfhi(xk[r]) * wk[1][0] + bfhi(xk[r + 1]) * wk[1][1] + bfhi(xk[r + 2]) * wk[1][2] + bfhi(xk[r + 3]) * wk[1][3];
                        a0 = silu_f(a0); a1 = silu_f(a1);
                        const float rk = 1.f / sqrtf(wave_sum(a0 * a0 + a1 * a1) + EPS);
                        k0[r] = a0 * rk; k1[r] = a1 * rk;
                        *(LAS unsigned*)(lds + KN + (8 * wave + r) * P128 + 4 * lane) = cvt_pk_bf16(k0[r], k1[r]);
                    }
                    *(LAS u32x4*)(lds + KNT + (2 * lane) * P64 + 16 * wave) = (u32x4){cvt_pk_bf16(k0[0], k0[1]), cvt_pk_bf16(k0[2], k0[3]), cvt_pk_bf16(k0[4], k0[5]), cvt_pk_bf16(k0[6], k0[7])};
                    *(LAS u32x4*)(lds + KNT + (2 * lane + 1) * P64 + 16 * wave) = (u32x4){cvt_pk_bf16(k1[0], k1[1]), cvt_pk_bf16(k1[2], k1[3]), cvt_pk_bf16(k1[4], k1[5]), cvt_pk_bf16(k1[6], k1[7])};
                }
                asm volatile("" ::: "memory");
                {
                    float v0[8], v1[8];
#pragma unroll
                    for (int r = 0; r < 8; ++r) {
                        const float a0 = bflo(xv[r]) * wv[0][0] + bflo(xv[r + 1]) * wv[0][1] + bflo(xv[r + 2]) * wv[0][2] + bflo(xv[r + 3]) * wv[0][3];
                        const float a1 = bfhi(xv[r]) * wv[1][0] + bfhi(xv[r + 1]) * wv[1][1] + bfhi(xv[r + 2]) * wv[1][2] + bfhi(xv[r + 3]) * wv[1][3];
                        v0[r] = silu_f(a0); v1[r] = silu_f(a1);
                    }
                    *(LAS u32x4*)(lds + VT + (2 * lane) * P64 + 16 * wave) = (u32x4){cvt_pk_bf16(v0[0], v0[1]), cvt_pk_bf16(v0[2], v0[3]), cvt_pk_bf16(v0[4], v0[5]), cvt_pk_bf16(v0[6], v0[7])};
                    *(LAS u32x4*)(lds + VT + (2 * lane + 1) * P64 + 16 * wave) = (u32x4){cvt_pk_bf16(v1[0], v1[1]), cvt_pk_bf16(v1[2], v1[3]), cvt_pk_bf16(v1[4], v1[5]), cvt_pk_bf16(v1[6], v1[7])};
                }
                asm volatile("" ::: "memory");
                if (wave == 0) {
                    float g = gb[(rowb + lane) * 32 + 16 + hv]; const float bt = gb[(rowb + lane) * 32 + hv];
#pragma unroll
                    for (int o = 1; o < 64; o <<= 1) { const float t = __shfl_up(g, o); if (lane >= o) g += t; }
                    const float gl = __shfl(g, 63);
                    aux[lane] = g; aux[64 + lane] = bt; aux[128 + lane] = __expf(g); aux[192 + lane] = __expf(gl - g);
                    if (lane == 0) aux[256] = __expf(gl);
                }
                {
                    const int row = tid >> 3, ch = tid & 7;
                    const u32x4 tv = *(const u32x4*)(Tbuf + (size_t)((b * 16 + hv) * 64 + chunk) * 4096 + row * 64 + ch * 8);
                    *(LAS u32x4*)(lds + TL + row * P64 + ch * 16) = tv;
                }
            }
            __syncthreads();
            if (wave < 4) {
                const int si = wave & 1, tq = wave >> 1;
                f32x16 p = {};
                p = mma(p, lds + KN + 32 * si * P128, P128, lds + QN + 32 * tq * P128, P128, 8, r32, hi);
                const int t = 32 * tq + r32; const float gt = aux[t];
#pragma unroll
                for (int g4 = 0; g4 < 4; ++g4) {
                    float a[4];
#pragma unroll
                    for (int e = 0; e < 4; ++e) { const int s = 32 * si + 8 * g4 + 4 * hi + e; a[e] = (s <= t) ? p[4 * g4 + e] * __expf(gt - aux[s]) : 0.f; }
                    *(LAS u32x2*)(lds + ATT + t * P64 + (32 * si + 8 * g4 + 4 * hi) * 2) = (u32x2){cvt_pk_bf16(a[0], a[1]), cvt_pk_bf16(a[2], a[3])};
                }
            }
            f32x16 o1 = {};
            {
                f32x16 acc = {};
                acc = mma(acc, lds + KN + 32 * ti * P128, P128, lds + ST + 32 * tj * P128, P128, 8, r32, hi);
                o1 = mma(o1, lds + QN + 32 * ti * P128, P128, lds + ST + 32 * tj * P128, P128, 8, r32, hi);
                const int dv = 32 * tj + r32;
#pragma unroll
                for (int g4 = 0; g4 < 4; ++g4) {
                    const int t0 = 32 * ti + 8 * g4 + 4 * hi;
                    const u32x2 vv = *(LAS const u32x2*)(lds + VT + dv * P64 + t0 * 2);
                    const float v4[4] = {bflo(vv.x), bfhi(vv.x), bflo(vv.y), bfhi(vv.y)};
                    float rr[4];
#pragma unroll
                    for (int e = 0; e < 4; ++e) { const float eg = aux[128 + t0 + e]; rr[e] = aux[64 + t0 + e] * (v4[e] - eg * acc[4 * g4 + e]); o1[4 * g4 + e] *= eg; }
                    *(LAS u32x2*)(lds + RT + dv * P64 + t0 * 2) = (u32x2){cvt_pk_bf16(rr[0], rr[1]), cvt_pk_bf16(rr[2], rr[3])};
                }
            }
            __syncthreads();
            {
                f32x16 acc = {};
                acc = mma(acc, lds + TL + 32 * ti * P64, P64, lds + RT + 32 * tj * P64, P64, 4, r32, hi);
                const int dv = 32 * tj + r32;
#pragma unroll
                for (int g4 = 0; g4 < 4; ++g4) {
                    const int t0 = 32 * ti + 8 * g4 + 4 * hi;
                    float s4[4];
#pragma unroll
                    for (int e = 0; e < 4; ++e) s4[e] = acc[4 * g4 + e] * aux[192 + t0 + e];
                    *(LAS u32x2*)(lds + VT + dv * P64 + t0 * 2) = (u32x2){cvt_pk_bf16(acc[4 * g4], acc[4 * g4 + 1]), cvt_pk_bf16(acc[4 * g4 + 2], acc[4 * g4 + 3])};
                    *(LAS u32x2*)(lds + QN + dv * P64 + t0 * 2) = (u32x2){cvt_pk_bf16(s4[0], s4[1]), cvt_pk_bf16(s4[2], s4[3])};
                }
            }
            __syncthreads();
            {
                o1 = mma(o1, lds + ATT + 32 * ti * P64, P64, lds + VT + 32 * tj * P64, P64, 4, r32, hi);
                const int dv = 32 * tj + r32;
#pragma unroll
                for (int r = 0; r < 16; ++r) { const int t = 32 * ti + crow(r, hi); *(LAS unsigned short*)(lds + RT + t * P128 + dv * 2) = (unsigned short)f2bf(o1[r]); }
                const float egl = aux[256];
                S0 = S0 * egl; S1 = S1 * egl;
                S0 = mma(S0, lds + KNT + 32 * (2 * ti) * P64, P64, lds + QN + 32 * tj * P64, P64, 4, r32, hi);
                S1 = mma(S1, lds + KNT + 32 * (2 * ti + 1) * P64, P64, lds + QN + 32 * tj * P64, P64, 4, r32, hi);
#pragma unroll
                for (int g4 = 0; g4 < 4; ++g4) {
                    const int d0 = 8 * g4 + 4 * hi;
                    *(LAS u32x2*)(lds + ST + dv * P128 + (64 * ti + d0) * 2) = (u32x2){cvt_pk_bf16(S0[4 * g4], S0[4 * g4 + 1]), cvt_pk_bf16(S0[4 * g4 + 2], S0[4 * g4 + 3])};
                    *(LAS u32x2*)(lds + ST + dv * P128 + (64 * ti + 32 + d0) * 2) = (u32x2){cvt_pk_bf16(S1[4 * g4], S1[4 * g4 + 1]), cvt_pk_bf16(S1[4 * g4 + 2], S1[4 * g4 + 3])};
                }
            }
            __syncthreads();
#pragma unroll
            for (int r = 0; r < 8; ++r) {
                const int t = 8 * wave + r;
                const unsigned ov = *(LAS const unsigned*)(lds + RT + t * P128 + 4 * lane);
                const float oa = bflo(ov), ob = bfhi(ov);
                const float rstd = 1.f / sqrtf(wave_sum(oa * oa + ob * ob) * (1.f / 128.f) + EPS);
                bf16_t* prow = proj + (rowb + t) * GDN_PITCH;
                const unsigned zv = *(const unsigned*)(prow + colz);
                *(unsigned*)(prow + colv) = cvt_pk_bf16(oa * rstd * nw0 * silu_f(bflo(zv)), ob * rstd * nw1 * silu_f(bfhi(zv)));
            }
        }
        __syncthreads();
    }
}

__device__ __forceinline__ void sb_attn(LAS unsigned char* lds, bf16_t* qkv, int blk, int G, int tid, int wave, int lane) {
    constexpr int KS = 0, VS = 9216, P = 144, LD = 3072;
    asm volatile("" : "+v"(lane), "+v"(tid));
    const int r32 = lane & 31, hi = lane >> 5;
    bf16x8 Uf[2][4];
#pragma unroll
    for (int si = 0; si < 2; ++si)
#pragma unroll
        for (int kk = 0; kk < 4; ++kk)
#pragma unroll
            for (int e = 0; e < 8; ++e) { const int j = 16 * kk + 8 * (e >> 2) + 4 * hi + (e & 3); Uf[si][kk][e] = (j > 32 * si + r32) ? (short)0x3F80 : (short)0; }
    const int srow = tid >> 3, sch = tid & 7;
    for (int u = blk; u < 2048; u += G) {
        const int i = u >> 8, jj = u & 255, bh = jj & 127, half = jj >> 7, qb = 15 - 2 * i - (half ^ (i & 1));
        const int b = bh >> 4, h = bh & 15, q0 = qb * 256;
        const size_t rowb = (size_t)b * SEQ;
        const int tq = q0 + 32 * wave + r32;
        bf16_t* qptr = qkv + (rowb + tq) * LD + h * 64;
        bf16x8 qr[4];
#pragma unroll
        for (int kk = 0; kk < 4; ++kk) qr[kk] = *(const bf16x8*)(qptr + 16 * kk + 8 * hi);
        f32x16 oT0 = {}, oT1 = {};
        float carry = 0.f;
        const int ktmax = (q0 >> 6) + 3;
        const bf16_t* kbase = qkv + (rowb + srow) * LD + 1024 + h * 64 + sch * 8;
        u32x4 kreg = *(const u32x4*)(kbase + (size_t)ktmax * 64 * LD), vreg = *(const u32x4*)(kbase + (size_t)ktmax * 64 * LD + 1024);
        for (int kt = ktmax; kt >= 0; --kt) {
            __syncthreads();
            *(LAS u32x4*)(lds + KS + srow * P + sch * 16) = kreg;
#pragma unroll
            for (int e = 0; e < 4; ++e) {
                *(LAS unsigned short*)(lds + VS + (sch * 8 + 2 * e) * P + srow * 2) = (unsigned short)(vreg[e] & 0xffffu);
                *(LAS unsigned short*)(lds + VS + (sch * 8 + 2 * e + 1) * P + srow * 2) = (unsigned short)(vreg[e] >> 16);
            }
            __syncthreads();
            if (kt > 0) { kreg = *(const u32x4*)(kbase + (size_t)(kt - 1) * 64 * LD); vreg = *(const u32x4*)(kbase + (size_t)(kt - 1) * 64 * LD + 1024); }
            const int s0 = kt * 64;
            if (s0 < q0 + 32 * wave + 31) {
                f32x16 p0 = {}, p1 = {};
#pragma unroll
                for (int kk = 0; kk < 4; ++kk) {
                    const bf16x8 k0 = *(LAS const bf16x8*)(lds + KS + r32 * P + (16 * kk + 8 * hi) * 2), k1 = *(LAS const bf16x8*)(lds + KS + (32 + r32) * P + (16 * kk + 8 * hi) * 2);
                    p0 = __builtin_amdgcn_mfma_f32_32x32x16_bf16(k0, qr[kk], p0, 0, 0, 0);
                    p1 = __builtin_amdgcn_mfma_f32_32x32x16_bf16(k1, qr[kk], p1, 0, 0, 0);
                }
                float lk0[16], lk1[16]; float csum = 0.f;
#pragma unroll
                for (int r = 0; r < 16; ++r) {
                    const int s = s0 + crow(r, hi);
                    const float z0 = p0[r] * 0.125f, z1 = p1[r] * 0.125f;
                    p0[r] = z0; p1[r] = z1;
                    lk0[r] = (s < tq) ? -softplus_f(z0) : 0.f;
                    lk1[r] = (s + 32 < tq) ? -softplus_f(z1) : 0.f;
                    csum += lk0[r] + lk1[r];
                }
                csum += __shfl_xor(csum, 32);
                bf16x8 lf[4];
#pragma unroll
                for (int kk = 0; kk < 4; ++kk) {
                    u32x4 w;
                    if (kk < 2) { w.x = cvt_pk_bf16(lk0[8 * kk], lk0[8 * kk + 1]); w.y = cvt_pk_bf16(lk0[8 * kk + 2], lk0[8 * kk + 3]); w.z = cvt_pk_bf16(lk0[8 * kk + 4], lk0[8 * kk + 5]); w.w = cvt_pk_bf16(lk0[8 * kk + 6], lk0[8 * kk + 7]); }
                    else { const int q = 8 * (kk - 2); w.x = cvt_pk_bf16(lk1[q], lk1[q + 1]); w.y = cvt_pk_bf16(lk1[q + 2], lk1[q + 3]); w.z = cvt_pk_bf16(lk1[q + 4], lk1[q + 5]); w.w = cvt_pk_bf16(lk1[q + 6], lk1[q + 7]); }
                    lf[kk] = __builtin_bit_cast(bf16x8, w);
                }
                f32x16 R0, R1;
#pragma unroll
                for (int r = 0; r < 16; ++r) { R0[r] = carry; R1[r] = carry; }
#pragma unroll
                for (int kk = 0; kk < 4; ++kk) {
                    R0 = __builtin_amdgcn_mfma_f32_32x32x16_bf16(Uf[0][kk], lf[kk], R0, 0, 0, 0);
                    R1 = __builtin_amdgcn_mfma_f32_32x32x16_bf16(Uf[1][kk], lf[kk], R1, 0, 0, 0);
                }
                carry += csum;
#pragma unroll
                for (int r = 0; r < 16; ++r) {
                    const int s = s0 + crow(r, hi);
                    lk0[r] = (s < tq) ? __expf(p0[r] + lk0[r] + R0[r]) : 0.f;
                    lk1[r] = (s + 32 < tq) ? __expf(p1[r] + lk1[r] + R1[r]) : 0.f;
                }
#pragma unroll
                for (int kk = 0; kk < 4; ++kk) {
                    u32x4 w;
                    if (kk < 2) { w.x = cvt_pk_bf16(lk0[8 * kk], lk0[8 * kk + 1]); w.y = cvt_pk_bf16(lk0[8 * kk + 2], lk0[8 * kk + 3]); w.z = cvt_pk_bf16(lk0[8 * kk + 4], lk0[8 * kk + 5]); w.w = cvt_pk_bf16(lk0[8 * kk + 6], lk0[8 * kk + 7]); }
                    else { const int q = 8 * (kk - 2); w.x = cvt_pk_bf16(lk1[q], lk1[q + 1]); w.y = cvt_pk_bf16(lk1[q + 2], lk1[q + 3]); w.z = cvt_pk_bf16(lk1[q + 4], lk1[q + 5]); w.w = cvt_pk_bf16(lk1[q + 6], lk1[q + 7]); }
                    const bf16x8 af = __builtin_bit_cast(bf16x8, w);
                    const u32x2 a0 = *(LAS const u32x2*)(lds + VS + r32 * P + (16 * kk + 4 * hi) * 2), a1 = *(LAS const u32x2*)(lds + VS + r32 * P + (16 * kk + 8 + 4 * hi) * 2);
                    const u32x2 b0 = *(LAS const u32x2*)(lds + VS + (32 + r32) * P + (16 * kk + 4 * hi) * 2), b1 = *(LAS const u32x2*)(lds + VS + (32 + r32) * P + (16 * kk + 8 + 4 * hi) * 2);
                    const bf16x8 v0 = __builtin_bit_cast(bf16x8, (u32x4){a0.x, a0.y, a1.x, a1.y}), v1 = __builtin_bit_cast(bf16x8, (u32x4){b0.x, b0.y, b1.x, b1.y});
                    oT0 = __builtin_amdgcn_mfma_f32_32x32x16_bf16(v0, af, oT0, 0, 0, 0);
                    oT1 = __builtin_amdgcn_mfma_f32_32x32x16_bf16(v1, af, oT1, 0, 0, 0);
                }
            }
        }
#pragma unroll
        for (int g4 = 0; g4 < 4; ++g4) {
            const int d0 = 8 * g4 + 4 * hi;
            *(u32x2*)(qptr + d0) = (u32x2){cvt_pk_bf16(oT0[4 * g4], oT0[4 * g4 + 1]), cvt_pk_bf16(oT0[4 * g4 + 2], oT0[4 * g4 + 3])};
            *(u32x2*)(qptr + 32 + d0) = (u32x2){cvt_pk_bf16(oT1[4 * g4], oT1[4 * g4 + 1]), cvt_pk_bf16(oT1[4 * g4 + 2], oT1[4 * g4 + 3])};
        }
    }
}

struct Args { const float* in[15]; float* out; unsigned char* ws; };
template <bool gdn> __device__ __forceinline__ void layer_body(const Args& a, const int layer, LAS unsigned char* lds, cg::grid_group& grid) {
#define LB_IDS() int tid = threadIdx.x; asm volatile("" : "+v"(tid)); const int lane = tid & 63, wave = __builtin_amdgcn_readfirstlane(tid >> 6); \
        const int G = gridDim.x, blk = blockIdx.x, gw = blk * 8 + wave, NGW = G * 8; (void)lane; (void)gw; (void)NGW; (void)G; (void)blk;
#define LB_PTRS() bf16_t* Win_t = (bf16_t*)(a.ws + WS_WIN); bf16_t* Wout_t = (bf16_t*)(a.ws + WS_WOUT); bf16_t* Wgu_t = (bf16_t*)(a.ws + WS_WGU); bf16_t* Wdn_t = (bf16_t*)(a.ws + WS_WDN); \
        float* gb = (float*)(a.ws + WS_GB); bf16_t* H = (bf16_t*)(a.ws + WS_H); bf16_t* PROJ = (bf16_t*)(a.ws + WS_PROJ); float* out = a.out; const float* xcur = (layer == 0) ? a.in[0] : a.out; \
        (void)Win_t; (void)Wout_t; (void)Wgu_t; (void)Wdn_t; (void)gb; (void)H; (void)PROJ; (void)out; (void)xcur;
        const int j = layer >> 1;
#ifndef NO_P1
        {
            LB_IDS(); LB_PTRS(); LAS float* scr = (LAS float*)(lds + wave * 16384);
            const float* w_in = gdn ? a.in[1] + (size_t)j * DM * GDN_N : a.in[7] + (size_t)j * DM * 3072;
            const float* w_out = gdn ? a.in[6] + (size_t)j * 2048 * DM : a.in[8] + (size_t)j * DM * DM;
            const int n_in = gdn ? GDN_N : 3072, k_out = gdn ? 2048 : 1024;
            const int I_in = (DM / 64) * (n_in / 32), I_out = (k_out / 64) * (DM / 32), I_g = (DM / 64) * (FF / 32), I_d = (FF / 64) * (DM / 32);
            const float* wg = a.in[11] + (size_t)layer * DM * FF; const float* wu = a.in[12] + (size_t)layer * DM * FF; const float* wd = a.in[13] + (size_t)layer * FF * DM;
            for (int it = gw; it < I_in + I_out + 2 * I_g + I_d; it += NGW) {
                int r = it;
                if (r < I_in) { conv_plain(w_in, DM, n_in, Win_t, r, scr, lane); continue; } r -= I_in;
                if (r < I_out) { conv_plain(w_out, k_out, DM, Wout_t, r, scr, lane); continue; } r -= I_out;
                if (r < I_g) { conv_gu(wg, Wgu_t, r, 0, scr, lane); continue; } r -= I_g;
                if (r < I_g) { conv_gu(wu, Wgu_t, r, 1, scr, lane); continue; } r -= I_g;
                conv_plain(wd, FF, DM, Wdn_t, r, scr, lane);
            }
            norm_rows(xcur, a.in[9] + layer * DM, H, gw, NGW, lane);
        }
#endif
        grid.sync();
        {
            LB_IDS(); LB_PTRS();
            pg8::Gemm g{H, Win_t, M_TOK, gdn ? GDN_NP : 3072, DM, DM}; pg8::StaticOrder S; S.init(M_TOK, g.N, G, blk);
            EpiProj E{PROJ, gdn ? GDN_PITCH : 3072, gdn ? 24 : -1, gb, a.in[3] + j * 16, a.in[4] + j * 16};
#if !defined(NO_GEMM) && !defined(NO_P2)
            pg8::gemm_phase<EpiProj, pg8::StaticOrder, true, true>(lds, g, S, E);
#endif
        }
        grid.sync();
        if constexpr (gdn) {
            LB_IDS(); LB_PTRS();
            const float* convw = a.in[2] + (size_t)j * 4096 * 4;
#ifndef NO_G1
            gdn_g1(lds, PROJ, gb, convw, H, gw, NGW, wave, lane);
#endif
            grid.sync();
#ifndef NO_G2
            gdn_g2(lds, PROJ, gb, convw, a.in[5] + j * 128, H, blk, G, tid, wave, lane);
#endif
        } else {
            LB_IDS(); LB_PTRS();
#ifndef NO_SB
            sb_attn(lds, PROJ, blk, G, tid, wave, lane);
#endif
        }
        grid.sync();
        {
            LB_IDS(); LB_PTRS();
            pg8::Gemm g{gdn ? PROJ + 2048 : PROJ, Wout_t, M_TOK, DM, gdn ? 2048 : 1024, gdn ? GDN_PITCH : 3072}; pg8::StaticOrder S; S.init(M_TOK, DM, G, blk);
            EpiRes E{xcur, out, DM};
#if !defined(NO_GEMM) && !defined(NO_P4)
            pg8::gemm_phase<EpiRes, pg8::StaticOrder, true, true>(lds, g, S, E);
#endif
        }
        grid.sync();
#ifndef NO_P5
        { LB_IDS(); LB_PTRS(); norm_rows(out, a.in[10] + layer * DM, H, gw, NGW, lane); }
#endif
        grid.sync();
        {
            LB_IDS(); LB_PTRS();
            pg8::Gemm g{H, Wgu_t, M_TOK, 2 * FF, DM, DM}; pg8::StaticOrder S; S.init(M_TOK, 2 * FF, G, blk);
            EpiSwiglu E{PROJ, FF};
#if !defined(NO_GEMM) && !defined(NO_P6)
            pg8::gemm_phase<EpiSwiglu, pg8::StaticOrder, true, true>(lds, g, S, E);
#endif
        }
        grid.sync();
        {
            LB_IDS(); LB_PTRS();
            pg8::Gemm g{PROJ, Wdn_t, M_TOK, DM, FF, FF}; pg8::StaticOrder S; S.init(M_TOK, DM, G, blk);
            EpiRes E{out, out, DM};
#if !defined(NO_GEMM) && !defined(NO_P7)
            pg8::gemm_phase<EpiRes, pg8::StaticOrder, true, true>(lds, g, S, E);
#endif
        }
        grid.sync();
}

__global__ void __launch_bounds__(512, 2) fwd(Args a) {
    extern __shared__ __attribute__((aligned(16))) unsigned char lds_raw[];
    LAS unsigned char* lds = (LAS unsigned char*)lds_raw;
    cg::grid_group grid = cg::this_grid();
#ifdef ONE_LAYER
    layer_body<false>(a, 1, lds, grid);
#else
    for (int lp = 0; lp < 2; ++lp) {
        layer_body<true>(a, 2 * lp, lds, grid);
        layer_body<false>(a, 2 * lp + 1, lds, grid);
    }
#endif
#ifndef NO_FINAL
    { int tid = threadIdx.x; asm volatile("" : "+v"(tid)); const int lane = tid & 63, wave = __builtin_amdgcn_readfirstlane(tid >> 6); final_norm_rows(a.out, a.in[14], blockIdx.x * 8 + wave, gridDim.x * 8, lane); }
#endif
}

extern "C" void kernel_launch(void* const* d_in, const int* in_sizes, int n_in, void* d_out, int out_size, void* d_ws, size_t ws_size, hipStream_t stream) {
    static int grid = 0;
    if (grid == 0) {
        if (n_in != 15 || out_size != M_TOK * DM || ws_size < WS_END) { fprintf(stderr, "kernel_launch: unexpected shapes (n_in %d out %d ws %zu)\n", n_in, out_size, ws_size); grid = -1; return; }
        int dev = 0, cus = 0, per_cu = 0;
        hipGetDevice(&dev); hipDeviceGetAttribute(&cus, hipDeviceAttributeMultiprocessorCount, dev);
        hipFuncSetAttribute((const void*)fwd, hipFuncAttributeMaxDynamicSharedMemorySize, LDS_BYTES);
        hipOccupancyMaxActiveBlocksPerMultiprocessor(&per_cu, (const void*)fwd, 512, LDS_BYTES);
        if (per_cu < 1) per_cu = 1;
        grid = cus * per_cu;
        (void)hipGetLastError();
    }
    if (grid < 0) return;
    Args a{};
    for (int i = 0; i < 15; ++i) a.in[i] = (const float*)d_in[i];
    a.out = (float*)d_out; a.ws = (unsigned char*)d_ws;
    void* args[] = {&a};
    hipError_t e = hipLaunchCooperativeKernel((const void*)fwd, dim3(grid), dim3(512), args, LDS_BYTES, stream);
    if (e != hipSuccess) fprintf(stderr, "cooperative launch failed: %s (grid %d)\n", hipGetErrorString(e), grid);
}
```

```cpp
#include <hip/hip_runtime.h>
#include <hip/hip_cooperative_groups.h>
#include <cstdio>
#include <cstdint>
namespace cg = cooperative_groups;
namespace pg8 {
#define PG8_LAS __attribute__((address_space(3)))
typedef unsigned short bf16_t;
typedef short bf16x8 __attribute__((ext_vector_type(8)));
typedef float f32x4 __attribute__((ext_vector_type(4)));
typedef unsigned u32x4 __attribute__((ext_vector_type(4)));
constexpr int BM = 256, BK = 64, HALF = 128, HTB = HALF * BK * 2  , STAGE_BYTES = 8 * HTB, NXCD = 8, WGM = 8;

__host__ __device__ __forceinline__ int lds_byte(int r, int c) { const int st = (r >> 4) * 2 + (c >> 5), rr = r & 15, cc = c & 31, ob = rr * 64 + cc * 2; return st * 1024 + (ob ^ (((ob >> 9) & 1) << 5)); }
__host__ __device__ __forceinline__ void stage_rc(int b, int& R, int& C) { const int st = b / 1024, sb = b % 1024, swz = sb ^ (((sb >> 9) & 1) << 5); R = (st >> 1) * 16 + swz / 64; C = (st & 1) * 32 + (swz % 64) / 2; }
__host__ __device__ __forceinline__ int perm32(int rho) { const int n = rho >> 4, i = rho & 15; return 8 * (i >> 2) + 4 * n + (i & 3); }

struct Unit { int pm, pn; };
struct Gemm { const bf16_t* A; const bf16_t* Bt; int M, N, K, lda; };

struct StaticOrder {
    int nM, nN, nwg, G, c;
    __host__ __device__ void init(int M, int N, int G_, int c_) { nM = M / BM; nN = N / BM; nwg = nM * nN; G = G_; c = c_; }
    __host__ __device__ bool next(int i, Unit& u) const {
        const long L = (long)i * G + c; if (L >= nwg) return false;
        int wgid = (int)L; { const int q = nwg / NXCD, r = nwg % NXCD, xcd = wgid % NXCD, off = wgid / NXCD; wgid = (xcd < r ? xcd * (q + 1) : r * (q + 1) + (xcd - r) * q) + off; }
        const int nig = WGM * nN, gid = wgid / nig, fm = gid * WGM, gsz = (nM - fm) < WGM ? (nM - fm) : WGM;
        u.pm = fm + ((wgid % nig) % gsz); u.pn = (wgid % nig) / gsz; return true;
    }
    __device__ __forceinline__ void a_ready(const Unit&) const {}
    __device__ __forceinline__ void done(const Unit&) const {}
};

__device__ __forceinline__ unsigned cvt_pk_bf16(float lo, float hi) { unsigned r; asm volatile("v_cvt_pk_bf16_f32 %0, %1, %2" : "=v"(r) : "v"(lo), "v"(hi)); return r; }
typedef float f32x2 __attribute__((ext_vector_type(2)));
template <class Epi, class Sched, bool ALIGN_EPI = false, bool SP2 = false>
__device__ __forceinline__ void gemm_phase(PG8_LAS unsigned char* lds, const Gemm g, const Sched& S, const Epi& E) {
    int tid_l = threadIdx.x; asm volatile("" : "+v"(tid_l));
    const int tid = tid_l, wid = __builtin_amdgcn_readfirstlane(tid >> 6), lane = tid & 63, wr = wid >> 2, wc = wid & 3, fr = lane & 15, fq = lane >> 4;
    const int K = g.K, nt = K / BK;
    unsigned voffA[2], voffB[2];
#pragma unroll
    for (int i = 0; i < 2; ++i) { int R, C; stage_rc(tid * 16 + i * 8192, R, C); const int Rb = Epi::PERM ? ((R & ~31) + perm32(R & 31)) : R;
        voffA[i] = (unsigned)(R * g.lda + C) * 2u; voffB[i] = (unsigned)(Rb * K + C) * 2u; }
    const size_t kstep = (size_t)(BK * 2);
    const size_t hstepA = (size_t)HALF * g.lda * 2, hstepB = (size_t)HALF * K * 2;
    const size_t tstepA = 2 * hstepA, tstepB = 2 * hstepB;
    const unsigned ldsw = (unsigned)wid * 1024u;
    const int aoff = lds_byte(wr * 64 + fr, fq * 8), boff = lds_byte(wc * 32 + fr, fq * 8);
#define PG8_SA(b, h) (((b) * 2 + (h)) * HTB)
#define PG8_SB(b, h) ((4 + (b) * 2 + (h)) * HTB)
#define PG8_STAGE(bufoff, gbase, voff) do { _Pragma("unroll") for (int _i = 0; _i < 2; ++_i) \
        __builtin_amdgcn_global_load_lds((const unsigned*)((const char*)(gbase) + (voff)[_i]), (PG8_LAS unsigned*)(lds + (bufoff) + ldsw + _i * 8192), 16, 0, 0); } while (0)
#define PG8_LDA(dst, b, h) do { _Pragma("unroll") for (int m = 0; m < 4; ++m) _Pragma("unroll") for (int k = 0; k < 2; ++k) dst[m][k] = *(const PG8_LAS bf16x8*)(lds + PG8_SA(b, h) + aoff + m * 2048 + k * 1024); } while (0)
#define PG8_LDB(dst, b, h) do { _Pragma("unroll") for (int n = 0; n < 2; ++n) _Pragma("unroll") for (int k = 0; k < 2; ++k) dst[n][k] = *(const PG8_LAS bf16x8*)(lds + PG8_SB(b, h) + boff + n * 2048 + k * 1024); } while (0)
#define PG8_MMA(ai, bj, At, Bt) do { __builtin_amdgcn_s_setprio(1); _Pragma("unroll") for (int m = 0; m < 4; ++m) _Pragma("unroll") for (int n = 0; n < 2; ++n) _Pragma("unroll") for (int k = 0; k < 2; ++k) \
        acc[ai][bj][m][n] = __builtin_amdgcn_mfma_f32_16x16x32_bf16(Bt[n][k], At[m][k], acc[ai][bj][m][n], 0, 0, 0); __builtin_amdgcn_s_setprio(0); } while (0)
#define PG8_WAIT_V(n) asm volatile("s_waitcnt vmcnt(" #n ")" ::: "memory")
#define PG8_WAIT_L(n) asm volatile("s_waitcnt lgkmcnt(" #n ")" ::: "memory")
#define PG8_BAR __builtin_amdgcn_s_barrier()
#define PG8_SCHED __builtin_amdgcn_sched_barrier(0)
    Unit cur, nxt; int ui = 0;
    if (!S.next(0, cur)) return;
    f32x4 acc[2][2][4][2];
#pragma unroll
    for (int a = 0; a < 2; ++a)
#pragma unroll
        for (int b = 0; b < 2; ++b)
#pragma unroll
            for (int m = 0; m < 4; ++m)
#pragma unroll
                for (int n = 0; n < 2; ++n) acc[a][b][m][n] = (f32x4){0.f, 0.f, 0.f, 0.f};
    bf16x8 At[4][2], B0[2][2], B1[2][2];
    const char* cA = (const char*)g.A + (size_t)cur.pm * tstepA; const char* cB = (const char*)g.Bt + (size_t)cur.pn * tstepB;
    S.a_ready(cur);
    if constexpr (SP2) {
        PG8_STAGE(PG8_SB(0, 0), cB, voffB); PG8_STAGE(PG8_SB(0, 1), cB + hstepB, voffB); PG8_STAGE(PG8_SA(0, 0), cA, voffA); PG8_STAGE(PG8_SA(0, 1), cA + hstepA, voffA);
        if (wr == 1) PG8_BAR;
        PG8_WAIT_V(2); PG8_BAR;
        PG8_STAGE(PG8_SB(1, 0), cB + kstep, voffB); PG8_STAGE(PG8_SA(1, 0), cA + kstep, voffA); PG8_STAGE(PG8_SB(1, 1), cB + hstepB + kstep, voffB);
        PG8_WAIT_V(6); PG8_BAR;
    } else {
        PG8_STAGE(PG8_SB(0, 0), cB, voffB); PG8_STAGE(PG8_SA(0, 0), cA, voffA); PG8_STAGE(PG8_SB(0, 1), cB + hstepB, voffB); PG8_STAGE(PG8_SA(0, 1), cA + hstepA, voffA);
        if (wr == 1) PG8_BAR;
        PG8_WAIT_V(4); PG8_BAR;
        PG8_STAGE(PG8_SB(1, 0), cB + kstep, voffB); PG8_STAGE(PG8_SA(1, 0), cA + kstep, voffA); PG8_STAGE(PG8_SB(1, 1), cB + hstepB + kstep, voffB);
        PG8_WAIT_V(6); PG8_BAR;
    }
    for (;;) {
        const bool has_next = S.next(ui + 1, nxt);
        const char* nA = has_next ? (const char*)g.A + (size_t)nxt.pm * tstepA : cA; const char* nB = has_next ? (const char*)g.Bt + (size_t)nxt.pn * tstepB : cB;
        for (int t = 0; t < nt; t += 2) {
            const bool last = (t == nt - 2);
            const char* a1 = cA + (size_t)(t + 1) * kstep;
            const char* a2 = last ? nA : cA + (size_t)(t + 2) * kstep; const char* b2 = last ? nB : cB + (size_t)(t + 2) * kstep;
            const char* a3 = a2 + kstep; const char* b3 = b2 + kstep;
            if (last && has_next) S.a_ready(nxt);
            if constexpr (SP2) {
            PG8_LDB(B0, 0, 0); PG8_LDB(B1, 0, 1); PG8_SCHED; PG8_LDA(At, 0, 0); PG8_STAGE(PG8_SA(1, 1), a1 + hstepA, voffA);
            PG8_WAIT_V(8); PG8_WAIT_L(0); PG8_BAR; PG8_MMA(0, 0, At, B0); PG8_MMA(0, 1, At, B1); PG8_BAR; PG8_SCHED;
            PG8_LDA(At, 0, 1); PG8_STAGE(PG8_SB(0, 0), b2, voffB); PG8_STAGE(PG8_SB(0, 1), b2 + hstepB, voffB); PG8_STAGE(PG8_SA(0, 0), a2, voffA);
            PG8_WAIT_V(8); PG8_WAIT_L(0); PG8_BAR; PG8_MMA(1, 0, At, B0); PG8_MMA(1, 1, At, B1); PG8_BAR; PG8_SCHED;
            PG8_LDB(B0, 1, 0); PG8_LDB(B1, 1, 1); PG8_SCHED; PG8_LDA(At, 1, 0); PG8_STAGE(PG8_SA(0, 1), a2 + hstepA, voffA);
            PG8_WAIT_V(8); PG8_WAIT_L(0); PG8_BAR; PG8_MMA(0, 0, At, B0); PG8_MMA(0, 1, At, B1); PG8_BAR; PG8_SCHED;
            PG8_LDA(At, 1, 1); PG8_STAGE(PG8_SB(1, 0), b3, voffB); PG8_STAGE(PG8_SB(1, 1), b3 + hstepB, voffB); PG8_STAGE(PG8_SA(1, 0), a3, voffA);
            PG8_WAIT_V(8); PG8_WAIT_L(0); PG8_BAR; PG8_MMA(1, 0, At, B0); PG8_MMA(1, 1, At, B1); PG8_BAR; PG8_SCHED;
            } else {
            PG8_LDB(B0, 0, 0); PG8_SCHED; PG8_LDA(At, 0, 0); PG8_STAGE(PG8_SA(1, 1), a1 + hstepA, voffA);
            PG8_WAIT_L(8); PG8_BAR; PG8_WAIT_L(0); PG8_MMA(0, 0, At, B0); PG8_BAR; PG8_SCHED;
            PG8_LDB(B1, 0, 1); PG8_STAGE(PG8_SB(0, 0), b2, voffB);
            PG8_BAR; PG8_WAIT_L(0); PG8_MMA(0, 1, At, B1); PG8_BAR;
            PG8_LDA(At, 0, 1); PG8_STAGE(PG8_SA(0, 0), a2, voffA);
            PG8_BAR; PG8_WAIT_L(0); PG8_MMA(1, 0, At, B0); PG8_BAR; PG8_SCHED;
            PG8_STAGE(PG8_SB(0, 1), b2 + hstepB, voffB);
            PG8_WAIT_V(6); PG8_BAR; PG8_MMA(1, 1, At, B1); PG8_BAR;
            PG8_LDB(B0, 1, 0); PG8_SCHED; PG8_LDA(At, 1, 0); PG8_STAGE(PG8_SA(0, 1), a2 + hstepA, voffA);
            PG8_WAIT_L(8); PG8_BAR; PG8_WAIT_L(0); PG8_MMA(0, 0, At, B0); PG8_BAR; PG8_SCHED;
            PG8_LDB(B1, 1, 1); PG8_STAGE(PG8_SB(1, 0), b3, voffB);
            PG8_BAR; PG8_WAIT_L(0); PG8_MMA(0, 1, At, B1); PG8_BAR;
            PG8_LDA(At, 1, 1); PG8_STAGE(PG8_SA(1, 0), a3, voffA);
            PG8_BAR; PG8_WAIT_L(0); PG8_MMA(1, 0, At, B0); PG8_BAR; PG8_SCHED;
            PG8_STAGE(PG8_SB(1, 1), b3 + hstepB, voffB);
            PG8_WAIT_V(6); PG8_BAR; PG8_MMA(1, 1, At, B1); PG8_BAR;
            }
        }
        if constexpr (ALIGN_EPI) { if (wr == 0) PG8_BAR; }
        if constexpr (!Epi::AFTER_DRAIN) { E(acc, cur, wr, wc, fr, fq); S.done(cur); }
        if (!has_next) break;
#pragma unroll
        for (int a = 0; a < 2; ++a)
#pragma unroll
            for (int b = 0; b < 2; ++b)
#pragma unroll
                for (int m = 0; m < 4; ++m)
#pragma unroll
                    for (int n = 0; n < 2; ++n) acc[a][b][m][n] = (f32x4){0.f, 0.f, 0.f, 0.f};
        cur = nxt; cA = nA; cB = nB; ++ui;
        if constexpr (ALIGN_EPI) { if (wr == 1) PG8_BAR; }
    }
    PG8_WAIT_V(0);
    if constexpr (!ALIGN_EPI) { if (wr == 0) PG8_BAR; }
    PG8_BAR;
    if constexpr (Epi::AFTER_DRAIN) { E.fused(acc, cur, wr, wc, fr, fq, lds, wid, lane); S.done(cur); }
#undef PG8_SA
#undef PG8_SB
#undef PG8_STAGE
#undef PG8_LDA
#undef PG8_LDB
#undef PG8_MMA
#undef PG8_WAIT_V
#undef PG8_WAIT_L
#undef PG8_BAR
#undef PG8_SCHED
}
}

constexpr int M_TOK = 32768, DM = 1024, SEQ = 4096, NB = 8;
constexpr int GDN_N = 6176, GDN_NP = 6400, GDN_PITCH = 6144, FF = 2816;
constexpr float EPS = 1e-6f;
#define LAS __attribute__((address_space(3)))
typedef unsigned short bf16_t;
typedef short bf16x8 __attribute__((ext_vector_type(8)));
typedef float f32x4 __attribute__((ext_vector_type(4)));
typedef float f32x16 __attribute__((ext_vector_type(16)));
typedef unsigned u32x4 __attribute__((ext_vector_type(4)));
typedef unsigned u32x2 __attribute__((ext_vector_type(2)));
using pg8::cvt_pk_bf16;

constexpr size_t MiB = 1u << 20;
constexpr size_t WS_WIN = 1 * MiB, WS_WOUT = 14 * MiB, WS_WGU = 18 * MiB, WS_WDN = 29 * MiB, WS_GB = 36 * MiB, WS_H = 40 * MiB, WS_PROJ = 104 * MiB, WS_END = 488 * MiB;
constexpr int LDS_BYTES = 147456;

__device__ __forceinline__ float bf2f(unsigned short b) { return __uint_as_float(((unsigned)b) << 16); }
__device__ __forceinline__ float bflo(unsigned u) { return __uint_as_float(u << 16); }
__device__ __forceinline__ float bfhi(unsigned u) { return __uint_as_float(u & 0xffff0000u); }
__device__ __forceinline__ float wave_sum(float v) {
#pragma unroll
    for (int o = 1; o < 64; o <<= 1) v += __shfl_xor(v, o);
    return v;
}
__device__ __forceinline__ float silu_f(float v) { return v * __builtin_amdgcn_rcpf(1.f + __expf(-v)); }
__device__ __forceinline__ float softplus_f(float x) { return fmaxf(x, 0.f) + __logf(1.f + __expf(-fabsf(x))); }

struct EpiProj {
    static constexpr bool PERM = true, AFTER_DRAIN = false;
    bf16_t* O; int ldc; int gate_tile; float* gb; const float* a_log; const float* dt_bias; int scale_tiles; float scale;
    __device__ __forceinline__ void operator()(const f32x4 (&acc)[2][2][4][2], const pg8::Unit& u, int wr, int wc, int fr, int fq) const {
        const int row0 = u.pm * 256 + wr * 64 + fr;
        if (u.pn == gate_tile) {
            if (wc == 0) {
                const int c0 = 8 * fq;
#pragma unroll
                for (int ai = 0; ai < 2; ++ai)
#pragma unroll
                    for (int m = 0; m < 4; ++m) {
                        const int row = row0 + ai * 128 + m * 16;
#pragma unroll
                        for (int n = 0; n < 2; ++n) {
                            const f32x4 v = acc[ai][0][m][n]; f32x4 o;
                            const int c = c0 + 4 * n;
                            if (fq < 2) {
#pragma unroll
                                for (int j = 0; j < 4; ++j) o[j] = 1.f / (1.f + __expf(-v[j]));
                            } else {
                                const f32x4 al = *(const f32x4*)(a_log + c - 16), db = *(const f32x4*)(dt_bias + c - 16);
#pragma unroll
                                for (int j = 0; j < 4; ++j) o[j] = -__expf(al[j]) * softplus_f(v[j] + db[j]);
                            }
                            *(f32x4*)(gb + (size_t)row * 32 + c) = o;
                        }
                    }
            }
            return;
        }
        const int col0 = u.pn * 256 + wc * 32 + 8 * fq;
        const float sc = (u.pn < scale_tiles) ? scale : 1.f;
#pragma unroll
        for (int ai = 0; ai < 2; ++ai)
#pragma unroll
            for (int m = 0; m < 4; ++m) { bf16_t* rowp = O + (size_t)(row0 + ai * 128 + m * 16) * ldc + col0;
#pragma unroll
                for (int bj = 0; bj < 2; ++bj) { const f32x4 v0 = acc[ai][bj][m][0] * sc, v1 = acc[ai][bj][m][1] * sc;
                    u32x4 w; w.x = cvt_pk_bf16(v0[0], v0[1]); w.y = cvt_pk_bf16(v0[2], v0[3]); w.z = cvt_pk_bf16(v1[0], v1[1]); w.w = cvt_pk_bf16(v1[2], v1[3]);
                    *(u32x4*)(rowp + bj * 128) = w; } }
    }
};
struct EpiSwiglu {
    static constexpr bool PERM = true, AFTER_DRAIN = false;
    bf16_t* O; int ldc;
    __device__ __forceinline__ void operator()(const f32x4 (&acc)[2][2][4][2], const pg8::Unit& u, int wr, int wc, int fr, int fq) const {
        const int row0 = u.pm * 256 + wr * 64 + fr, col0 = u.pn * 128 + wc * 32 + 8 * fq;
#pragma unroll
        for (int ai = 0; ai < 2; ++ai)
#pragma unroll
            for (int m = 0; m < 4; ++m) { bf16_t* rowp = O + (size_t)(row0 + ai * 128 + m * 16) * ldc + col0;
                float r[8];
#pragma unroll
                for (int n = 0; n < 2; ++n)
#pragma unroll
                    for (int j = 0; j < 4; ++j) { const float g = acc[ai][0][m][n][j], up = acc[ai][1][m][n][j]; r[4 * n + j] = silu_f(g) * up; }
                u32x4 w; w.x = cvt_pk_bf16(r[0], r[1]); w.y = cvt_pk_bf16(r[2], r[3]); w.z = cvt_pk_bf16(r[4], r[5]); w.w = cvt_pk_bf16(r[6], r[7]);
                *(u32x4*)rowp = w; }
    }
};
struct EpiRes {
    static constexpr bool PERM = false, AFTER_DRAIN = false;
    const float* base; float* out; int ldc;
    __device__ __forceinline__ void operator()(const f32x4 (&acc)[2][2][4][2], const pg8::Unit& u, int wr, int wc, int fr, int fq) const {
        const int row0 = u.pm * 256 + wr * 64 + fr, col0 = u.pn * 256 + wc * 32 + 4 * fq;
#pragma unroll
        for (int ai = 0; ai < 2; ++ai)
#pragma unroll
            for (int m = 0; m < 4; ++m) { const size_t off = (size_t)(row0 + ai * 128 + m * 16) * ldc + col0;
#pragma unroll
                for (int bj = 0; bj < 2; ++bj)
#pragma unroll
                    for (int n = 0; n < 2; ++n) { const f32x4 b = *(const f32x4*)(base + off + bj * 128 + n * 16); *(f32x4*)(out + off + bj * 128 + n * 16) = b + acc[ai][bj][m][n]; } }
    }
};

__device__ __forceinline__ unsigned f2bf(float f) { unsigned u = __float_as_uint(f); return (u + 0x7fffu + ((u >> 16) & 1u)) >> 16; }
__device__ __forceinline__ unsigned pk2(float lo, float hi) { return f2bf(lo) | (f2bf(hi) << 16); }
__device__ __forceinline__ void transpose_item(const float* W, int K, int N, bf16_t* WT, int k0, int n0, int drow0, LAS float* scr, int lane) {
#pragma unroll 8
    for (int i = 0; i < 32; ++i) { const int kk = 2 * i + (lane >> 5); scr[kk * 33 + (lane & 31)] = W[(size_t)(k0 + kk) * N + n0 + (lane & 31)]; }
    asm volatile("s_waitcnt lgkmcnt(0)" ::: "memory");
    const int c = lane & 7;
#pragma unroll
    for (int j = 0; j < 4; ++j) { const int n = (lane >> 3) + 8 * j; const LAS float* s = scr + (8 * c) * 33 + n;
        u32x4 o; o.x = pk2(s[0 * 33], s[1 * 33]); o.y = pk2(s[2 * 33], s[3 * 33]); o.z = pk2(s[4 * 33], s[5 * 33]); o.w = pk2(s[6 * 33], s[7 * 33]);
        *(u32x4*)(WT + (size_t)(drow0 + n) * K + k0 + 8 * c) = o; }
    asm volatile("s_waitcnt lgkmcnt(0)" ::: "memory");
}
__device__ __forceinline__ void conv_plain(const float* W, int K, int N, bf16_t* WT, int item, LAS float* scr, int lane) {
    const int nblk = N / 32, kb = item / nblk, nb = item % nblk;
    transpose_item(W, K, N, WT, 64 * kb, 32 * nb, 32 * nb, scr, lane);
}
__device__ __forceinline__ void conv_gu(const float* W, bf16_t* WT, int item, int up, LAS float* scr, int lane) {
    const int nblk = FF / 32, kb = item / nblk, nb = item % nblk, n0 = 32 * nb;
    transpose_item(W, DM, FF, WT, 64 * kb, n0, (n0 >> 7) * 256 + (n0 & 127) + up * 128, scr, lane);
}
__device__ __forceinline__ void norm_rows(const float* x, const float* w, bf16_t* h, int gw, int NGW, int lane) {
    asm volatile("" : "+v"(lane));
    f32x4 wv[4];
#pragma unroll
    for (int j = 0; j < 4; ++j) wv[j] = *((const f32x4*)w + lane + 64 * j);
    for (int m = gw; m < M_TOK; m += NGW) {
        const f32x4* xr = (const f32x4*)(x + (size_t)m * DM) + lane; f32x4 v[4]; float s = 0.f;
#pragma unroll
        for (int j = 0; j < 4; ++j) { v[j] = xr[64 * j]; s += (v[j].x * v[j].x + v[j].y * v[j].y) + (v[j].z * v[j].z + v[j].w * v[j].w); }
        const float rstd = 1.f / sqrtf(wave_sum(s) * (1.f / DM) + EPS);
        u32x2* o8 = (u32x2*)(h + (size_t)m * DM) + lane;
#pragma unroll
        for (int j = 0; j < 4; ++j) { const f32x4 o = v[j] * rstd * wv[j]; u32x2 p; p.x = cvt_pk_bf16(o.x, o.y); p.y = cvt_pk_bf16(o.z, o.w); o8[64 * j] = p; }
    }
}
__device__ __forceinline__ void final_norm_rows(float* x, const float* w, int gw, int NGW, int lane) {
    f32x4 wv[4];
#pragma unroll
    for (int j = 0; j < 4; ++j) wv[j] = *((const f32x4*)w + lane + 64 * j);
    for (int m = gw; m < M_TOK; m += NGW) {
        f32x4* xr = (f32x4*)(x + (size_t)m * DM) + lane; f32x4 v[4]; float s = 0.f;
#pragma unroll
        for (int j = 0; j < 4; ++j) { v[j] = xr[64 * j]; s += (v[j].x * v[j].x + v[j].y * v[j].y) + (v[j].z * v[j].z + v[j].w * v[j].w); }
        const float rstd = 1.f / sqrtf(wave_sum(s) * (1.f / DM) + EPS);
#pragma unroll
        for (int j = 0; j < 4; ++j) xr[64 * j] = v[j] * rstd * wv[j];
    }
}

__device__ __forceinline__ int crow(int r, int hi) { return (r & 3) + 8 * (r >> 2) + 4 * hi; }

__device__ __forceinline__ void gdn_g1(LAS unsigned char* lds, const bf16_t* __restrict__ proj, const float* __restrict__ gb, const float* __restrict__ convw,
                                        bf16_t* __restrict__ Tbuf, int gw, int NGW, int wave, int lane) {
    asm volatile("" : "+v"(lane));
    LAS float* Lw = (LAS float*)(lds + wave * 16384);
    LAS float* aux = (LAS float*)(lds + 131072 + wave * 1024);
    const int r32 = lane & 31, hi = lane >> 5;
    for (int u = gw; u < NB * 64 * 16; u += NGW) {
        const int hv = u & 15, chunk = (u >> 4) & 63, b = u >> 10, hq = hv >> 1;
        const size_t rowb = (size_t)b * SEQ + chunk * 64;
        {
            float g = gb[(rowb + lane) * 32 + 16 + hv]; const float bt = gb[(rowb + lane) * 32 + hv];
#pragma unroll
            for (int o = 1; o < 64; o <<= 1) { const float t = __shfl_up(g, o); if (lane >= o) g += t; }
            aux[lane] = g; aux[64 + lane] = bt;
        }
        float ss[2] = {0.f, 0.f};
        f32x16 a00 = {}, a10 = {}, a11 = {};
#pragma unroll 1
        for (int kk = 0; kk < 8; ++kk) {
            const int cb = 1024 + hq * 128 + 16 * kk + 8 * hi;
            f32x4 w[8];
#pragma unroll
            for (int e = 0; e < 8; ++e) w[e] = *(const f32x4*)(convw + (size_t)(cb + e) * 4);
            bf16x8 kf[2];
#pragma unroll
            for (int ti = 0; ti < 2; ++ti) {
                const int t = 32 * ti + r32, tin = chunk * 64 + t;
                const bf16_t* p = proj + (rowb + t) * GDN_PITCH + cb;
                u32x4 x3 = *(const u32x4*)p, x2 = {0, 0, 0, 0}, x1 = {0, 0, 0, 0}, x0 = {0, 0, 0, 0};
                if (tin >= 1) x2 = *(const u32x4*)(p - GDN_PITCH);
                if (tin >= 2) x1 = *(const u32x4*)(p - 2 * GDN_PITCH);
                if (tin >= 3) x0 = *(const u32x4*)(p - 3 * GDN_PITCH);
                float o[8];
#pragma unroll
                for (int e2 = 0; e2 < 4; ++e2) {
                    const float c0 = bflo(x0[e2]) * w[2 * e2][0] + bflo(x1[e2]) * w[2 * e2][1] + bflo(x2[e2]) * w[2 * e2][2] + bflo(x3[e2]) * w[2 * e2][3];
                    const float c1 = bfhi(x0[e2]) * w[2 * e2 + 1][0] + bfhi(x1[e2]) * w[2 * e2 + 1][1] + bfhi(x2[e2]) * w[2 * e2 + 1][2] + bfhi(x3[e2]) * w[2 * e2 + 1][3];
                    o[2 * e2] = silu_f(c0); o[2 * e2 + 1] = silu_f(c1);
                    ss[ti] += o[2 * e2] * o[2 * e2] + o[2 * e2 + 1] * o[2 * e2 + 1];
                }
                u32x4 pk; pk.x = cvt_pk_bf16(o[0], o[1]); pk.y = cvt_pk_bf16(o[2], o[3]); pk.z = cvt_pk_bf16(o[4], o[5]); pk.w = cvt_pk_bf16(o[6], o[7]);
                kf[ti] = __builtin_bit_cast(bf16x8, pk);
            }
            a00 = __builtin_amdgcn_mfma_f32_32x32x16_bf16(kf[0], kf[0], a00, 0, 0, 0);
            a10 = __builtin_amdgcn_mfma_f32_32x32x16_bf16(kf[1], kf[0], a10, 0, 0, 0);
            a11 = __builtin_amdgcn_mfma_f32_32x32x16_bf16(kf[1], kf[1], a11, 0, 0, 0);
        }
#pragma unroll
        for (int ti = 0; ti < 2; ++ti) { ss[ti] += __shfl_xor(ss[ti], 32); if (hi == 0) aux[128 + 32 * ti + r32] = __builtin_amdgcn_rsqf(ss[ti] + EPS); }
        asm volatile("s_waitcnt lgkmcnt(0)" ::: "memory");
        {
            const float gcj0 = aux[r32], gcj1 = aux[32 + r32], rnj0 = aux[128 + r32], rnj1 = aux[160 + r32];
#pragma unroll
            for (int r = 0; r < 16; ++r) {
                const int i0 = crow(r, hi), i1 = 32 + i0;
                const float gi0 = aux[i0], gi1 = aux[i1], bi0 = aux[64 + i0], bi1 = aux[64 + i1], ri0 = aux[128 + i0], ri1 = aux[128 + i1];
                Lw[i0 * 64 + r32] = (i0 > r32) ? bi0 * ri0 * rnj0 * a00[r] * __expf(gi0 - gcj0) : 0.f;
                Lw[i1 * 64 + r32] = bi1 * ri1 * rnj0 * a10[r] * __expf(gi1 - gcj0);
                Lw[i1 * 64 + 32 + r32] = (i0 > r32) ? bi1 * ri1 * rnj1 * a11[r] * __expf(gi1 - gcj1) : 0.f;
            }
        }
        asm volatile("s_waitcnt lgkmcnt(0)" ::: "memory");
        float X[64];
#pragma unroll
        for (int i = 0; i < 64; ++i) {
            float xi = (lane == i) ? 1.f : 0.f, xj = 0.f;
#pragma unroll
            for (int g4 = 0; g4 < (i + 3) / 4; ++g4) {
                const f32x4 l = *(const LAS f32x4*)(Lw + i * 64 + 4 * g4);
#pragma unroll
                for (int e = 0; e < 4; ++e) { const int j = 4 * g4 + e; if (j < i) { if (j & 1) xj -= l[e] * X[j]; else xi -= l[e] * X[j]; } }
            }
            X[i] = xi + xj;
            asm volatile("" ::: "memory");
        }
        bf16_t* To = Tbuf + (size_t)((b * 16 + hv) * 64 + chunk) * 4096 + lane;
#pragma unroll
        for (int i = 0; i < 64; ++i) To[i * 64] = (bf16_t)f2bf(X[i]);
        asm volatile("s_waitcnt lgkmcnt(0)" ::: "memory");
    }
}

namespace g2 {
constexpr int QN = 0, KN = 18432, KNT = 35840, VT = 54272, RT = 72704, ST = 91136, TL = 125952, ATT = 135168, AUX = 144384;
constexpr int P128 = 272, P64 = 144;
__device__ __forceinline__ f32x16 mma(f32x16 acc, LAS const unsigned char* A, int ap, LAS const unsigned char* B, int bp, int nk, int r32, int hi) {
    LAS const unsigned char* a = A + r32 * ap + 16 * hi; LAS const unsigned char* b = B + r32 * bp + 16 * hi;
#pragma unroll
    for (int kk = 0; kk < 8; ++kk) if (kk < nk) {
        const bf16x8 av = *(LAS const bf16x8*)(a + 32 * kk), bv = *(LAS const bf16x8*)(b + 32 * kk);
        acc = __builtin_amdgcn_mfma_f32_32x32x16_bf16(av, bv, acc, 0, 0, 0);
    }
    return acc;
}
}
__device__ __forceinline__ void gdn_g2(LAS unsigned char* lds, bf16_t* proj, const float* __restrict__ gb, const float* __restrict__ convw, const float* __restrict__ normw,
                                        const bf16_t* __restrict__ Tbuf, int unit0, int ustride, int tid, int wave, int lane) {
    using namespace g2;
    asm volatile("" : "+v"(lane), "+v"(tid));
    const int r32 = lane & 31, hi = lane >> 5, ti = wave & 1, tj = wave >> 1;
    LAS float* aux = (LAS float*)(lds + AUX);
    LAS unsigned* halo = (LAS unsigned*)(lds + AUX + 1088);
    for (int unit = unit0; unit < NB * 16; unit += ustride) {
        const int b = unit >> 4, hv = unit & 15, hq = hv >> 1;
        const int colq = hq * 128 + 2 * lane, colk = 1024 + colq, colv = 2048 + hv * 128 + 2 * lane, colz = 4096 + hv * 128 + 2 * lane;
        f32x4 wq[2], wk[2], wv[2];
#pragma unroll
        for (int c = 0; c < 2; ++c) { wq[c] = *(const f32x4*)(convw + (size_t)(colq + c) * 4); wk[c] = *(const f32x4*)(convw + (size_t)(colk + c) * 4); wv[c] = *(const f32x4*)(convw + (size_t)(colv + c) * 4); }
        const float nw0 = normw[2 * lane], nw1 = normw[2 * lane + 1];
        f32x16 S0 = {}, S1 = {};
        for (int i = tid; i < 34816 / 4; i += 512) ((LAS unsigned*)(lds + ST))[i] = 0u;
        for (int chunk = 0; chunk < 64; ++chunk) {
            const size_t rowb = (size_t)b * SEQ + chunk * 64;
            {
                unsigned xq[11], xk[11], xv[11];
#pragma unroll
                for (int j = 0; j < 11; ++j) {
                    const int t = 8 * wave - 3 + j;
                    const bool ok = (chunk * 64 + t) >= 0;
                    const bf16_t* p = proj + (size_t)((long)rowb + t) * GDN_PITCH;
                    xq[j] = ok ? *(const unsigned*)(p + colq) : 0u;
                    xk[j] = ok ? *(const unsigned*)(p + colk) : 0u;
                    if (t >= 0) xv[j] = *(const unsigned*)(p + colv);
                    else xv[j] = (chunk > 0) ? halo[((chunk & 1) * 3 + (t + 3)) * 64 + lane] : 0u;
                }
                if (wave == 7) {
#pragma unroll
                    for (int j = 0; j < 3; ++j) halo[((((chunk + 1) & 1)) * 3 + j) * 64 + lane] = xv[8 + j];
                }
                asm volatile("" ::: "memory");
                {
#pragma unroll
                    for (int r = 0; r < 8; ++r) {
                        float q0 = bflo(xq[r]) * wq[0][0] + bflo(xq[r + 1]) * wq[0][1] + bflo(xq[r + 2]) * wq[0][2] + bflo(xq[r + 3]) * wq[0][3];
                        float q1 = bfhi(xq[r]) * wq[1][0] + bfhi(xq[r + 1]) * wq[1][1] + bfhi(xq[r + 2]) * wq[1][2] + bfhi(xq[r + 3]) * wq[1][3];
                        q0 = silu_f(q0); q1 = silu_f(q1);
                        const float rq = 0.08838834764831845f / sqrtf(wave_sum(q0 * q0 + q1 * q1) + EPS);
                        *(LAS unsigned*)(lds + QN + (8 * wave + r) * P128 + 4 * lane) = cvt_pk_bf16(q0 * rq, q1 * rq);
                    }
                }
                asm volatile("" ::: "memory");
                {
                    float k0[8], k1[8];
#pragma unroll
                    for (int r = 0; r < 8; ++r) {
                        float a0 = bflo(xk[r]) * wk[0][0] + bflo(xk[r + 1]) * wk[0][1] + bflo(xk[r + 2]) * wk[0][2] + bflo(xk[r + 3]) * wk[0][3];
                        float a1 = bfhi(xk[r]) * wk[1][0] + bfhi(xk[r + 1]) * wk[1][1] + bfhi(xk[r + 2]) * wk[1][2] + bfhi(xk[r + 3]) * wk[1][3];
                        a0 = silu_f(a0); a1 = silu_f(a1);
                        const float rk = 1.f / sqrtf(wave_sum(a0 * a0 + a1 * a1) + EPS);
                        k0[r] = a0 * rk; k1[r] = a1 * rk;
                        *(LAS unsigned*)(lds + KN + (8 * wave + r) * P128 + 4 * lane) = cvt_pk_bf16(k0[r], k1[r]);
                    }
                    *(LAS u32x4*)(lds + KNT + (2 * lane) * P64 + 16 * wave) = (u32x4){cvt_pk_bf16(k0[0], k0[1]), cvt_pk_bf16(k0[2], k0[3]), cvt_pk_bf16(k0[4], k0[5]), cvt_pk_bf16(k0[6], k0[7])};
                    *(LAS u32x4*)(lds + KNT + (2 * lane + 1) * P64 + 16 * wave) = (u32x4){cvt_pk_bf16(k1[0], k1[1]), cvt_pk_bf16(k1[2], k1[3]), cvt_pk_bf16(k1[4], k1[5]), cvt_pk_bf16(k1[6], k1[7])};
                }
                asm volatile("" ::: "memory");
                {
                    float v0[8], v1[8];
#pragma unroll
                    for (int r = 0; r < 8; ++r) {
                        const float a0 = bflo(xv[r]) * wv[0][0] + bflo(xv[r + 1]) * wv[0][1] + bflo(xv[r + 2]) * wv[0][2] + bflo(xv[r + 3]) * wv[0][3];
                        const float a1 = bfhi(xv[r]) * wv[1][0] + bfhi(xv[r + 1]) * wv[1][1] + bfhi(xv[r + 2]) * wv[1][2] + bfhi(xv[r + 3]) * wv[1][3];
                        v0[r] = silu_f(a0); v1[r] = silu_f(a1);
                    }
                    *(LAS u32x4*)(lds + VT + (2 * lane) * P64 + 16 * wave) = (u32x4){cvt_pk_bf16(v0[0], v0[1]), cvt_pk_bf16(v0[2], v0[3]), cvt_pk_bf16(v0[4], v0[5]), cvt_pk_bf16(v0[6], v0[7])};
                    *(LAS u32x4*)(lds + VT + (2 * lane + 1) * P64 + 16 * wave) = (u32x4){cvt_pk_bf16(v1[0], v1[1]), cvt_pk_bf16(v1[2], v1[3]), cvt_pk_bf16(v1[4], v1[5]), cvt_pk_bf16(v1[6], v1[7])};
                }
                asm volatile("" ::: "memory");
                if (wave == 0) {
                    float g = gb[(rowb + lane) * 32 + 16 + hv]; const float bt = gb[(rowb + lane) * 32 + hv];
#pragma unroll
                    for (int o = 1; o < 64; o <<= 1) { const float t = __shfl_up(g, o); if (lane >= o) g += t; }
                    const float gl = __shfl(g, 63);
                    aux[lane] = g; aux[64 + lane] = bt; aux[128 + lane] = __expf(g); aux[192 + lane] = __expf(gl - g);
                    if (lane == 0) aux[256] = __expf(gl);
                }
                {
                    const int row = tid >> 3, ch = tid & 7;
                    const u32x4 tv = *(const u32x4*)(Tbuf + (size_t)((b * 16 + hv) * 64 + chunk) * 4096 + row * 64 + ch * 8);
                    *(LAS u32x4*)(lds + TL + row * P64 + ch * 16) = tv;
                }
            }
            __syncthreads();
            if (wave < 4) {
                const int si = wave & 1, tq = wave >> 1;
                f32x16 p = {};
                p = mma(p, lds + KN + 32 * si * P128, P128, lds + QN + 32 * tq * P128, P128, 8, r32, hi);
                const int t = 32 * tq + r32; const float gt = aux[t];
#pragma unroll
                for (int g4 = 0; g4 < 4; ++g4) {
                    float a[4];
#pragma unroll
                    for (int e = 0; e < 4; ++e) { const int s = 32 * si + 8 * g4 + 4 * hi + e; a[e] = (s <= t) ? p[4 * g4 + e] * __expf(gt - aux[s]) : 0.f; }
                    *(LAS u32x2*)(lds + ATT + t * P64 + (32 * si + 8 * g4 + 4 * hi) * 2) = (u32x2){cvt_pk_bf16(a[0], a[1]), cvt_pk_bf16(a[2], a[3])};
                }
            }
            f32x16 o1 = {};
            {
                f32x16 acc = {};
                acc = mma(acc, lds + KN + 32 * ti * P128, P128, lds + ST + 32 * tj * P128, P128, 8, r32, hi);
                o1 = mma(o1, lds + QN + 32 * ti * P128, P128, lds + ST + 32 * tj * P128, P128, 8, r32, hi);
                const int dv = 32 * tj + r32;
#pragma unroll
                for (int g4 = 0; g4 < 4; ++g4) {
                    const int t0 = 32 * ti + 8 * g4 + 4 * hi;
                    const u32x2 vv = *(LAS const u32x2*)(lds + VT + dv * P64 + t0 * 2);
                    const float v4[4] = {bflo(vv.x), bfhi(vv.x), bflo(vv.y), bfhi(vv.y)};
                    float rr[4];
#pragma unroll
                    for (int e = 0; e < 4; ++e) { const float eg = aux[128 + t0 + e]; rr[e] = aux[64 + t0 + e] * (v4[e] - eg * acc[4 * g4 + e]); o1[4 * g4 + e] *= eg; }
                    *(LAS u32x2*)(lds + RT + dv * P64 + t0 * 2) = (u32x2){cvt_pk_bf16(rr[0], rr[1]), cvt_pk_bf16(rr[2], rr[3])};
                }
            }
            __syncthreads();
            {
                f32x16 acc = {};
                acc = mma(acc, lds + TL + 32 * ti * P64, P64, lds + RT + 32 * tj * P64, P64, 4, r32, hi);
                const int dv = 32 * tj + r32;
#pragma unroll
                for (int g4 = 0; g4 < 4; ++g4) {
                    const int t0 = 32 * ti + 8 * g4 + 4 * hi;
                    float s4[4];
#pragma unroll
                    for (int e = 0; e < 4; ++e) s4[e] = acc[4 * g4 + e] * aux[192 + t0 + e];
                    *(LAS u32x2*)(lds + VT + dv * P64 + t0 * 2) = (u32x2){cvt_pk_bf16(acc[4 * g4], acc[4 * g4 + 1]), cvt_pk_bf16(acc[4 * g4 + 2], acc[4 * g4 + 3])};
                    *(LAS u32x2*)(lds + QN + dv * P64 + t0 * 2) = (u32x2){cvt_pk_bf16(s4[0], s4[1]), cvt_pk_bf16(s4[2], s4[3])};
                }
            }
            __syncthreads();
            {
                o1 = mma(o1, lds + ATT + 32 * ti * P64, P64, lds + VT + 32 * tj * P64, P64, 4, r32, hi);
                const int dv = 32 * tj + r32;
#pragma unroll
                for (int r = 0; r < 16; ++r) { const int t = 32 * ti + crow(r, hi); *(LAS unsigned short*)(lds + RT + t * P128 + dv * 2) = (unsigned short)f2bf(o1[r]); }
                const float egl = aux[256];
                S0 = S0 * egl; S1 = S1 * egl;
                S0 = mma(S0, lds + KNT + 32 * (2 * ti) * P64, P64, lds + QN + 32 * tj * P64, P64, 4, r32, hi);
                S1 = mma(S1, lds + KNT + 32 * (2 * ti + 1) * P64, P64, lds + QN + 32 * tj * P64, P64, 4, r32, hi);
#pragma unroll
                for (int g4 = 0; g4 < 4; ++g4) {
                    const int d0 = 8 * g4 + 4 * hi;
                    *(LAS u32x2*)(lds + ST + dv * P128 + (64 * ti + d0) * 2) = (u32x2){cvt_pk_bf16(S0[4 * g4], S0[4 * g4 + 1]), cvt_pk_bf16(S0[4 * g4 + 2], S0[4 * g4 + 3])};
                    *(LAS u32x2*)(lds + ST + dv * P128 + (64 * ti + 32 + d0) * 2) = (u32x2){cvt_pk_bf16(S1[4 * g4], S1[4 * g4 + 1]), cvt_pk_bf16(S1[4 * g4 + 2], S1[4 * g4 + 3])};
                }
            }
            __syncthreads();
#pragma unroll
            for (int r = 0; r < 8; ++r) {
                const int t = 8 * wave + r;
                const unsigned ov = *(LAS const unsigned*)(lds + RT + t * P128 + 4 * lane);
                const float oa = bflo(ov), ob = bfhi(ov);
                const float rstd = 1.f / sqrtf(wave_sum(oa * oa + ob * ob) * (1.f / 128.f) + EPS);
                bf16_t* prow = proj + (rowb + t) * GDN_PITCH;
                const unsigned zv = *(const unsigned*)(prow + colz);
                *(unsigned*)(prow + colv) = cvt_pk_bf16(oa * rstd * nw0 * silu_f(bflo(zv)), ob * rstd * nw1 * silu_f(bfhi(zv)));
            }
        }
        __syncthreads();
    }
}

template <bool MASK> __device__ __forceinline__ void sb_tile(LAS const unsigned char* kb, LAS const unsigned char* vb, const bf16x8 (&qr)[4], const bf16x8 (&Uf)[2],
                                                            f32x16& oT0, f32x16& oT1, float& carry, const int s0, const int tq, const int r32, const int hi) {
    constexpr int P = 144;
    f32x16 p0 = {}, p1 = {};
#pragma unroll
    for (int kk = 0; kk < 4; ++kk) {
        const bf16x8 k0 = *(LAS const bf16x8*)(kb + r32 * P + (16 * kk + 8 * hi) * 2), k1 = *(LAS const bf16x8*)(kb + (32 + r32) * P + (16 * kk + 8 * hi) * 2);
        p0 = __builtin_amdgcn_mfma_f32_32x32x16_bf16(k0, qr[kk], p0, 0, 0, 0);
        p1 = __builtin_amdgcn_mfma_f32_32x32x16_bf16(k1, qr[kk], p1, 0, 0, 0);
    }
    float lk0[16], lk1[16]; float cs0 = 0.f, cs1 = 0.f;
#pragma unroll
    for (int r = 0; r < 16; ++r) {
        const float y0 = p0[r], y1 = p1[r];
        const float sp0 = fmaxf(y0, 0.f) + __builtin_amdgcn_logf(1.f + __builtin_amdgcn_exp2f(-fabsf(y0)));
        const float sp1 = fmaxf(y1, 0.f) + __builtin_amdgcn_logf(1.f + __builtin_amdgcn_exp2f(-fabsf(y1)));
        p0[r] = y0 - sp0; p1[r] = y1 - sp1;
        if (MASK) { const int s = s0 + crow(r, hi); lk0[r] = (s < tq) ? -sp0 : 0.f; lk1[r] = (s + 32 < tq) ? -sp1 : 0.f; }
        else { lk0[r] = -sp0; lk1[r] = -sp1; }
        cs0 += lk0[r]; cs1 += lk1[r];
    }
    cs0 += __shfl_xor(cs0, 32); cs1 += __shfl_xor(cs1, 32);
    f32x16 R0, R1;
#pragma unroll
    for (int r = 0; r < 16; ++r) { R0[r] = carry + cs1; R1[r] = carry; }
#pragma unroll
    for (int kk = 0; kk < 4; ++kk) {
        u32x4 w;
        if (kk < 2) { w.x = cvt_pk_bf16(lk0[8 * kk], lk0[8 * kk + 1]); w.y = cvt_pk_bf16(lk0[8 * kk + 2], lk0[8 * kk + 3]); w.z = cvt_pk_bf16(lk0[8 * kk + 4], lk0[8 * kk + 5]); w.w = cvt_pk_bf16(lk0[8 * kk + 6], lk0[8 * kk + 7]); }
        else { const int q = 8 * (kk - 2); w.x = cvt_pk_bf16(lk1[q], lk1[q + 1]); w.y = cvt_pk_bf16(lk1[q + 2], lk1[q + 3]); w.z = cvt_pk_bf16(lk1[q + 4], lk1[q + 5]); w.w = cvt_pk_bf16(lk1[q + 6], lk1[q + 7]); }
        const bf16x8 lf = __builtin_bit_cast(bf16x8, w);
        if (kk < 2) R0 = __builtin_amdgcn_mfma_f32_32x32x16_bf16(Uf[kk], lf, R0, 0, 0, 0);
        else R1 = __builtin_amdgcn_mfma_f32_32x32x16_bf16(Uf[kk - 2], lf, R1, 0, 0, 0);
    }
    const float csum = cs0 + cs1;
    carry += csum;
#pragma unroll
    for (int r = 0; r < 16; ++r) {
        float a0 = __builtin_amdgcn_exp2f(p0[r] + R0[r]), a1 = __builtin_amdgcn_exp2f(p1[r] + R1[r]);
        if (MASK) { const int s = s0 + crow(r, hi); a0 = (s < tq) ? a0 : 0.f; a1 = (s + 32 < tq) ? a1 : 0.f; }
        lk0[r] = a0; lk1[r] = a1;
    }
#pragma unroll
    for (int kk = 0; kk < 4; ++kk) {
        u32x4 w;
        if (kk < 2) { w.x = cvt_pk_bf16(lk0[8 * kk], lk0[8 * kk + 1]); w.y = cvt_pk_bf16(lk0[8 * kk + 2], lk0[8 * kk + 3]); w.z = cvt_pk_bf16(lk0[8 * kk + 4], lk0[8 * kk + 5]); w.w = cvt_pk_bf16(lk0[8 * kk + 6], lk0[8 * kk + 7]); }
        else { const int q = 8 * (kk - 2); w.x = cvt_pk_bf16(lk1[q], lk1[q + 1]); w.y = cvt_pk_bf16(lk1[q + 2], lk1[q + 3]); w.z = cvt_pk_bf16(lk1[q + 4], lk1[q + 5]); w.w = cvt_pk_bf16(lk1[q + 6], lk1[q + 7]); }
        const bf16x8 af = __builtin_bit_cast(bf16x8, w);
        const u32x2 a0 = *(LAS const u32x2*)(vb + r32 * P + (16 * kk + 4 * hi) * 2), a1 = *(LAS const u32x2*)(vb + r32 * P + (16 * kk + 8 + 4 * hi) * 2);
        const u32x2 b0 = *(LAS const u32x2*)(vb + (32 + r32) * P + (16 * kk + 4 * hi) * 2), b1 = *(LAS const u32x2*)(vb + (32 + r32) * P + (16 * kk + 8 + 4 * hi) * 2);
        const bf16x8 v0 = __builtin_bit_cast(bf16x8, (u32x4){a0.x, a0.y, a1.x, a1.y}), v1 = __builtin_bit_cast(bf16x8, (u32x4){b0.x, b0.y, b1.x, b1.y});
        oT0 = __builtin_amdgcn_mfma_f32_32x32x16_bf16(v0, af, oT0, 0, 0, 0);
        oT1 = __builtin_amdgcn_mfma_f32_32x32x16_bf16(v1, af, oT1, 0, 0, 0);
    }
}
__device__ __forceinline__ void sb_attn(LAS unsigned char* lds, bf16_t* qkv, int blk, int G, int tid, int wave, int lane) {
    constexpr int KS = 0, VS = 18432, BUF = 9216, P = 144, LD = 3072;
    asm volatile("" : "+v"(lane), "+v"(tid));
    const int r32 = lane & 31, hi = lane >> 5;
    bf16x8 Uf[2];
#pragma unroll
    for (int kk = 0; kk < 2; ++kk)
#pragma unroll
        for (int e = 0; e < 8; ++e) { const int j = 16 * kk + 8 * (e >> 2) + 4 * hi + (e & 3); Uf[kk][e] = (j > r32) ? (short)0x3F80 : (short)0; }
    const int srow = tid >> 3, sch = tid & 7;
    for (int u = blk; u < 2048; u += G) {
        const int i = u >> 8, jj = u & 255, bh = jj & 127, half = jj >> 7, qb = 15 - 2 * i - (half ^ (i & 1));
        const int b = bh >> 4, h = bh & 15, q0 = qb * 256;
        const size_t rowb = (size_t)b * SEQ;
        const int tq = q0 + 32 * wave + r32;
        bf16_t* qptr = qkv + (rowb + tq) * LD + h * 64;
        bf16x8 qr[4];
#pragma unroll
        for (int kk = 0; kk < 4; ++kk) qr[kk] = *(const bf16x8*)(qptr + 16 * kk + 8 * hi);
        f32x16 oT0 = {}, oT1 = {};
        float carry = 0.f;
        const int ktmax = (q0 >> 6) + 3;
        const bf16_t* kbase = qkv + (rowb + srow) * LD + 1024 + h * 64 + sch * 8;
        u32x4 kreg = *(const u32x4*)(kbase + (size_t)ktmax * 64 * LD), vreg = *(const u32x4*)(kbase + (size_t)ktmax * 64 * LD + 1024);
        int cur = 0;
        __syncthreads();
        for (int kt = ktmax; kt >= 0; --kt) {
            LAS unsigned char* kb = lds + KS + cur * BUF; LAS unsigned char* vb = lds + VS + cur * BUF;
            *(LAS u32x4*)(kb + srow * P + sch * 16) = kreg;
#pragma unroll
            for (int e = 0; e < 4; ++e) {
                *(LAS unsigned short*)(vb + (sch * 8 + 2 * e) * P + srow * 2) = (unsigned short)(vreg[e] & 0xffffu);
                *(LAS unsigned short*)(vb + (sch * 8 + 2 * e + 1) * P + srow * 2) = (unsigned short)(vreg[e] >> 16);
            }
            __syncthreads();
            if (kt > 0) { kreg = *(const u32x4*)(kbase + (size_t)(kt - 1) * 64 * LD); vreg = *(const u32x4*)(kbase + (size_t)(kt - 1) * 64 * LD + 1024); }
            const int s0 = kt * 64, tmin = q0 + 32 * wave;
            if (s0 < tmin + 31) {
                if (s0 + 63 >= tmin) sb_tile<true>(kb, vb, qr, Uf, oT0, oT1, carry, s0, tq, r32, hi);
                else sb_tile<false>(kb, vb, qr, Uf, oT0, oT1, carry, s0, tq, r32, hi);
            }
            cur ^= 1;
        }
#pragma unroll
        for (int g4 = 0; g4 < 4; ++g4) {
            const int d0 = 8 * g4 + 4 * hi;
            *(u32x2*)(qptr + d0) = (u32x2){cvt_pk_bf16(oT0[4 * g4], oT0[4 * g4 + 1]), cvt_pk_bf16(oT0[4 * g4 + 2], oT0[4 * g4 + 3])};
            *(u32x2*)(qptr + 32 + d0) = (u32x2){cvt_pk_bf16(oT1[4 * g4], oT1[4 * g4 + 1]), cvt_pk_bf16(oT1[4 * g4 + 2], oT1[4 * g4 + 3])};
        }
    }
}

struct Args { const float* in[15]; float* out; unsigned char* ws; };
template <bool gdn> __device__ __forceinline__ void layer_body(const Args& a, const int layer, LAS unsigned char* lds, cg::grid_group& grid) {
#define LB_IDS() int tid = threadIdx.x; asm volatile("" : "+v"(tid)); const int lane = tid & 63, wave = __builtin_amdgcn_readfirstlane(tid >> 6); \
        const int G = gridDim.x, blk = blockIdx.x, gw = blk * 8 + wave, NGW = G * 8; (void)lane; (void)gw; (void)NGW; (void)G; (void)blk;
#define LB_PTRS() bf16_t* Win_t = (bf16_t*)(a.ws + WS_WIN); bf16_t* Wout_t = (bf16_t*)(a.ws + WS_WOUT); bf16_t* Wgu_t = (bf16_t*)(a.ws + WS_WGU); bf16_t* Wdn_t = (bf16_t*)(a.ws + WS_WDN); \
        float* gb = (float*)(a.ws + WS_GB); bf16_t* H = (bf16_t*)(a.ws + WS_H); bf16_t* PROJ = (bf16_t*)(a.ws + WS_PROJ); float* out = a.out; const float* xcur = (layer == 0) ? a.in[0] : a.out; \
        (void)Win_t; (void)Wout_t; (void)Wgu_t; (void)Wdn_t; (void)gb; (void)H; (void)PROJ; (void)out; (void)xcur;
        const int j = layer >> 1;
#ifndef NO_P1
        {
            LB_IDS(); LB_PTRS(); LAS float* scr = (LAS float*)(lds + wave * 16384);
            const float* w_in = gdn ? a.in[1] + (size_t)j * DM * GDN_N : a.in[7] + (size_t)j * DM * 3072;
            const float* w_out = gdn ? a.in[6] + (size_t)j * 2048 * DM : a.in[8] + (size_t)j * DM * DM;
            const int n_in = gdn ? GDN_N : 3072, k_out = gdn ? 2048 : 1024;
            const int I_in = (DM / 64) * (n_in / 32), I_out = (k_out / 64) * (DM / 32), I_g = (DM / 64) * (FF / 32), I_d = (FF / 64) * (DM / 32);
            const float* wg = a.in[11] + (size_t)layer * DM * FF; const float* wu = a.in[12] + (size_t)layer * DM * FF; const float* wd = a.in[13] + (size_t)layer * FF * DM;
            for (int it = gw; it < I_in + I_out + 2 * I_g + I_d; it += NGW) {
                int r = it;
                if (r < I_in) { conv_plain(w_in, DM, n_in, Win_t, r, scr, lane); continue; } r -= I_in;
                if (r < I_out) { conv_plain(w_out, k_out, DM, Wout_t, r, scr, lane); continue; } r -= I_out;
                if (r < I_g) { conv_gu(wg, Wgu_t, r, 0, scr, lane); continue; } r -= I_g;
                if (r < I_g) { conv_gu(wu, Wgu_t, r, 1, scr, lane); continue; } r -= I_g;
                conv_plain(wd, FF, DM, Wdn_t, r, scr, lane);
            }
            norm_rows(xcur, a.in[9] + layer * DM, H, gw, NGW, lane);
        }
#endif
        grid.sync();
        {
            LB_IDS(); LB_PTRS();
            pg8::Gemm g{H, Win_t, M_TOK, gdn ? GDN_NP : 3072, DM, DM}; pg8::StaticOrder S; S.init(M_TOK, g.N, G, blk);
            EpiProj E{PROJ, gdn ? GDN_PITCH : 3072, gdn ? 24 : -1, gb, a.in[3] + j * 16, a.in[4] + j * 16, gdn ? 0 : 4, 0.125f * 1.4426950408889634f};
#if !defined(NO_GEMM) && !defined(NO_P2)
            pg8::gemm_phase<EpiProj, pg8::StaticOrder, true, true>(lds, g, S, E);
#endif
        }
        grid.sync();
        if constexpr (gdn) {
            LB_IDS(); LB_PTRS();
            const float* convw = a.in[2] + (size_t)j * 4096 * 4;
#ifndef NO_G1
            gdn_g1(lds, PROJ, gb, convw, H, gw, NGW, wave, lane);
#endif
            grid.sync();
#ifndef NO_G2
            gdn_g2(lds, PROJ, gb, convw, a.in[5] + j * 128, H, blk, G, tid, wave, lane);
#endif
        } else {
            LB_IDS(); LB_PTRS();
#ifndef NO_SB
            sb_attn(lds, PROJ, blk, G, tid, wave, lane);
#endif
        }
        grid.sync();
        {
            LB_IDS(); LB_PTRS();
            pg8::Gemm g{gdn ? PROJ + 2048 : PROJ, Wout_t, M_TOK, DM, gdn ? 2048 : 1024, gdn ? GDN_PITCH : 3072}; pg8::StaticOrder S; S.init(M_TOK, DM, G, blk);
            EpiRes E{xcur, out, DM};
#if !defined(NO_GEMM) && !defined(NO_P4)
            pg8::gemm_phase<EpiRes, pg8::StaticOrder, true, true>(lds, g, S, E);
#endif
        }
        grid.sync();
#ifndef NO_P5
        { LB_IDS(); LB_PTRS(); norm_rows(out, a.in[10] + layer * DM, H, gw, NGW, lane); }
#endif
        grid.sync();
        {
            LB_IDS(); LB_PTRS();
            pg8::Gemm g{H, Wgu_t, M_TOK, 2 * FF, DM, DM}; pg8::StaticOrder S; S.init(M_TOK, 2 * FF, G, blk);
            EpiSwiglu E{PROJ, FF};
#if !defined(NO_GEMM) && !defined(NO_P6)
            pg8::gemm_phase<EpiSwiglu, pg8::StaticOrder, true, true>(lds, g, S, E);
#endif
        }
        grid.sync();
        {
            LB_IDS(); LB_PTRS();
            pg8::Gemm g{PROJ, Wdn_t, M_TOK, DM, FF, FF}; pg8::StaticOrder S; S.init(M_TOK, DM, G, blk);
            EpiRes E{out, out, DM};
#if !defined(NO_GEMM) && !defined(NO_P7)
            pg8::gemm_phase<EpiRes, pg8::StaticOrder, true, true>(lds, g, S, E);
#endif
        }
        grid.sync();
}

__global__ void __launch_bounds__(512, 2) fwd(Args a) {
    extern __shared__ __attribute__((aligned(16))) unsigned char lds_raw[];
    LAS unsigned char* lds = (LAS unsigned char*)lds_raw;
    cg::grid_group grid = cg::this_grid();
#ifdef ONE_LAYER
    layer_body<false>(a, 1, lds, grid);
#else
    for (int lp = 0; lp < 2; ++lp) {
        layer_body<true>(a, 2 * lp, lds, grid);
        layer_body<false>(a, 2 * lp + 1, lds, grid);
    }
#endif
#ifndef NO_FINAL
    { int tid = threadIdx.x; asm volatile("" : "+v"(tid)); const int lane = tid & 63, wave = __builtin_amdgcn_readfirstlane(tid >> 6); final_norm_rows(a.out, a.in[14], blockIdx.x * 8 + wave, gridDim.x * 8, lane); }
#endif
}

extern "C" void kernel_launch(void* const* d_in, const int* in_sizes, int n_in, void* d_out, int out_size, void* d_ws, size_t ws_size, hipStream_t stream) {
    static int grid = 0;
    if (grid == 0) {
        if (n_in != 15 || out_size != M_TOK * DM || ws_size < WS_END) { fprintf(stderr, "kernel_launch: unexpected shapes (n_in %d out %d ws %zu)\n", n_in, out_size, ws_size); grid = -1; return; }
        int dev = 0, cus = 0, per_cu = 0;
        hipGetDevice(&dev); hipDeviceGetAttribute(&cus, hipDeviceAttributeMultiprocessorCount, dev);
        hipFuncSetAttribute((const void*)fwd, hipFuncAttributeMaxDynamicSharedMemorySize, LDS_BYTES);
        hipOccupancyMaxActiveBlocksPerMultiprocessor(&per_cu, (const void*)fwd, 512, LDS_BYTES);
        if (per_cu < 1) per_cu = 1;
        grid = cus * per_cu;
        (void)hipGetLastError();
    }
    if (grid < 0) return;
    Args a{};
    for (int i = 0; i < 15; ++i) a.in[i] = (const float*)d_in[i];
    a.out = (float*)d_out; a.ws = (unsigned char*)d_ws;
    void* args[] = {&a};
    hipError_t e = hipLaunchCooperativeKernel((const void*)fwd, dim3(grid), dim3(512), args, LDS_BYTES, stream);
    if (e != hipSuccess) fprintf(stderr, "cooperative launch failed: %s (grid %d)\n", hipGetErrorString(e), grid);
}
```

```cpp
#include <hip/hip_runtime.h>
#include <hip/hip_cooperative_groups.h>
#include <cstdio>
#include <cstdint>
namespace cg = cooperative_groups;
namespace pg8 {
#define PG8_LAS __attribute__((address_space(3)))
typedef unsigned short bf16_t;
typedef short bf16x8 __attribute__((ext_vector_type(8)));
typedef float f32x4 __attribute__((ext_vector_type(4)));
typedef unsigned u32x4 __attribute__((ext_vector_type(4)));
constexpr int BM = 256, BK = 64, HALF = 128, HTB = HALF * BK * 2  , STAGE_BYTES = 8 * HTB, NXCD = 8, WGM = 8;

__host__ __device__ __forceinline__ int lds_byte(int r, int c) { const int st = (r >> 4) * 2 + (c >> 5), rr = r & 15, cc = c & 31, ob = rr * 64 + cc * 2; return st * 1024 + (ob ^ (((ob >> 9) & 1) << 5)); }
__host__ __device__ __forceinline__ void stage_rc(int b, int& R, int& C) { const int st = b / 1024, sb = b % 1024, swz = sb ^ (((sb >> 9) & 1) << 5); R = (st >> 1) * 16 + swz / 64; C = (st & 1) * 32 + (swz % 64) / 2; }
__host__ __device__ __forceinline__ int perm32(int rho) { const int n = rho >> 4, i = rho & 15; return 8 * (i >> 2) + 4 * n + (i & 3); }

struct Unit { int pm, pn; };
struct Gemm { const bf16_t* A; const bf16_t* Bt; int M, N, K, lda; };

struct StaticOrder {
    int nM, nN, nwg, G, c;
    __host__ __device__ void init(int M, int N, int G_, int c_) { nM = M / BM; nN = N / BM; nwg = nM * nN; G = G_; c = c_; }
    __host__ __device__ bool next(int i, Unit& u) const {
        const long L = (long)i * G + c; if (L >= nwg) return false;
        int wgid = (int)L; { const int q = nwg / NXCD, r = nwg % NXCD, xcd = wgid % NXCD, off = wgid / NXCD; wgid = (xcd < r ? xcd * (q + 1) : r * (q + 1) + (xcd - r) * q) + off; }
        const int nig = WGM * nN, gid = wgid / nig, fm = gid * WGM, gsz = (nM - fm) < WGM ? (nM - fm) : WGM;
        u.pm = fm + ((wgid % nig) % gsz); u.pn = (wgid % nig) / gsz; return true;
    }
    __device__ __forceinline__ void a_ready(const Unit&) const {}
    __device__ __forceinline__ void done(const Unit&) const {}
};

__device__ __forceinline__ unsigned cvt_pk_bf16(float lo, float hi) { unsigned r; asm volatile("v_cvt_pk_bf16_f32 %0, %1, %2" : "=v"(r) : "v"(lo), "v"(hi)); return r; }
typedef float f32x2 __attribute__((ext_vector_type(2)));
template <class Epi, class Sched, bool ALIGN_EPI = false, bool SP2 = false>
__device__ __forceinline__ void gemm_phase(PG8_LAS unsigned char* lds, const Gemm g, const Sched& S, const Epi& E) {
    int tid_l = threadIdx.x; asm volatile("" : "+v"(tid_l));
    const int tid = tid_l, wid = __builtin_amdgcn_readfirstlane(tid >> 6), lane = tid & 63, wr = wid >> 2, wc = wid & 3, fr = lane & 15, fq = lane >> 4;
    const int K = g.K, nt = K / BK;
    unsigned voffA[2], voffB[2];
#pragma unroll
    for (int i = 0; i < 2; ++i) { int R, C; stage_rc(tid * 16 + i * 8192, R, C); const int Rb = Epi::PERM ? ((R & ~31) + perm32(R & 31)) : R;
        voffA[i] = (unsigned)(R * g.lda + C) * 2u; voffB[i] = (unsigned)(Rb * K + C) * 2u; }
    const size_t kstep = (size_t)(BK * 2);
    const size_t hstepA = (size_t)HALF * g.lda * 2, hstepB = (size_t)HALF * K * 2;
    const size_t tstepA = 2 * hstepA, tstepB = 2 * hstepB;
    const unsigned ldsw = (unsigned)wid * 1024u;
    const int aoff = lds_byte(wr * 64 + fr, fq * 8), boff = lds_byte(wc * 32 + fr, fq * 8);
#define PG8_SA(b, h) (((b) * 2 + (h)) * HTB)
#define PG8_SB(b, h) ((4 + (b) * 2 + (h)) * HTB)
#define PG8_STAGE(bufoff, gbase, voff) do { _Pragma("unroll") for (int _i = 0; _i < 2; ++_i) \
        __builtin_amdgcn_global_load_lds((const unsigned*)((const char*)(gbase) + (voff)[_i]), (PG8_LAS unsigned*)(lds + (bufoff) + ldsw + _i * 8192), 16, 0, 0); } while (0)
#define PG8_LDA(dst, b, h) do { _Pragma("unroll") for (int m = 0; m < 4; ++m) _Pragma("unroll") for (int k = 0; k < 2; ++k) dst[m][k] = *(const PG8_LAS bf16x8*)(lds + PG8_SA(b, h) + aoff + m * 2048 + k * 1024); } while (0)
#define PG8_LDB(dst, b, h) do { _Pragma("unroll") for (int n = 0; n < 2; ++n) _Pragma("unroll") for (int k = 0; k < 2; ++k) dst[n][k] = *(const PG8_LAS bf16x8*)(lds + PG8_SB(b, h) + boff + n * 2048 + k * 1024); } while (0)
#define PG8_MMA(ai, bj, At, Bt) do { __builtin_amdgcn_s_setprio(1); _Pragma("unroll") for (int m = 0; m < 4; ++m) _Pragma("unroll") for (int n = 0; n < 2; ++n) _Pragma("unroll") for (int k = 0; k < 2; ++k) \
        acc[ai][bj][m][n] = __builtin_amdgcn_mfma_f32_16x16x32_bf16(Bt[n][k], At[m][k], acc[ai][bj][m][n], 0, 0, 0); __builtin_amdgcn_s_setprio(0); } while (0)
#define PG8_WAIT_V(n) asm volatile("s_waitcnt vmcnt(" #n ")" ::: "memory")
#define PG8_WAIT_L(n) asm volatile("s_waitcnt lgkmcnt(" #n ")" ::: "memory")
#define PG8_BAR __builtin_amdgcn_s_barrier()
#define PG8_SCHED __builtin_amdgcn_sched_barrier(0)
    Unit cur, nxt; int ui = 0;
    if (!S.next(0, cur)) return;
    f32x4 acc[2][2][4][2];
#pragma unroll
    for (int a = 0; a < 2; ++a)
#pragma unroll
        for (int b = 0; b < 2; ++b)
#pragma unroll
            for (int m = 0; m < 4; ++m)
#pragma unroll
                for (int n = 0; n < 2; ++n) acc[a][b][m][n] = (f32x4){0.f, 0.f, 0.f, 0.f};
    bf16x8 At[4][2], B0[2][2], B1[2][2];
    const char* cA = (const char*)g.A + (size_t)cur.pm * tstepA; const char* cB = (const char*)g.Bt + (size_t)cur.pn * tstepB;
    S.a_ready(cur);
    if constexpr (SP2) {
        PG8_STAGE(PG8_SB(0, 0), cB, voffB); PG8_STAGE(PG8_SB(0, 1), cB + hstepB, voffB); PG8_STAGE(PG8_SA(0, 0), cA, voffA); PG8_STAGE(PG8_SA(0, 1), cA + hstepA, voffA);
        if (wr == 1) PG8_BAR;
        PG8_WAIT_V(2); PG8_BAR;
        PG8_STAGE(PG8_SB(1, 0), cB + kstep, voffB); PG8_STAGE(PG8_SA(1, 0), cA + kstep, voffA); PG8_STAGE(PG8_SB(1, 1), cB + hstepB + kstep, voffB);
        PG8_WAIT_V(6); PG8_BAR;
    } else {
        PG8_STAGE(PG8_SB(0, 0), cB, voffB); PG8_STAGE(PG8_SA(0, 0), cA, voffA); PG8_STAGE(PG8_SB(0, 1), cB + hstepB, voffB); PG8_STAGE(PG8_SA(0, 1), cA + hstepA, voffA);
        if (wr == 1) PG8_BAR;
        PG8_WAIT_V(4); PG8_BAR;
        PG8_STAGE(PG8_SB(1, 0), cB + kstep, voffB); PG8_STAGE(PG8_SA(1, 0), cA + kstep, voffA); PG8_STAGE(PG8_SB(1, 1), cB + hstepB + kstep, voffB);
        PG8_WAIT_V(6); PG8_BAR;
    }
    for (;;) {
        const bool has_next = S.next(ui + 1, nxt);
        const char* nA = has_next ? (const char*)g.A + (size_t)nxt.pm * tstepA : cA; const char* nB = has_next ? (const char*)g.Bt + (size_t)nxt.pn * tstepB : cB;
        for (int t = 0; t < nt; t += 2) {
            const bool last = (t == nt - 2);
            const char* a1 = cA + (size_t)(t + 1) * kstep;
            const char* a2 = last ? nA : cA + (size_t)(t + 2) * kstep; const char* b2 = last ? nB : cB + (size_t)(t + 2) * kstep;
            const char* a3 = a2 + kstep; const char* b3 = b2 + kstep;
            if (last && has_next) S.a_ready(nxt);
            if constexpr (SP2) {
            PG8_LDB(B0, 0, 0); PG8_LDB(B1, 0, 1); PG8_SCHED; PG8_LDA(At, 0, 0); PG8_STAGE(PG8_SA(1, 1), a1 + hstepA, voffA);
            PG8_WAIT_V(8); PG8_WAIT_L(0); PG8_BAR; PG8_MMA(0, 0, At, B0); PG8_MMA(0, 1, At, B1); PG8_BAR; PG8_SCHED;
            PG8_LDA(At, 0, 1); PG8_STAGE(PG8_SB(0, 0), b2, voffB); PG8_STAGE(PG8_SB(0, 1), b2 + hstepB, voffB); PG8_STAGE(PG8_SA(0, 0), a2, voffA);
            PG8_WAIT_V(8); PG8_WAIT_L(0); PG8_BAR; PG8_MMA(1, 0, At, B0); PG8_MMA(1, 1, At, B1); PG8_BAR; PG8_SCHED;
            PG8_LDB(B0, 1, 0); PG8_LDB(B1, 1, 1); PG8_SCHED; PG8_LDA(At, 1, 0); PG8_STAGE(PG8_SA(0, 1), a2 + hstepA, voffA);
            PG8_WAIT_V(8); PG8_WAIT_L(0); PG8_BAR; PG8_MMA(0, 0, At, B0); PG8_MMA(0, 1, At, B1); PG8_BAR; PG8_SCHED;
            PG8_LDA(At, 1, 1); PG8_STAGE(PG8_SB(1, 0), b3, voffB); PG8_STAGE(PG8_SB(1, 1), b3 + hstepB, voffB); PG8_STAGE(PG8_SA(1, 0), a3, voffA);
            PG8_WAIT_V(8); PG8_WAIT_L(0); PG8_BAR; PG8_MMA(1, 0, At, B0); PG8_MMA(1, 1, At, B1); PG8_BAR; PG8_SCHED;
            } else {
            PG8_LDB(B0, 0, 0); PG8_SCHED; PG8_LDA(At, 0, 0); PG8_STAGE(PG8_SA(1, 1), a1 + hstepA, voffA);
            PG8_WAIT_L(8); PG8_BAR; PG8_WAIT_L(0); PG8_MMA(0, 0, At, B0); PG8_BAR; PG8_SCHED;
            PG8_LDB(B1, 0, 1); PG8_STAGE(PG8_SB(0, 0), b2, voffB);
            PG8_BAR; PG8_WAIT_L(0); PG8_MMA(0, 1, At, B1); PG8_BAR;
            PG8_LDA(At, 0, 1); PG8_STAGE(PG8_SA(0, 0), a2, voffA);
            PG8_BAR; PG8_WAIT_L(0); PG8_MMA(1, 0, At, B0); PG8_BAR; PG8_SCHED;
            PG8_STAGE(PG8_SB(0, 1), b2 + hstepB, voffB);
            PG8_WAIT_V(6); PG8_BAR; PG8_MMA(1, 1, At, B1); PG8_BAR;
            PG8_LDB(B0, 1, 0); PG8_SCHED; PG8_LDA(At, 1, 0); PG8_STAGE(PG8_SA(0, 1), a2 + hstepA, voffA);
            PG8_WAIT_L(8); PG8_BAR; PG8_WAIT_L(0); PG8_MMA(0, 0, At, B0); PG8_BAR; PG8_SCHED;
            PG8_LDB(B1, 1, 1); PG8_STAGE(PG8_SB(1, 0), b3, voffB);
            PG8_BAR; PG8_WAIT_L(0); PG8_MMA(0, 1, At, B1); PG8_BAR;
            PG8_LDA(At, 1, 1); PG8_STAGE(PG8_SA(1, 0), a3, voffA);
            PG8_BAR; PG8_WAIT_L(0); PG8_MMA(1, 0, At, B0); PG8_BAR; PG8_SCHED;
            PG8_STAGE(PG8_SB(1, 1), b3 + hstepB, voffB);
            PG8_WAIT_V(6); PG8_BAR; PG8_MMA(1, 1, At, B1); PG8_BAR;
            }
        }
        if constexpr (ALIGN_EPI) { if (wr == 0) PG8_BAR; }
        if constexpr (!Epi::AFTER_DRAIN) { E(acc, cur, wr, wc, fr, fq); S.done(cur); }
        if (!has_next) break;
#pragma unroll
        for (int a = 0; a < 2; ++a)
#pragma unroll
            for (int b = 0; b < 2; ++b)
#pragma unroll
                for (int m = 0; m < 4; ++m)
#pragma unroll
                    for (int n = 0; n < 2; ++n) acc[a][b][m][n] = (f32x4){0.f, 0.f, 0.f, 0.f};
        cur = nxt; cA = nA; cB = nB; ++ui;
        if constexpr (ALIGN_EPI) { if (wr == 1) PG8_BAR; }
    }
    PG8_WAIT_V(0);
    if constexpr (!ALIGN_EPI) { if (wr == 0) PG8_BAR; }
    PG8_BAR;
    if constexpr (Epi::AFTER_DRAIN) { E.fused(acc, cur, wr, wc, fr, fq, lds, wid, lane); S.done(cur); }
#undef PG8_SA
#undef PG8_SB
#undef PG8_STAGE
#undef PG8_LDA
#undef PG8_LDB
#undef PG8_MMA
#undef PG8_WAIT_V
#undef PG8_WAIT_L
#undef PG8_BAR
#undef PG8_SCHED
}
}

constexpr int M_TOK = 32768, DM = 1024, SEQ = 4096, NB = 8;
constexpr int GDN_N = 6176, GDN_NP = 6400, GDN_PITCH = 6144, FF = 2816;
constexpr float EPS = 1e-6f;
#define LAS __attribute__((address_space(3)))
typedef unsigned short bf16_t;
typedef short bf16x8 __attribute__((ext_vector_type(8)));
typedef float f32x4 __attribute__((ext_vector_type(4)));
typedef float f32x16 __attribute__((ext_vector_type(16)));
typedef unsigned u32x4 __attribute__((ext_vector_type(4)));
typedef unsigned u32x2 __attribute__((ext_vector_type(2)));
using pg8::cvt_pk_bf16;

constexpr size_t MiB = 1u << 20;
constexpr size_t WS_WIN = 1 * MiB, WS_WOUT = 14 * MiB, WS_WGU = 18 * MiB, WS_WDN = 29 * MiB, WS_GB = 36 * MiB, WS_H = 40 * MiB, WS_PROJ = 104 * MiB, WS_SSQ = 488 * MiB, WS_END = 492 * MiB;
constexpr int LDS_BYTES = 147456;

__device__ __forceinline__ float bf2f(unsigned short b) { return __uint_as_float(((unsigned)b) << 16); }
__device__ __forceinline__ float bflo(unsigned u) { return __uint_as_float(u << 16); }
__device__ __forceinline__ float bfhi(unsigned u) { return __uint_as_float(u & 0xffff0000u); }
template <int CTRL> __device__ __forceinline__ float dpp_f(float v) { return __builtin_bit_cast(float, __builtin_amdgcn_update_dpp(0, __builtin_bit_cast(int, v), CTRL, 0xf, 0xf, true)); }
__device__ __forceinline__ float wave_sum(float v) {
    v += dpp_f<0xB1>(v); v += dpp_f<0x4E>(v); v += dpp_f<0x141>(v); v += dpp_f<0x140>(v);
    const int vi = __builtin_bit_cast(int, v);
    return (__builtin_bit_cast(float, __builtin_amdgcn_readlane(vi, 0)) + __builtin_bit_cast(float, __builtin_amdgcn_readlane(vi, 16))) +
           (__builtin_bit_cast(float, __builtin_amdgcn_readlane(vi, 32)) + __builtin_bit_cast(float, __builtin_amdgcn_readlane(vi, 48)));
}
__device__ __forceinline__ float silu_f(float v) { return v * __builtin_amdgcn_rcpf(1.f + __expf(-v)); }
__device__ __forceinline__ float softplus_f(float x) { return fmaxf(x, 0.f) + __logf(1.f + __expf(-fabsf(x))); }

__device__ __forceinline__ float rstd_of(const float* ssq16, int row) {
    const f32x4* p = (const f32x4*)(ssq16 + (size_t)row * 16);
    const f32x4 a = p[0], b = p[1], c = p[2], d = p[3];
    const f32x4 t = (a + b) + (c + d);
    return __builtin_amdgcn_rsqf(((t[0] + t[1]) + (t[2] + t[3])) * (1.f / DM) + EPS);
}
struct EpiProj {
    static constexpr bool PERM = true, AFTER_DRAIN = false;
    bf16_t* O; int ldc; int gate_tile; float* gb; const float* a_log; const float* dt_bias; int scale_tiles; float scale; const float* ssq;
    __device__ __forceinline__ void operator()(const f32x4 (&acc)[2][2][4][2], const pg8::Unit& u, int wr, int wc, int fr, int fq) const {
        const int row0 = u.pm * 256 + wr * 64 + fr;
#define RS_OF(ai, m) rstd_of(ssq, row0 + (ai) * 128 + (m) * 16)
        if (u.pn == gate_tile) {
            if (wc == 0) {
                const int c0 = 8 * fq;
#pragma unroll
                for (int ai = 0; ai < 2; ++ai)
#pragma unroll
                    for (int m = 0; m < 4; ++m) {
                        const int row = row0 + ai * 128 + m * 16; const float rsv = RS_OF(ai, m);
#pragma unroll
                        for (int n = 0; n < 2; ++n) {
                            const f32x4 v = acc[ai][0][m][n] * rsv; f32x4 o;
                            const int c = c0 + 4 * n;
                            if (fq < 2) {
#pragma unroll
                                for (int j = 0; j < 4; ++j) o[j] = 1.f / (1.f + __expf(-v[j]));
                            } else {
                                const f32x4 al = *(const f32x4*)(a_log + c - 16), db = *(const f32x4*)(dt_bias + c - 16);
#pragma unroll
                                for (int j = 0; j < 4; ++j) o[j] = -__expf(al[j]) * softplus_f(v[j] + db[j]);
                            }
                            *(f32x4*)(gb + (size_t)row * 32 + c) = o;
                        }
                    }
            }
            return;
        }
        const int col0 = u.pn * 256 + wc * 32 + 8 * fq;
        const float sc = (u.pn < scale_tiles) ? scale : 1.f;
#pragma unroll
        for (int ai = 0; ai < 2; ++ai)
#pragma unroll
            for (int m = 0; m < 4; ++m) { bf16_t* rowp = O + (size_t)(row0 + ai * 128 + m * 16) * ldc + col0; const float sr = sc * RS_OF(ai, m);
#pragma unroll
                for (int bj = 0; bj < 2; ++bj) { const f32x4 v0 = acc[ai][bj][m][0] * sr, v1 = acc[ai][bj][m][1] * sr;
                    u32x4 w; w.x = cvt_pk_bf16(v0[0], v0[1]); w.y = cvt_pk_bf16(v0[2], v0[3]); w.z = cvt_pk_bf16(v1[0], v1[1]); w.w = cvt_pk_bf16(v1[2], v1[3]);
                    *(u32x4*)(rowp + bj * 128) = w; } }
    }
};
struct EpiSwiglu {
    static constexpr bool PERM = true, AFTER_DRAIN = false;
    bf16_t* O; int ldc; const float* ssq;
    __device__ __forceinline__ void operator()(const f32x4 (&acc)[2][2][4][2], const pg8::Unit& u, int wr, int wc, int fr, int fq) const {
        const int row0 = u.pm * 256 + wr * 64 + fr, col0 = u.pn * 128 + wc * 32 + 8 * fq;
#pragma unroll
        for (int ai = 0; ai < 2; ++ai)
#pragma unroll
            for (int m = 0; m < 4; ++m) { bf16_t* rowp = O + (size_t)(row0 + ai * 128 + m * 16) * ldc + col0;
                float r[8]; const float rsd = rstd_of(ssq, row0 + ai * 128 + m * 16);
#pragma unroll
                for (int n = 0; n < 2; ++n)
#pragma unroll
                    for (int j = 0; j < 4; ++j) { const float g = acc[ai][0][m][n][j] * rsd, up = acc[ai][1][m][n][j] * rsd; r[4 * n + j] = silu_f(g) * up; }
                u32x4 w; w.x = cvt_pk_bf16(r[0], r[1]); w.y = cvt_pk_bf16(r[2], r[3]); w.z = cvt_pk_bf16(r[4], r[5]); w.w = cvt_pk_bf16(r[6], r[7]);
                *(u32x4*)rowp = w; }
    }
};
struct EpiRes {
    static constexpr bool PERM = false, AFTER_DRAIN = false;
    const float* base; float* out; int ldc; bf16_t* xb; float* ssq;
    __device__ __forceinline__ void operator()(const f32x4 (&acc)[2][2][4][2], const pg8::Unit& u, int wr, int wc, int fr, int fq) const {
        const int row0 = u.pm * 256 + wr * 64 + fr, col0 = u.pn * 256 + wc * 32 + 4 * fq;
#pragma unroll
        for (int ai = 0; ai < 2; ++ai)
#pragma unroll
            for (int m = 0; m < 4; ++m) { const int row = row0 + ai * 128 + m * 16; const size_t off = (size_t)row * ldc + col0; float sq = 0.f;
#pragma unroll
                for (int bj = 0; bj < 2; ++bj)
#pragma unroll
                    for (int n = 0; n < 2; ++n) { const f32x4 b = *(const f32x4*)(base + off + bj * 128 + n * 16); const f32x4 o = b + acc[ai][bj][m][n]; *(f32x4*)(out + off + bj * 128 + n * 16) = o;
                        sq += (o[0] * o[0] + o[1] * o[1]) + (o[2] * o[2] + o[3] * o[3]);
                        *(u32x2*)(xb + off + bj * 128 + n * 16) = (u32x2){cvt_pk_bf16(o[0], o[1]), cvt_pk_bf16(o[2], o[3])}; }
                sq += __shfl_xor(sq, 16); sq += __shfl_xor(sq, 32);
                if (fq == 0) ssq[(size_t)row * 16 + u.pn * 4 + wc] = sq; }
    }
};

__device__ __forceinline__ unsigned f2bf(float f) { unsigned u = __float_as_uint(f); return (u + 0x7fffu + ((u >> 16) & 1u)) >> 16; }
__device__ __forceinline__ unsigned pk2(float lo, float hi) { return f2bf(lo) | (f2bf(hi) << 16); }
__device__ __forceinline__ void transpose_item(const float* W, int K, int N, bf16_t* WT, int k0, int n0, int drow0, LAS float* scr, int lane, const float* kscale) {
    const float ks = kscale ? kscale[k0 + lane] : 1.f;
#pragma unroll 8
    for (int i = 0; i < 32; ++i) { const int kk = 2 * i + (lane >> 5); scr[kk * 33 + (lane & 31)] = W[(size_t)(k0 + kk) * N + n0 + (lane & 31)] * __shfl(ks, kk); }
    asm volatile("s_waitcnt lgkmcnt(0)" ::: "memory");
    const int c = lane & 7;
#pragma unroll
    for (int j = 0; j < 4; ++j) { const int n = (lane >> 3) + 8 * j; const LAS float* s = scr + (8 * c) * 33 + n;
        u32x4 o; o.x = pk2(s[0 * 33], s[1 * 33]); o.y = pk2(s[2 * 33], s[3 * 33]); o.z = pk2(s[4 * 33], s[5 * 33]); o.w = pk2(s[6 * 33], s[7 * 33]);
        *(u32x4*)(WT + (size_t)(drow0 + n) * K + k0 + 8 * c) = o; }
    asm volatile("s_waitcnt lgkmcnt(0)" ::: "memory");
}
__device__ __forceinline__ void conv_plain(const float* W, int K, int N, bf16_t* WT, int item, LAS float* scr, int lane, const float* kscale) {
    const int nblk = N / 32, kb = item / nblk, nb = item % nblk;
    transpose_item(W, K, N, WT, 64 * kb, 32 * nb, 32 * nb, scr, lane, kscale);
}
__device__ __forceinline__ void conv_gu(const float* W, bf16_t* WT, int item, int up, LAS float* scr, int lane, const float* kscale) {
    const int nblk = FF / 32, kb = item / nblk, nb = item % nblk, n0 = 32 * nb;
    transpose_item(W, DM, FF, WT, 64 * kb, n0, (n0 >> 7) * 256 + (n0 & 127) + up * 128, scr, lane, kscale);
}
__device__ __forceinline__ void xb_rows(const float* x, bf16_t* xb, float* ssq, int gw, int NGW, int lane) {
    asm volatile("" : "+v"(lane));
    for (int m = gw; m < M_TOK; m += NGW) {
        const f32x4* xr = (const f32x4*)(x + (size_t)m * DM) + lane; f32x4 v[4]; float s = 0.f;
#pragma unroll
        for (int j = 0; j < 4; ++j) { v[j] = xr[64 * j]; s += (v[j].x * v[j].x + v[j].y * v[j].y) + (v[j].z * v[j].z + v[j].w * v[j].w); }
        s = wave_sum(s);
        if (lane < 16) ssq[(size_t)m * 16 + lane] = (lane == 0) ? s : 0.f;
        u32x2* o8 = (u32x2*)(xb + (size_t)m * DM) + lane;
#pragma unroll
        for (int j = 0; j < 4; ++j) { u32x2 p; p.x = cvt_pk_bf16(v[j].x, v[j].y); p.y = cvt_pk_bf16(v[j].z, v[j].w); o8[64 * j] = p; }
    }
}
__device__ __forceinline__ void final_norm_rows(float* x, const float* w, const float* ssq, int gw, int NGW, int lane) {
    f32x4 wv[4];
#pragma unroll
    for (int j = 0; j < 4; ++j) wv[j] = *((const f32x4*)w + lane + 64 * j);
    for (int m = gw; m < M_TOK; m += NGW) {
        f32x4* xr = (f32x4*)(x + (size_t)m * DM) + lane;
        const float rstd = rstd_of(ssq, m);
#pragma unroll
        for (int j = 0; j < 4; ++j) xr[64 * j] = xr[64 * j] * rstd * wv[j];
    }
}

__device__ __forceinline__ void gdn_g0(LAS unsigned char* lds, bf16_t* proj, const float* __restrict__ convw, int blk, int G, int tid, int wave, int lane) {
    asm volatile("" : "+v"(lane), "+v"(tid));
    LAS unsigned* halo = (LAS unsigned*)lds;
    for (int unit = blk; unit < NB * 32; unit += G) {
        const int b = unit >> 5, slab = unit & 31, col = slab * 128 + 2 * lane;
        const f32x4 w0 = *(const f32x4*)(convw + (size_t)col * 4), w1 = *(const f32x4*)(convw + (size_t)(col + 1) * 4);
        const float nsc = (slab < 8) ? 0.08838834764831845f : 1.f;
        const bool donorm = slab < 16;
        bf16_t* base = proj + (size_t)b * SEQ * GDN_PITCH + col;
        unsigned x[11];
#pragma unroll
        for (int j = 0; j < 11; ++j) { const int t = 8 * wave - 3 + j; x[j] = (t >= 0) ? *(const unsigned*)(base + (size_t)t * GDN_PITCH) : 0u; }
        __syncthreads();
        for (int chunk = 0; chunk < 64; ++chunk) {
            if (wave == 7) {
#pragma unroll
                for (int j = 0; j < 3; ++j) halo[(((chunk + 1) & 1) * 3 + j) * 64 + lane] = x[8 + j];
            }
            unsigned o[8];
#pragma unroll
            for (int r = 0; r < 8; ++r) {
                float a0 = bflo(x[r]) * w0[0] + bflo(x[r + 1]) * w0[1] + bflo(x[r + 2]) * w0[2] + bflo(x[r + 3]) * w0[3];
                float a1 = bfhi(x[r]) * w1[0] + bfhi(x[r + 1]) * w1[1] + bfhi(x[r + 2]) * w1[2] + bfhi(x[r + 3]) * w1[3];
                a0 = silu_f(a0); a1 = silu_f(a1);
                if (donorm) { const float rn = nsc * __builtin_amdgcn_rsqf(wave_sum(a0 * a0 + a1 * a1) + EPS); a0 *= rn; a1 *= rn; }
                o[r] = cvt_pk_bf16(a0, a1);
            }
            __syncthreads();
            bf16_t* cb = base + (size_t)(chunk * 64 + 8 * wave) * GDN_PITCH;
#pragma unroll
            for (int r = 0; r < 8; ++r) *(unsigned*)(cb + (size_t)r * GDN_PITCH) = o[r];
            if (chunk < 63) {
#pragma unroll
                for (int j = 0; j < 11; ++j) { const int t = 8 * wave - 3 + j;
                    if (t >= 0) x[j] = *(const unsigned*)(base + (size_t)((chunk + 1) * 64 + t) * GDN_PITCH);
                    else x[j] = halo[(((chunk + 1) & 1) * 3 + j) * 64 + lane]; }
            }
        }
        __syncthreads();
    }
}

__device__ __forceinline__ int crow(int r, int hi) { return (r & 3) + 8 * (r >> 2) + 4 * hi; }

__device__ __forceinline__ void gdn_g1(LAS unsigned char* lds, const bf16_t* __restrict__ proj, const float* gb, float* gcs, const float* __restrict__ convw,
                                        bf16_t* __restrict__ Tbuf, int gw, int NGW, int wave, int lane) {
    asm volatile("" : "+v"(lane));
    LAS float* Lw = (LAS float*)(lds + wave * 16384);
    LAS float* aux = (LAS float*)(lds + 131072 + wave * 1024);
    const int r32 = lane & 31, hi = lane >> 5;
    for (int u = gw; u < NB * 64 * 16; u += NGW) {
        const int hv = u & 15, chunk = (u >> 4) & 63, b = u >> 10, hq = hv >> 1;
        const size_t rowb = (size_t)b * SEQ + chunk * 64;
        {
            float g = gb[(rowb + lane) * 32 + 16 + hv]; const float bt = gb[(rowb + lane) * 32 + hv];
#pragma unroll
            for (int o = 1; o < 64; o <<= 1) { const float t = __shfl_up(g, o); if (lane >= o) g += t; }
            aux[lane] = g; aux[64 + lane] = bt;
            gcs[(rowb + lane) * 32 + 16 + hv] = g;
        }
        f32x16 a00 = {}, a10 = {}, a11 = {};
        {
            const bf16_t* kp = proj + (rowb + r32) * GDN_PITCH + 1024 + hq * 128 + 8 * hi;
            bf16x8 kf0[8], kf1[8];
#pragma unroll
            for (int kk = 0; kk < 8; ++kk) { kf0[kk] = *(const bf16x8*)(kp + 16 * kk); kf1[kk] = *(const bf16x8*)(kp + (size_t)32 * GDN_PITCH + 16 * kk); }
#pragma unroll
            for (int kk = 0; kk < 8; ++kk) {
                a00 = __builtin_amdgcn_mfma_f32_32x32x16_bf16(kf0[kk], kf0[kk], a00, 0, 0, 0);
                a10 = __builtin_amdgcn_mfma_f32_32x32x16_bf16(kf1[kk], kf0[kk], a10, 0, 0, 0);
                a11 = __builtin_amdgcn_mfma_f32_32x32x16_bf16(kf1[kk], kf1[kk], a11, 0, 0, 0);
            }
        }
        asm volatile("s_waitcnt lgkmcnt(0)" ::: "memory");
        {
            const float gcj0 = aux[r32], gcj1 = aux[32 + r32];
#pragma unroll
            for (int r = 0; r < 16; ++r) {
                const int i0 = crow(r, hi), i1 = 32 + i0;
                const float gi0 = aux[i0], gi1 = aux[i1], bi0 = aux[64 + i0], bi1 = aux[64 + i1];
                Lw[i0 * 64 + r32] = (i0 > r32) ? bi0 * a00[r] * __expf(gi0 - gcj0) : 0.f;
                Lw[i1 * 64 + r32] = bi1 * a10[r] * __expf(gi1 - gcj0);
                Lw[i1 * 64 + 32 + r32] = (i0 > r32) ? bi1 * a11[r] * __expf(gi1 - gcj1) : 0.f;
            }
        }
        asm volatile("s_waitcnt lgkmcnt(0)" ::: "memory");
        float X[64];
#pragma unroll
        for (int i = 0; i < 64; ++i) {
            float xi = (lane == i) ? 1.f : 0.f, xj = 0.f;
#pragma unroll
            for (int g4 = 0; g4 < (i + 3) / 4; ++g4) {
                const f32x4 l = *(const LAS f32x4*)(Lw + i * 64 + 4 * g4);
#pragma unroll
                for (int e = 0; e < 4; ++e) { const int j = 4 * g4 + e; if (j < i) { if (j & 1) xj -= l[e] * X[j]; else xi -= l[e] * X[j]; } }
            }
            X[i] = xi + xj;
            asm volatile("" ::: "memory");
        }
        bf16_t* To = Tbuf + (size_t)((b * 16 + hv) * 64 + chunk) * 4096 + lane;
#pragma unroll
        for (int i = 0; i < 64; ++i) To[i * 64] = (bf16_t)f2bf(X[i]);
        asm volatile("s_waitcnt lgkmcnt(0)" ::: "memory");
    }
}

namespace g2 {
constexpr int QN = 0, KN = 18432, KNT = 35840, VT = 54272, RT = 72704, ST = 91136, TL = 125952, ATT = 135168, AUX = 144384;
constexpr int P128 = 272, P64 = 144;
__device__ __forceinline__ f32x16 mma(f32x16 acc, LAS const unsigned char* A, int ap, LAS const unsigned char* B, int bp, int nk, int r32, int hi) {
    LAS const unsigned char* a = A + r32 * ap + 16 * hi; LAS const unsigned char* b = B + r32 * bp + 16 * hi;
#pragma unroll
    for (int kk = 0; kk < 8; ++kk) if (kk < nk) {
        const bf16x8 av = *(LAS const bf16x8*)(a + 32 * kk), bv = *(LAS const bf16x8*)(b + 32 * kk);
        acc = __builtin_amdgcn_mfma_f32_32x32x16_bf16(av, bv, acc, 0, 0, 0);
    }
    return acc;
}
}
__device__ __forceinline__ void gdn_g2(LAS unsigned char* lds, bf16_t* proj, const float* __restrict__ gb, const float* __restrict__ convw, const float* __restrict__ normw,
                                        const bf16_t* __restrict__ Tbuf, int unit0, int ustride, int tid, int wave, int lane) {
    using namespace g2;
    asm volatile("" : "+v"(lane), "+v"(tid));
    const int r32 = lane & 31, hi = lane >> 5, ti = wave & 1, tj = wave >> 1;
    LAS float* aux = (LAS float*)(lds + AUX);
    for (int unit = unit0; unit < NB * 16; unit += ustride) {
        const int b = unit >> 4, hv = unit & 15, hq = hv >> 1;
        const int colq = hq * 128 + 2 * lane, colk = 1024 + colq, colv = 2048 + hv * 128 + 2 * lane, colz = 4096 + hv * 128 + 2 * lane;
        const float nw0 = normw[2 * lane], nw1 = normw[2 * lane + 1];
        f32x16 S0 = {}, S1 = {};
        for (int i = tid; i < 34816 / 4; i += 512) ((LAS unsigned*)(lds + ST))[i] = 0u;
        unsigned xq[8], xk[8], xv[8];
#define G2_LOADX(CH) do { _Pragma("unroll") for (int r = 0; r < 8; ++r) { const bf16_t* p = proj + (size_t)((long)b * SEQ + (CH) * 64 + 8 * wave + r) * GDN_PITCH; \
            xq[r] = *(const unsigned*)(p + colq); xk[r] = *(const unsigned*)(p + colk); xv[r] = *(const unsigned*)(p + colv); } } while (0)
        G2_LOADX(0);
        for (int chunk = 0; chunk < 64; ++chunk) {
            const size_t rowb = (size_t)b * SEQ + chunk * 64;
            unsigned zreg[8]; u32x4 treg;
            {
#pragma unroll
                for (int r = 0; r < 8; ++r) zreg[r] = *(const unsigned*)(proj + (rowb + 8 * wave + r) * GDN_PITCH + colz);
                treg = *(const u32x4*)(Tbuf + (size_t)((b * 16 + hv) * 64 + chunk) * 4096 + (tid >> 3) * 64 + (tid & 7) * 8);
#pragma unroll
                for (int r = 0; r < 8; ++r) {
                    *(LAS unsigned*)(lds + QN + (8 * wave + r) * P128 + 4 * lane) = xq[r];
                    *(LAS unsigned*)(lds + KN + (8 * wave + r) * P128 + 4 * lane) = xk[r];
                }
#define PKLO(a, b) (((a) & 0xffffu) | ((b) << 16))
#define PKHI(a, b) (((a) >> 16) | ((b) & 0xffff0000u))
                *(LAS u32x4*)(lds + KNT + (2 * lane) * P64 + 16 * wave) = (u32x4){PKLO(xk[0], xk[1]), PKLO(xk[2], xk[3]), PKLO(xk[4], xk[5]), PKLO(xk[6], xk[7])};
                *(LAS u32x4*)(lds + KNT + (2 * lane + 1) * P64 + 16 * wave) = (u32x4){PKHI(xk[0], xk[1]), PKHI(xk[2], xk[3]), PKHI(xk[4], xk[5]), PKHI(xk[6], xk[7])};
                *(LAS u32x4*)(lds + VT + (2 * lane) * P64 + 16 * wave) = (u32x4){PKLO(xv[0], xv[1]), PKLO(xv[2], xv[3]), PKLO(xv[4], xv[5]), PKLO(xv[6], xv[7])};
                *(LAS u32x4*)(lds + VT + (2 * lane + 1) * P64 + 16 * wave) = (u32x4){PKHI(xv[0], xv[1]), PKHI(xv[2], xv[3]), PKHI(xv[4], xv[5]), PKHI(xv[6], xv[7])};
                if (wave == 0) {
                    const float g = gb[(rowb + lane) * 32 + 16 + hv], bt = gb[(rowb + lane) * 32 + hv];
                    const float gl = __builtin_bit_cast(float, __builtin_amdgcn_readlane(__builtin_bit_cast(int, g), 63));
                    aux[lane] = g; aux[64 + lane] = bt; aux[128 + lane] = __expf(g); aux[192 + lane] = __expf(gl - g);
                    if (lane == 0) aux[256] = __expf(gl);
                }
            }
            __syncthreads();
            if (chunk < 63) G2_LOADX(chunk + 1);
            if (wave < 4) {
                const int si = wave & 1, tq = wave >> 1;
                f32x16 p = {};
                p = mma(p, lds + KN + 32 * si * P128, P128, lds + QN + 32 * tq * P128, P128, 8, r32, hi);
                const int t = 32 * tq + r32; const float gt = aux[t];
#pragma unroll
                for (int g4 = 0; g4 < 4; ++g4) {
                    float a[4];
#pragma unroll
                    for (int e = 0; e < 4; ++e) { const int s = 32 * si + 8 * g4 + 4 * hi + e; a[e] = (s <= t) ? p[4 * g4 + e] * __expf(gt - aux[s]) : 0.f; }
                    *(LAS u32x2*)(lds + ATT + t * P64 + (32 * si + 8 * g4 + 4 * hi) * 2) = (u32x2){cvt_pk_bf16(a[0], a[1]), cvt_pk_bf16(a[2], a[3])};
                }
            }
            f32x16 o1 = {};
            {
                f32x16 acc = {};
                acc = mma(acc, lds + KN + 32 * ti * P128, P128, lds + ST + 32 * tj * P128, P128, 8, r32, hi);
                o1 = mma(o1, lds + QN + 32 * ti * P128, P128, lds + ST + 32 * tj * P128, P128, 8, r32, hi);
                const int dv = 32 * tj + r32;
#pragma unroll
                for (int g4 = 0; g4 < 4; ++g4) {
                    const int t0 = 32 * ti + 8 * g4 + 4 * hi;
                    const u32x2 vv = *(LAS const u32x2*)(lds + VT + dv * P64 + t0 * 2);
                    const float v4[4] = {bflo(vv.x), bfhi(vv.x), bflo(vv.y), bfhi(vv.y)};
                    float rr[4];
#pragma unroll
                    for (int e = 0; e < 4; ++e) { const float eg = aux[128 + t0 + e]; rr[e] = aux[64 + t0 + e] * (v4[e] - eg * acc[4 * g4 + e]); o1[4 * g4 + e] *= eg; }
                    *(LAS u32x2*)(lds + RT + dv * P64 + t0 * 2) = (u32x2){cvt_pk_bf16(rr[0], rr[1]), cvt_pk_bf16(rr[2], rr[3])};
                }
            }
            *(LAS u32x4*)(lds + TL + (tid >> 3) * P64 + (tid & 7) * 16) = treg;
            __syncthreads();
            {
                f32x16 acc = {};
                acc = mma(acc, lds + TL + 32 * ti * P64, P64, lds + RT + 32 * tj * P64, P64, 4, r32, hi);
                const int dv = 32 * tj + r32;
#pragma unroll
                for (int g4 = 0; g4 < 4; ++g4) {
                    const int t0 = 32 * ti + 8 * g4 + 4 * hi;
                    float s4[4];
#pragma unroll
                    for (int e = 0; e < 4; ++e) s4[e] = acc[4 * g4 + e] * aux[192 + t0 + e];
                    *(LAS u32x2*)(lds + VT + dv * P64 + t0 * 2) = (u32x2){cvt_pk_bf16(acc[4 * g4], acc[4 * g4 + 1]), cvt_pk_bf16(acc[4 * g4 + 2], acc[4 * g4 + 3])};
                    *(LAS u32x2*)(lds + QN + dv * P64 + t0 * 2) = (u32x2){cvt_pk_bf16(s4[0], s4[1]), cvt_pk_bf16(s4[2], s4[3])};
                }
            }
            __syncthreads();
            {
                o1 = mma(o1, lds + ATT + 32 * ti * P64, P64, lds + VT + 32 * tj * P64, P64, 4, r32, hi);
                const int dv = 32 * tj + r32;
#pragma unroll
                for (int r = 0; r < 16; ++r) { const int t = 32 * ti + crow(r, hi); *(LAS unsigned short*)(lds + RT + t * P128 + dv * 2) = (unsigned short)f2bf(o1[r]); }
                const float egl = aux[256];
                S0 = S0 * egl; S1 = S1 * egl;
                S0 = mma(S0, lds + KNT + 32 * (2 * ti) * P64, P64, lds + QN + 32 * tj * P64, P64, 4, r32, hi);
                S1 = mma(S1, lds + KNT + 32 * (2 * ti + 1) * P64, P64, lds + QN + 32 * tj * P64, P64, 4, r32, hi);
#pragma unroll
                for (int g4 = 0; g4 < 4; ++g4) {
                    const int d0 = 8 * g4 + 4 * hi;
                    *(LAS u32x2*)(lds + ST + dv * P128 + (64 * ti + d0) * 2) = (u32x2){cvt_pk_bf16(S0[4 * g4], S0[4 * g4 + 1]), cvt_pk_bf16(S0[4 * g4 + 2], S0[4 * g4 + 3])};
                    *(LAS u32x2*)(lds + ST + dv * P128 + (64 * ti + 32 + d0) * 2) = (u32x2){cvt_pk_bf16(S1[4 * g4], S1[4 * g4 + 1]), cvt_pk_bf16(S1[4 * g4 + 2], S1[4 * g4 + 3])};
                }
            }
            __syncthreads();
#pragma unroll
            for (int r = 0; r < 8; ++r) {
                const int t = 8 * wave + r;
                const unsigned ov = *(LAS const unsigned*)(lds + RT + t * P128 + 4 * lane);
                const float oa = bflo(ov), ob = bfhi(ov);
                const float rstd = __builtin_amdgcn_rsqf(wave_sum(oa * oa + ob * ob) * (1.f / 128.f) + EPS);
                bf16_t* prow = proj + (rowb + t) * GDN_PITCH;
                const unsigned zv = zreg[r];
                *(unsigned*)(prow + colv) = cvt_pk_bf16(oa * rstd * nw0 * silu_f(bflo(zv)), ob * rstd * nw1 * silu_f(bfhi(zv)));
            }
        }
        __syncthreads();
    }
}

template <bool MASK> __device__ __forceinline__ void sb_tile(LAS const unsigned char* kb, LAS const unsigned char* vb, const bf16x8 (&qr)[4], const bf16x8 (&Uf)[2],
                                                            f32x16& oT0, f32x16& oT1, float& carry, const int s0, const int tq, const int r32, const int hi) {
    constexpr int P = 144;
    f32x16 p0 = {}, p1 = {};
#pragma unroll
    for (int kk = 0; kk < 4; ++kk) {
        const bf16x8 k0 = *(LAS const bf16x8*)(kb + r32 * P + (16 * kk + 8 * hi) * 2), k1 = *(LAS const bf16x8*)(kb + (32 + r32) * P + (16 * kk + 8 * hi) * 2);
        p0 = __builtin_amdgcn_mfma_f32_32x32x16_bf16(k0, qr[kk], p0, 0, 0, 0);
        p1 = __builtin_amdgcn_mfma_f32_32x32x16_bf16(k1, qr[kk], p1, 0, 0, 0);
    }
    float lk0[16], lk1[16]; float cs0 = 0.f, cs1 = 0.f;
#pragma unroll
    for (int r = 0; r < 16; ++r) {
        const float y0 = p0[r], y1 = p1[r];
        const float sp0 = fmaxf(y0, 0.f) + __builtin_amdgcn_logf(1.f + __builtin_amdgcn_exp2f(-fabsf(y0)));
        const float sp1 = fmaxf(y1, 0.f) + __builtin_amdgcn_logf(1.f + __builtin_amdgcn_exp2f(-fabsf(y1)));
        p0[r] = y0 - sp0; p1[r] = y1 - sp1;
        if (MASK) { const int s = s0 + crow(r, hi); lk0[r] = (s < tq) ? -sp0 : 0.f; lk1[r] = (s + 32 < tq) ? -sp1 : 0.f; }
        else { lk0[r] = -sp0; lk1[r] = -sp1; }
        cs0 += lk0[r]; cs1 += lk1[r];
    }
    cs0 += __shfl_xor(cs0, 32); cs1 += __shfl_xor(cs1, 32);
    f32x16 R0, R1;
#pragma unroll
    for (int r = 0; r < 16; ++r) { R0[r] = carry + cs1; R1[r] = carry; }
#pragma unroll
    for (int kk = 0; kk < 4; ++kk) {
        u32x4 w;
        if (kk < 2) { w.x = cvt_pk_bf16(lk0[8 * kk], lk0[8 * kk + 1]); w.y = cvt_pk_bf16(lk0[8 * kk + 2], lk0[8 * kk + 3]); w.z = cvt_pk_bf16(lk0[8 * kk + 4], lk0[8 * kk + 5]); w.w = cvt_pk_bf16(lk0[8 * kk + 6], lk0[8 * kk + 7]); }
        else { const int q = 8 * (kk - 2); w.x = cvt_pk_bf16(lk1[q], lk1[q + 1]); w.y = cvt_pk_bf16(lk1[q + 2], lk1[q + 3]); w.z = cvt_pk_bf16(lk1[q + 4], lk1[q + 5]); w.w = cvt_pk_bf16(lk1[q + 6], lk1[q + 7]); }
        const bf16x8 lf = __builtin_bit_cast(bf16x8, w);
        if (kk < 2) R0 = __builtin_amdgcn_mfma_f32_32x32x16_bf16(Uf[kk], lf, R0, 0, 0, 0);
        else R1 = __builtin_amdgcn_mfma_f32_32x32x16_bf16(Uf[kk - 2], lf, R1, 0, 0, 0);
    }
    const float csum = cs0 + cs1;
    carry += csum;
#pragma unroll
    for (int r = 0; r < 16; ++r) {
        float a0 = __builtin_amdgcn_exp2f(p0[r] + R0[r]), a1 = __builtin_amdgcn_exp2f(p1[r] + R1[r]);
        if (MASK) { const int s = s0 + crow(r, hi); a0 = (s < tq) ? a0 : 0.f; a1 = (s + 32 < tq) ? a1 : 0.f; }
        lk0[r] = a0; lk1[r] = a1;
    }
#pragma unroll
    for (int kk = 0; kk < 4; ++kk) {
        u32x4 w;
        if (kk < 2) { w.x = cvt_pk_bf16(lk0[8 * kk], lk0[8 * kk + 1]); w.y = cvt_pk_bf16(lk0[8 * kk + 2], lk0[8 * kk + 3]); w.z = cvt_pk_bf16(lk0[8 * kk + 4], lk0[8 * kk + 5]); w.w = cvt_pk_bf16(lk0[8 * kk + 6], lk0[8 * kk + 7]); }
        else { const int q = 8 * (kk - 2); w.x = cvt_pk_bf16(lk1[q], lk1[q + 1]); w.y = cvt_pk_bf16(lk1[q + 2], lk1[q + 3]); w.z = cvt_pk_bf16(lk1[q + 4], lk1[q + 5]); w.w = cvt_pk_bf16(lk1[q + 6], lk1[q + 7]); }
        const bf16x8 af = __builtin_bit_cast(bf16x8, w);
        const u32x2 a0 = *(LAS const u32x2*)(vb + r32 * P + (16 * kk + 4 * hi) * 2), a1 = *(LAS const u32x2*)(vb + r32 * P + (16 * kk + 8 + 4 * hi) * 2);
        const u32x2 b0 = *(LAS const u32x2*)(vb + (32 + r32) * P + (16 * kk + 4 * hi) * 2), b1 = *(LAS const u32x2*)(vb + (32 + r32) * P + (16 * kk + 8 + 4 * hi) * 2);
        const bf16x8 v0 = __builtin_bit_cast(bf16x8, (u32x4){a0.x, a0.y, a1.x, a1.y}), v1 = __builtin_bit_cast(bf16x8, (u32x4){b0.x, b0.y, b1.x, b1.y});
        oT0 = __builtin_amdgcn_mfma_f32_32x32x16_bf16(v0, af, oT0, 0, 0, 0);
        oT1 = __builtin_amdgcn_mfma_f32_32x32x16_bf16(v1, af, oT1, 0, 0, 0);
    }
}
__device__ __forceinline__ void sb_attn(LAS unsigned char* lds, bf16_t* qkv, int blk, int G, int tid, int wave, int lane) {
    constexpr int KS = 0, VS = 18432, BUF = 9216, P = 144, LD = 3072;
    asm volatile("" : "+v"(lane), "+v"(tid));
    const int r32 = lane & 31, hi = lane >> 5;
    bf16x8 Uf[2];
#pragma unroll
    for (int kk = 0; kk < 2; ++kk)
#pragma unroll
        for (int e = 0; e < 8; ++e) { const int j = 16 * kk + 8 * (e >> 2) + 4 * hi + (e & 3); Uf[kk][e] = (j > r32) ? (short)0x3F80 : (short)0; }
    const int srow = tid >> 3, sch = tid & 7;
    for (int u = blk; u < 2048; u += G) {
        const int i = u >> 8, jj = u & 255, bh = jj & 127, half = jj >> 7, qb = 15 - 2 * i - (half ^ (i & 1));
        const int b = bh >> 4, h = bh & 15, q0 = qb * 256;
        const size_t rowb = (size_t)b * SEQ;
        const int tq = q0 + 32 * wave + r32;
        bf16_t* qptr = qkv + (rowb + tq) * LD + h * 64;
        bf16x8 qr[4];
#pragma unroll
        for (int kk = 0; kk < 4; ++kk) qr[kk] = *(const bf16x8*)(qptr + 16 * kk + 8 * hi);
        f32x16 oT0 = {}, oT1 = {};
        float carry = 0.f;
        const int ktmax = (q0 >> 6) + 3;
        const bf16_t* kbase = qkv + (rowb + srow) * LD + 1024 + h * 64 + sch * 8;
        u32x4 kreg = *(const u32x4*)(kbase + (size_t)ktmax * 64 * LD), vreg = *(const u32x4*)(kbase + (size_t)ktmax * 64 * LD + 1024);
        int cur = 0;
        __syncthreads();
        for (int kt = ktmax; kt >= 0; --kt) {
            LAS unsigned char* kb = lds + KS + cur * BUF; LAS unsigned char* vb = lds + VS + cur * BUF;
            *(LAS u32x4*)(kb + srow * P + sch * 16) = kreg;
#pragma unroll
            for (int e = 0; e < 4; ++e) {
                *(LAS unsigned short*)(vb + (sch * 8 + 2 * e) * P + srow * 2) = (unsigned short)(vreg[e] & 0xffffu);
                *(LAS unsigned short*)(vb + (sch * 8 + 2 * e + 1) * P + srow * 2) = (unsigned short)(vreg[e] >> 16);
            }
            __syncthreads();
            if (kt > 0) { kreg = *(const u32x4*)(kbase + (size_t)(kt - 1) * 64 * LD); vreg = *(const u32x4*)(kbase + (size_t)(kt - 1) * 64 * LD + 1024); }
            const int s0 = kt * 64, tmin = q0 + 32 * wave;
            if (s0 < tmin + 31) {
                if (s0 + 63 >= tmin) sb_tile<true>(kb, vb, qr, Uf, oT0, oT1, carry, s0, tq, r32, hi);
                else sb_tile<false>(kb, vb, qr, Uf, oT0, oT1, carry, s0, tq, r32, hi);
            }
            cur ^= 1;
        }
#pragma unroll
        for (int g4 = 0; g4 < 4; ++g4) {
            const int d0 = 8 * g4 + 4 * hi;
            *(u32x2*)(qptr + d0) = (u32x2){cvt_pk_bf16(oT0[4 * g4], oT0[4 * g4 + 1]), cvt_pk_bf16(oT0[4 * g4 + 2], oT0[4 * g4 + 3])};
            *(u32x2*)(qptr + 32 + d0) = (u32x2){cvt_pk_bf16(oT1[4 * g4], oT1[4 * g4 + 1]), cvt_pk_bf16(oT1[4 * g4 + 2], oT1[4 * g4 + 3])};
        }
    }
}

struct Args { const float* in[15]; float* out; unsigned char* ws; };
template <bool gdn> __device__ __forceinline__ void conv_mixer_weights(const Args& a, const int layer, LAS float* scr, int gw, int NGW, int lane) {
    const int j = layer >> 1;
    const float* w_in = gdn ? a.in[1] + (size_t)j * DM * GDN_N : a.in[7] + (size_t)j * DM * 3072;
    const float* w_out = gdn ? a.in[6] + (size_t)j * 2048 * DM : a.in[8] + (size_t)j * DM * DM;
    constexpr int n_in = gdn ? GDN_N : 3072, k_out = gdn ? 2048 : 1024;
    constexpr int I_in = (DM / 64) * (n_in / 32), I_out = (k_out / 64) * (DM / 32);
    bf16_t* Win_t = (bf16_t*)(a.ws + WS_WIN); bf16_t* Wout_t = (bf16_t*)(a.ws + WS_WOUT);
    for (int it = gw; it < I_in + I_out; it += NGW) {
        if (it < I_in) conv_plain(w_in, DM, n_in, Win_t, it, scr, lane, a.in[9] + layer * DM);
        else conv_plain(w_out, k_out, DM, Wout_t, it - I_in, scr, lane, nullptr);
    }
}
__device__ __forceinline__ void conv_gu_weights(const Args& a, const int layer, LAS float* scr, int gw, int NGW, int lane) {
    constexpr int I_g = (DM / 64) * (FF / 32);
    bf16_t* Wgu_t = (bf16_t*)(a.ws + WS_WGU);
    const float* wg = a.in[11] + (size_t)layer * DM * FF; const float* wu = a.in[12] + (size_t)layer * DM * FF;
    for (int it = gw; it < 2 * I_g; it += NGW) {
        if (it < I_g) conv_gu(wg, Wgu_t, it, 0, scr, lane, a.in[10] + layer * DM);
        else conv_gu(wu, Wgu_t, it - I_g, 1, scr, lane, a.in[10] + layer * DM);
    }
}
__device__ __forceinline__ void conv_dn_weights(const Args& a, const int layer, LAS float* scr, int gw, int NGW, int lane) {
    constexpr int I_d = (FF / 64) * (DM / 32);
    bf16_t* Wdn_t = (bf16_t*)(a.ws + WS_WDN);
    const float* wd = a.in[13] + (size_t)layer * FF * DM;
    for (int it = gw; it < I_d; it += NGW) conv_plain(wd, FF, DM, Wdn_t, it, scr, lane, nullptr);
}
__device__ __forceinline__ void zero_ssq(float* p) { int g = blockIdx.x * 512 + threadIdx.x; asm volatile("" : "+v"(g)); if (g < M_TOK) p[g] = 0.f; }

template <bool gdn> __device__ __forceinline__ void layer_body(const Args& a, const int layer, LAS unsigned char* lds, cg::grid_group& grid) {
#define LB_IDS() int tid = threadIdx.x; asm volatile("" : "+v"(tid)); const int lane = tid & 63, wave = __builtin_amdgcn_readfirstlane(tid >> 6); \
        const int G = gridDim.x, blk = blockIdx.x, gw = blk * 8 + wave, NGW = G * 8; (void)lane; (void)gw; (void)NGW; (void)G; (void)blk;
#define LB_PTRS() bf16_t* Win_t = (bf16_t*)(a.ws + WS_WIN); bf16_t* Wout_t = (bf16_t*)(a.ws + WS_WOUT); bf16_t* Wgu_t = (bf16_t*)(a.ws + WS_WGU); bf16_t* Wdn_t = (bf16_t*)(a.ws + WS_WDN); \
        float* gb = (float*)(a.ws + WS_GB); bf16_t* H = (bf16_t*)(a.ws + WS_H); bf16_t* PROJ = (bf16_t*)(a.ws + WS_PROJ); float* out = a.out; const float* xcur = (layer == 0) ? a.in[0] : a.out; \
        float* ssqA = (float*)(a.ws + WS_SSQ); float* ssqB = ssqA + (size_t)M_TOK * 16; \
        (void)Win_t; (void)Wout_t; (void)Wgu_t; (void)Wdn_t; (void)gb; (void)H; (void)PROJ; (void)out; (void)xcur; (void)ssqA; (void)ssqB;
        const int j = layer >> 1;
        {
            LB_IDS(); LB_PTRS();
            if (layer > 0) { conv_dn_weights(a, layer, (LAS float*)(lds + wave * 16384), gw, NGW, lane); __syncthreads(); }
            pg8::Gemm g{H, Win_t, M_TOK, gdn ? GDN_NP : 3072, DM, DM}; pg8::StaticOrder S; S.init(M_TOK, g.N, G, blk);
            EpiProj E{PROJ, gdn ? GDN_PITCH : 3072, gdn ? 24 : -1, gb, a.in[3] + j * 16, a.in[4] + j * 16, gdn ? 0 : 4, 0.125f * 1.4426950408889634f, ssqA};
#if !defined(NO_GEMM) && !defined(NO_P2)
            pg8::gemm_phase<EpiProj, pg8::StaticOrder, true, true>(lds, g, S, E);
#endif
        }
        grid.sync();
        if constexpr (gdn) {
            LB_IDS(); LB_PTRS();
            const float* convw = a.in[2] + (size_t)j * 4096 * 4;
            gdn_g0(lds, PROJ, convw, blk, G, tid, wave, lane);
            grid.sync();
#ifndef NO_G1
            gdn_g1(lds, PROJ, gb, gb, convw, H, gw, NGW, wave, lane);
#endif
            grid.sync();
#ifndef NO_G2
            gdn_g2(lds, PROJ, gb, convw, a.in[5] + j * 128, H, blk, G, tid, wave, lane);
#endif
        } else {
            LB_IDS(); LB_PTRS();
#ifndef NO_SB
            sb_attn(lds, PROJ, blk, G, tid, wave, lane);
#endif
        }
        grid.sync();
        {
            LB_IDS(); LB_PTRS();
            pg8::Gemm g{gdn ? PROJ + 2048 : PROJ, Wout_t, M_TOK, DM, gdn ? 2048 : 1024, gdn ? GDN_PITCH : 3072}; pg8::StaticOrder S; S.init(M_TOK, DM, G, blk);
            EpiRes E{xcur, out, DM, H, ssqB};
#if !defined(NO_GEMM) && !defined(NO_P4)
            pg8::gemm_phase<EpiRes, pg8::StaticOrder, true, true>(lds, g, S, E);
#endif
        }
        grid.sync();
        {
            LB_IDS(); LB_PTRS();
            if (layer < 3) { conv_mixer_weights<!gdn>(a, layer + 1, (LAS float*)(lds + wave * 16384), gw, NGW, lane); __syncthreads(); }
            pg8::Gemm g{H, Wgu_t, M_TOK, 2 * FF, DM, DM}; pg8::StaticOrder S; S.init(M_TOK, 2 * FF, G, blk);
            EpiSwiglu E{PROJ, FF, ssqB};
#if !defined(NO_GEMM) && !defined(NO_P6)
            pg8::gemm_phase<EpiSwiglu, pg8::StaticOrder, true, true>(lds, g, S, E);
#endif
        }
        grid.sync();
        {
            LB_IDS(); LB_PTRS();
            if (layer < 3) { conv_gu_weights(a, layer + 1, (LAS float*)(lds + wave * 16384), gw, NGW, lane); __syncthreads(); }
            pg8::Gemm g{PROJ, Wdn_t, M_TOK, DM, FF, FF}; pg8::StaticOrder S; S.init(M_TOK, DM, G, blk);
            EpiRes E{out, out, DM, H, ssqA};
#if !defined(NO_GEMM) && !defined(NO_P7)
            pg8::gemm_phase<EpiRes, pg8::StaticOrder, true, true>(lds, g, S, E);
#endif
        }
        grid.sync();
}

__global__ void __launch_bounds__(512, 2) fwd(Args a) {
    extern __shared__ __attribute__((aligned(16))) unsigned char lds_raw[];
    LAS unsigned char* lds = (LAS unsigned char*)lds_raw;
    cg::grid_group grid = cg::this_grid();
    {
        int tid = threadIdx.x; asm volatile("" : "+v"(tid)); const int lane = tid & 63, wave = __builtin_amdgcn_readfirstlane(tid >> 6);
        const int gw = blockIdx.x * 8 + wave, NGW = gridDim.x * 8; LAS float* scr = (LAS float*)(lds + wave * 16384);
        conv_mixer_weights<true>(a, 0, scr, gw, NGW, lane); conv_gu_weights(a, 0, scr, gw, NGW, lane); conv_dn_weights(a, 0, scr, gw, NGW, lane);
        xb_rows(a.in[0], (bf16_t*)(a.ws + WS_H), (float*)(a.ws + WS_SSQ), gw, NGW, lane);
    }
    grid.sync();
#ifdef ONE_LAYER
    layer_body<false>(a, 1, lds, grid);
#else
    for (int lp = 0; lp < 2; ++lp) {
        layer_body<true>(a, 2 * lp, lds, grid);
        layer_body<false>(a, 2 * lp + 1, lds, grid);
    }
#endif
#ifndef NO_FINAL
    { int tid = threadIdx.x; asm volatile("" : "+v"(tid)); const int lane = tid & 63, wave = __builtin_amdgcn_readfirstlane(tid >> 6); final_norm_rows(a.out, a.in[14], (const float*)(a.ws + WS_SSQ), blockIdx.x * 8 + wave, gridDim.x * 8, lane); }
#endif
}

extern "C" void kernel_launch(void* const* d_in, const int* in_sizes, int n_in, void* d_out, int out_size, void* d_ws, size_t ws_size, hipStream_t stream) {
    static int grid = 0;
    if (grid == 0) {
        if (n_in != 15 || out_size != M_TOK * DM || ws_size < WS_END) { fprintf(stderr, "kernel_launch: unexpected shapes (n_in %d out %d ws %zu)\n", n_in, out_size, ws_size); grid = -1; return; }
        int dev = 0, cus = 0, per_cu = 0;
        hipGetDevice(&dev); hipDeviceGetAttribute(&cus, hipDeviceAttributeMultiprocessorCount, dev);
        hipFuncSetAttribute((const void*)fwd, hipFuncAttributeMaxDynamicSharedMemorySize, LDS_BYTES);
        hipOccupancyMaxActiveBlocksPerMultiprocessor(&per_cu, (const void*)fwd, 512, LDS_BYTES);
        if (per_cu < 1) per_cu = 1;
        grid = cus * per_cu;
        (void)hipGetLastError();
    }
    if (grid < 0) return;
    Args a{};
    for (int i = 0; i < 15; ++i) a.in[i] = (const float*)d_in[i];
    a.out = (float*)d_out; a.ws = (unsigned char*)d_ws;
    void* args[] = {&a};
    hipError_t e = hipLaunchCooperativeKernel((const void*)fwd, dim3(grid), dim3(512), args, LDS_BYTES, stream);
    if (e != hipSuccess) fprintf(stderr, "cooperative launch failed: %s (grid %d)\n", hipGetErrorString(e), grid);
}
```

```cpp
#include <hip/hip_runtime.h>
#include <hip/hip_cooperative_groups.h>
#include <cstdio>
#include <cstdint>
namespace cg = cooperative_groups;
namespace pg8 {
#define PG8_LAS __attribute__((address_space(3)))
typedef unsigned short bf16_t;
typedef short bf16x8 __attribute__((ext_vector_type(8)));
typedef float f32x4 __attribute__((ext_vector_type(4)));
typedef unsigned u32x4 __attribute__((ext_vector_type(4)));
constexpr int BM = 256, BK = 64, HALF = 128, HTB = HALF * BK * 2  , STAGE_BYTES = 8 * HTB, NXCD = 8;

__host__ __device__ __forceinline__ int lds_byte(int r, int c) { const int st = (r >> 4) * 2 + (c >> 5), rr = r & 15, cc = c & 31, ob = rr * 64 + cc * 2; return st * 1024 + (ob ^ (((ob >> 9) & 1) << 5)); }
__host__ __device__ __forceinline__ void stage_rc(int b, int& R, int& C) { const int st = b / 1024, sb = b % 1024, swz = sb ^ (((sb >> 9) & 1) << 5); R = (st >> 1) * 16 + swz / 64; C = (st & 1) * 32 + (swz % 64) / 2; }
__host__ __device__ __forceinline__ int perm32(int rho) { const int n = rho >> 4, i = rho & 15; return 8 * (i >> 2) + 4 * n + (i & 3); }

struct Unit { int pm, pn; };
struct Gemm { const bf16_t* A; const bf16_t* Bt; int M, N, K, lda; };

struct StaticOrder {
    int nM, nN, nwg, G, c, WGM;
    __host__ __device__ void init(int M, int N, int G_, int c_, int wgm = 4) { nM = M / BM; nN = N / BM; nwg = nM * nN; G = G_; c = c_; WGM = wgm; }
    __host__ __device__ bool next(int i, Unit& u) const {
        const long L = (long)i * G + c; if (L >= nwg) return false;
        int wgid = (int)L; { const int q = nwg / NXCD, r = nwg % NXCD, xcd = wgid % NXCD, off = wgid / NXCD; wgid = (xcd < r ? xcd * (q + 1) : r * (q + 1) + (xcd - r) * q) + off; }
        const int nig = WGM * nN, gid = wgid / nig, fm = gid * WGM, gsz = (nM - fm) < WGM ? (nM - fm) : WGM;
        u.pm = fm + ((wgid % nig) % gsz); u.pn = (wgid % nig) / gsz; return true;
    }
    __device__ __forceinline__ void a_ready(const Unit&) const {}
    __device__ __forceinline__ void done(const Unit&) const {}
};

typedef float f32x2_cv __attribute__((ext_vector_type(2))); typedef __bf16 bf16x2_cv __attribute__((ext_vector_type(2)));
__device__ __forceinline__ unsigned cvt_pk_bf16(float lo, float hi) { const f32x2_cv v = {lo, hi}; return __builtin_bit_cast(unsigned, __builtin_convertvector(v, bf16x2_cv)); }
typedef float f32x2 __attribute__((ext_vector_type(2)));
template <class Epi, class Sched, bool ALIGN_EPI = false, bool SP2 = false>
__device__ __forceinline__ void gemm_phase(PG8_LAS unsigned char* lds, const Gemm g, const Sched& S, const Epi& E) {
    int tid_l = threadIdx.x; asm volatile("" : "+v"(tid_l));
    const int tid = tid_l, wid = __builtin_amdgcn_readfirstlane(tid >> 6), lane = tid & 63, wr = wid >> 2, wc = wid & 3, fr = lane & 15, fq = lane >> 4;
    const int K = g.K, nt = K / BK;
    unsigned voffA[2], voffB[2];
#pragma unroll
    for (int i = 0; i < 2; ++i) { int R, C; stage_rc(tid * 16 + i * 8192, R, C); const int Rb = Epi::PERM ? ((R & ~31) + perm32(R & 31)) : R;
        voffA[i] = (unsigned)(R * g.lda + C) * 2u; voffB[i] = (unsigned)(Rb * K + C) * 2u; }
    const size_t kstep = (size_t)(BK * 2);
    const size_t hstepA = (size_t)HALF * g.lda * 2, hstepB = (size_t)HALF * K * 2;
    const size_t tstepA = 2 * hstepA, tstepB = 2 * hstepB;
    const unsigned ldsw = (unsigned)wid * 1024u;
    const int aoff = lds_byte(wr * 64 + fr, fq * 8), boff = lds_byte(wc * 32 + fr, fq * 8);
#define PG8_SA(b, h) (((b) * 2 + (h)) * HTB)
#define PG8_SB(b, h) ((4 + (b) * 2 + (h)) * HTB)
#define PG8_STAGE(bufoff, gbase, voff) do { _Pragma("unroll") for (int _i = 0; _i < 2; ++_i) \
        __builtin_amdgcn_global_load_lds((const unsigned*)((const char*)(gbase) + (voff)[_i]), (PG8_LAS unsigned*)(lds + (bufoff) + ldsw + _i * 8192), 16, 0, 0); } while (0)
#define PG8_LDA(dst, b, h) do { _Pragma("unroll") for (int m = 0; m < 4; ++m) _Pragma("unroll") for (int k = 0; k < 2; ++k) dst[m][k] = *(const PG8_LAS bf16x8*)(lds + PG8_SA(b, h) + aoff + m * 2048 + k * 1024); } while (0)
#define PG8_LDB(dst, b, h) do { _Pragma("unroll") for (int n = 0; n < 2; ++n) _Pragma("unroll") for (int k = 0; k < 2; ++k) dst[n][k] = *(const PG8_LAS bf16x8*)(lds + PG8_SB(b, h) + boff + n * 2048 + k * 1024); } while (0)
#define PG8_MMA(ai, bj, At, Bt) do { __builtin_amdgcn_s_setprio(1); _Pragma("unroll") for (int m = 0; m < 4; ++m) _Pragma("unroll") for (int n = 0; n < 2; ++n) _Pragma("unroll") for (int k = 0; k < 2; ++k) \
        acc[ai][bj][m][n] = __builtin_amdgcn_mfma_f32_16x16x32_bf16(Bt[n][k], At[m][k], acc[ai][bj][m][n], 0, 0, 0); __builtin_amdgcn_s_setprio(0); } while (0)
#define PG8_WAIT_V(n) asm volatile("s_waitcnt vmcnt(" #n ")" ::: "memory")
#define PG8_WAIT_L(n) asm volatile("s_waitcnt lgkmcnt(" #n ")" ::: "memory")
#define PG8_BAR __builtin_amdgcn_s_barrier()
#define PG8_SCHED __builtin_amdgcn_sched_barrier(0)
    Unit cur, nxt; int ui = 0;
    if (!S.next(0, cur)) return;
    f32x4 acc[2][2][4][2];
#pragma unroll
    for (int a = 0; a < 2; ++a)
#pragma unroll
        for (int b = 0; b < 2; ++b)
#pragma unroll
            for (int m = 0; m < 4; ++m)
#pragma unroll
                for (int n = 0; n < 2; ++n) acc[a][b][m][n] = (f32x4){0.f, 0.f, 0.f, 0.f};
    bf16x8 At[4][2], B0[2][2], B1[2][2];
    const char* cA = (const char*)g.A + (size_t)cur.pm * tstepA; const char* cB = (const char*)g.Bt + (size_t)cur.pn * tstepB;
    S.a_ready(cur);
    if constexpr (SP2) {
        PG8_STAGE(PG8_SB(0, 0), cB, voffB); PG8_STAGE(PG8_SB(0, 1), cB + hstepB, voffB); PG8_STAGE(PG8_SA(0, 0), cA, voffA); PG8_STAGE(PG8_SA(0, 1), cA + hstepA, voffA);
        if (wr == 1) PG8_BAR;
        PG8_WAIT_V(2); PG8_BAR;
        PG8_STAGE(PG8_SB(1, 0), cB + kstep, voffB); PG8_STAGE(PG8_SA(1, 0), cA + kstep, voffA); PG8_STAGE(PG8_SB(1, 1), cB + hstepB + kstep, voffB);
        PG8_WAIT_V(6); PG8_BAR;
    } else {
        PG8_STAGE(PG8_SB(0, 0), cB, voffB); PG8_STAGE(PG8_SA(0, 0), cA, voffA); PG8_STAGE(PG8_SB(0, 1), cB + hstepB, voffB); PG8_STAGE(PG8_SA(0, 1), cA + hstepA, voffA);
        if (wr == 1) PG8_BAR;
        PG8_WAIT_V(4); PG8_BAR;
        PG8_STAGE(PG8_SB(1, 0), cB + kstep, voffB); PG8_STAGE(PG8_SA(1, 0), cA + kstep, voffA); PG8_STAGE(PG8_SB(1, 1), cB + hstepB + kstep, voffB);
        PG8_WAIT_V(6); PG8_BAR;
    }
    for (;;) {
        const bool has_next = S.next(ui + 1, nxt);
        const char* nA = has_next ? (const char*)g.A + (size_t)nxt.pm * tstepA : cA; const char* nB = has_next ? (const char*)g.Bt + (size_t)nxt.pn * tstepB : cB;
        for (int t = 0; t < nt; t += 2) {
            const bool last = (t == nt - 2);
            const char* a1 = cA + (size_t)(t + 1) * kstep;
            const char* a2 = last ? nA : cA + (size_t)(t + 2) * kstep; const char* b2 = last ? nB : cB + (size_t)(t + 2) * kstep;
            const char* a3 = a2 + kstep; const char* b3 = b2 + kstep;
            if (last && has_next) S.a_ready(nxt);
            if constexpr (SP2) {
            PG8_LDB(B0, 0, 0); PG8_LDB(B1, 0, 1); PG8_SCHED; PG8_LDA(At, 0, 0); PG8_STAGE(PG8_SA(1, 1), a1 + hstepA, voffA);
            PG8_WAIT_V(8); PG8_WAIT_L(0); PG8_BAR; PG8_MMA(0, 0, At, B0); PG8_MMA(0, 1, At, B1); PG8_BAR; PG8_SCHED;
            PG8_LDA(At, 0, 1); PG8_STAGE(PG8_SB(0, 0), b2, voffB); PG8_STAGE(PG8_SB(0, 1), b2 + hstepB, voffB); PG8_STAGE(PG8_SA(0, 0), a2, voffA);
            PG8_WAIT_V(8); PG8_WAIT_L(0); PG8_BAR; PG8_MMA(1, 0, At, B0); PG8_MMA(1, 1, At, B1); PG8_BAR; PG8_SCHED;
            PG8_LDB(B0, 1, 0); PG8_LDB(B1, 1, 1); PG8_SCHED; PG8_LDA(At, 1, 0); PG8_STAGE(PG8_SA(0, 1), a2 + hstepA, voffA);
            PG8_WAIT_V(8); PG8_WAIT_L(0); PG8_BAR; PG8_MMA(0, 0, At, B0); PG8_MMA(0, 1, At, B1); PG8_BAR; PG8_SCHED;
            PG8_LDA(At, 1, 1); PG8_STAGE(PG8_SB(1, 0), b3, voffB); PG8_STAGE(PG8_SB(1, 1), b3 + hstepB, voffB); PG8_STAGE(PG8_SA(1, 0), a3, voffA);
            PG8_WAIT_V(8); PG8_WAIT_L(0); PG8_BAR; PG8_MMA(1, 0, At, B0); PG8_MMA(1, 1, At, B1); PG8_BAR; PG8_SCHED;
            } else {
            PG8_LDB(B0, 0, 0); PG8_SCHED; PG8_LDA(At, 0, 0); PG8_STAGE(PG8_SA(1, 1), a1 + hstepA, voffA);
            PG8_WAIT_L(8); PG8_BAR; PG8_WAIT_L(0); PG8_MMA(0, 0, At, B0); PG8_BAR; PG8_SCHED;
            PG8_LDB(B1, 0, 1); PG8_STAGE(PG8_SB(0, 0), b2, voffB);
            PG8_BAR; PG8_WAIT_L(0); PG8_MMA(0, 1, At, B1); PG8_BAR;
            PG8_LDA(At, 0, 1); PG8_STAGE(PG8_SA(0, 0), a2, voffA);
            PG8_BAR; PG8_WAIT_L(0); PG8_MMA(1, 0, At, B0); PG8_BAR; PG8_SCHED;
            PG8_STAGE(PG8_SB(0, 1), b2 + hstepB, voffB);
            PG8_WAIT_V(6); PG8_BAR; PG8_MMA(1, 1, At, B1); PG8_BAR;
            PG8_LDB(B0, 1, 0); PG8_SCHED; PG8_LDA(At, 1, 0); PG8_STAGE(PG8_SA(0, 1), a2 + hstepA, voffA);
            PG8_WAIT_L(8); PG8_BAR; PG8_WAIT_L(0); PG8_MMA(0, 0, At, B0); PG8_BAR; PG8_SCHED;
            PG8_LDB(B1, 1, 1); PG8_STAGE(PG8_SB(1, 0), b3, voffB);
            PG8_BAR; PG8_WAIT_L(0); PG8_MMA(0, 1, At, B1); PG8_BAR;
            PG8_LDA(At, 1, 1); PG8_STAGE(PG8_SA(1, 0), a3, voffA);
            PG8_BAR; PG8_WAIT_L(0); PG8_MMA(1, 0, At, B0); PG8_BAR; PG8_SCHED;
            PG8_STAGE(PG8_SB(1, 1), b3 + hstepB, voffB);
            PG8_WAIT_V(6); PG8_BAR; PG8_MMA(1, 1, At, B1); PG8_BAR;
            }
        }
        if constexpr (ALIGN_EPI) { if (wr == 0) PG8_BAR; }
        if constexpr (!Epi::AFTER_DRAIN) { E(acc, cur, wr, wc, fr, fq); S.done(cur); }
        if (!has_next) break;
#pragma unroll
        for (int a = 0; a < 2; ++a)
#pragma unroll
            for (int b = 0; b < 2; ++b)
#pragma unroll
                for (int m = 0; m < 4; ++m)
#pragma unroll
                    for (int n = 0; n < 2; ++n) acc[a][b][m][n] = (f32x4){0.f, 0.f, 0.f, 0.f};
        cur = nxt; cA = nA; cB = nB; ++ui;
        if constexpr (ALIGN_EPI) { if (wr == 1) PG8_BAR; }
    }
    PG8_WAIT_V(0);
    if constexpr (!ALIGN_EPI) { if (wr == 0) PG8_BAR; }
    PG8_BAR;
    if constexpr (Epi::AFTER_DRAIN) { E.fused(acc, cur, wr, wc, fr, fq, lds, wid, lane); S.done(cur); }
#undef PG8_SA
#undef PG8_SB
#undef PG8_STAGE
#undef PG8_LDA
#undef PG8_LDB
#undef PG8_MMA
#undef PG8_WAIT_V
#undef PG8_WAIT_L
#undef PG8_BAR
#undef PG8_SCHED
}
}

constexpr int M_TOK = 32768, DM = 1024, SEQ = 4096, NB = 8;
constexpr int GDN_N = 6176, GDN_NP = 6400, GDN_PITCH = 6144, FF = 2816;
constexpr float EPS = 1e-6f;
#define LAS __attribute__((address_space(3)))
typedef unsigned short bf16_t;
typedef short bf16x8 __attribute__((ext_vector_type(8)));
typedef float f32x4 __attribute__((ext_vector_type(4)));
typedef float f32x16 __attribute__((ext_vector_type(16)));
typedef unsigned u32x4 __attribute__((ext_vector_type(4)));
typedef unsigned u32x2 __attribute__((ext_vector_type(2)));
using pg8::cvt_pk_bf16;

constexpr size_t MiB = 1u << 20;
constexpr size_t WS_WIN = 1 * MiB, WS_WOUT = 14 * MiB, WS_WGU = 18 * MiB, WS_WDN = 29 * MiB, WS_GB = 36 * MiB, WS_H = 40 * MiB, WS_PROJ = 104 * MiB, WS_SSQ = 488 * MiB, WS_ALT_WOUT = 492 * MiB, WS_ALT_WGU = 494 * MiB, WS_ALT_WDN = 505 * MiB, WS_END = 511 * MiB;
constexpr int LDS_BYTES = 147456 + 256, LDS_BARST = 147456;
#ifndef PROBE_ID
#define PROBE_ID 0
#endif
#define PH_T0(id) unsigned long long ph_t0_ = 0; if (PROBE_ID == (id)) ph_t0_ = __builtin_amdgcn_s_memrealtime();
#define PH_T1(id) if (PROBE_ID == (id)) probe_acc += __builtin_amdgcn_s_memrealtime() - ph_t0_;

__device__ __forceinline__ float bf2f(unsigned short b) { return __uint_as_float(((unsigned)b) << 16); }
__device__ __forceinline__ float bflo(unsigned u) { return __uint_as_float(u << 16); }
__device__ __forceinline__ float bfhi(unsigned u) { return __uint_as_float(u & 0xffff0000u); }
template <int CTRL> __device__ __forceinline__ float dpp_f(float v) { return __builtin_bit_cast(float, __builtin_amdgcn_update_dpp(0, __builtin_bit_cast(int, v), CTRL, 0xf, 0xf, true)); }
__device__ __forceinline__ float wave_sum(float v) {
    v += dpp_f<0xB1>(v); v += dpp_f<0x4E>(v); v += dpp_f<0x141>(v); v += dpp_f<0x140>(v);
    const int vi = __builtin_bit_cast(int, v);
    return (__builtin_bit_cast(float, __builtin_amdgcn_readlane(vi, 0)) + __builtin_bit_cast(float, __builtin_amdgcn_readlane(vi, 16))) +
           (__builtin_bit_cast(float, __builtin_amdgcn_readlane(vi, 32)) + __builtin_bit_cast(float, __builtin_amdgcn_readlane(vi, 48)));
}
__device__ __forceinline__ float silu_f(float v) { return v * __builtin_amdgcn_rcpf(1.f + __expf(-v)); }
__device__ __forceinline__ float softplus_f(float x) { return fmaxf(x, 0.f) + __logf(1.f + __expf(-fabsf(x))); }

__device__ __forceinline__ float rstd_of(const float* ssq16, int row) {
    const f32x4* p = (const f32x4*)(ssq16 + (size_t)row * 16);
    const f32x4 a = p[0], b = p[1], c = p[2], d = p[3];
    const f32x4 t = (a + b) + (c + d);
    return __builtin_amdgcn_rsqf(((t[0] + t[1]) + (t[2] + t[3])) * (1.f / DM) + EPS);
}
struct EpiProj {
    static constexpr bool PERM = true, AFTER_DRAIN = false;
    bf16_t* O; int ldc; int gate_tile; float* gb; const float* a_log; const float* dt_bias; int scale_tiles; float scale; const float* ssq; const LAS float* rl; int row_lo; int silu_lo, silu_hi;
    __device__ __forceinline__ void operator()(const f32x4 (&acc)[2][2][4][2], const pg8::Unit& u, int wr, int wc, int fr, int fq) const {
        const int row0 = u.pm * 256 + wr * 64 + fr;
#define RS_OF(ai, m) (rl ? rl[row0 + (ai) * 128 + (m) * 16 - row_lo] : rstd_of(ssq, row0 + (ai) * 128 + (m) * 16))
        if (u.pn == gate_tile) {
            if (wc == 0) {
                const int c0 = 8 * fq;
#pragma unroll
                for (int ai = 0; ai < 2; ++ai)
#pragma unroll
                    for (int m = 0; m < 4; ++m) {
                        const int row = row0 + ai * 128 + m * 16; const float rsv = RS_OF(ai, m);
#pragma unroll
                        for (int n = 0; n < 2; ++n) {
                            const f32x4 v = acc[ai][0][m][n] * rsv; f32x4 o;
                            const int c = c0 + 4 * n;
                            if (fq < 2) {
#pragma unroll
                                for (int j = 0; j < 4; ++j) o[j] = 1.f / (1.f + __expf(-v[j]));
                            } else {
                                const f32x4 al = *(const f32x4*)(a_log + c - 16), db = *(const f32x4*)(dt_bias + c - 16);
#pragma unroll
                                for (int j = 0; j < 4; ++j) o[j] = -__expf(al[j]) * softplus_f(v[j] + db[j]);
                            }
                            *(f32x4*)(gb + (size_t)row * 32 + c) = o;
                        }
                    }
            }
            return;
        }
        const int col0 = u.pn * 256 + wc * 32 + 8 * fq;
        const float sc = (u.pn < scale_tiles) ? scale : 1.f;
#pragma unroll
        for (int ai = 0; ai < 2; ++ai)
#pragma unroll
            for (int m = 0; m < 4; ++m) { bf16_t* rowp = O + (size_t)(row0 + ai * 128 + m * 16) * ldc + col0; const float sr = sc * RS_OF(ai, m);
#pragma unroll
                for (int bj = 0; bj < 2; ++bj) { f32x4 v0 = acc[ai][bj][m][0] * sr, v1 = acc[ai][bj][m][1] * sr;
                    if (u.pn >= silu_lo && u.pn < silu_hi) {
#pragma unroll
                        for (int e = 0; e < 4; ++e) { v0[e] = silu_f(v0[e]); v1[e] = silu_f(v1[e]); } }
                    u32x4 w; w.x = cvt_pk_bf16(v0[0], v0[1]); w.y = cvt_pk_bf16(v0[2], v0[3]); w.z = cvt_pk_bf16(v1[0], v1[1]); w.w = cvt_pk_bf16(v1[2], v1[3]);
                    *(u32x4*)(rowp + bj * 128) = w; } }
    }
};
struct EpiSwiglu {
    static constexpr bool PERM = true, AFTER_DRAIN = false;
    bf16_t* O; int ldc; const float* ssq; const LAS float* rl; int row_lo;
    __device__ __forceinline__ void operator()(const f32x4 (&acc)[2][2][4][2], const pg8::Unit& u, int wr, int wc, int fr, int fq) const {
        const int row0 = u.pm * 256 + wr * 64 + fr, col0 = u.pn * 128 + wc * 32 + 8 * fq;
#pragma unroll
        for (int ai = 0; ai < 2; ++ai)
#pragma unroll
            for (int m = 0; m < 4; ++m) { bf16_t* rowp = O + (size_t)(row0 + ai * 128 + m * 16) * ldc + col0;
                float r[8]; const float rsd = rl ? rl[row0 + ai * 128 + m * 16 - row_lo] : rstd_of(ssq, row0 + ai * 128 + m * 16);
#pragma unroll
                for (int n = 0; n < 2; ++n)
#pragma unroll
                    for (int j = 0; j < 4; ++j) { const float g = acc[ai][0][m][n][j] * rsd, up = acc[ai][1][m][n][j] * rsd; r[4 * n + j] = silu_f(g) * up; }
                u32x4 w; w.x = cvt_pk_bf16(r[0], r[1]); w.y = cvt_pk_bf16(r[2], r[3]); w.z = cvt_pk_bf16(r[4], r[5]); w.w = cvt_pk_bf16(r[6], r[7]);
                *(u32x4*)rowp = w; }
    }
};
struct EpiRes {
    static constexpr bool PERM = false, AFTER_DRAIN = false;
    const float* base; float* out; int ldc; bf16_t* xb; float* ssq;
    __device__ __forceinline__ void operator()(const f32x4 (&acc)[2][2][4][2], const pg8::Unit& u, int wr, int wc, int fr, int fq) const {
        const int row0 = u.pm * 256 + wr * 64 + fr, col0 = u.pn * 256 + wc * 32 + 4 * fq;
#pragma unroll
        for (int ai = 0; ai < 2; ++ai) {
            f32x4 bs[4][2][2];
#pragma unroll
            for (int m = 0; m < 4; ++m) { const size_t off = (size_t)(row0 + ai * 128 + m * 16) * ldc + col0;
#pragma unroll
                for (int bj = 0; bj < 2; ++bj)
#pragma unroll
                    for (int n = 0; n < 2; ++n) bs[m][bj][n] = *(const f32x4*)(base + off + bj * 128 + n * 16); }
#pragma unroll
            for (int m = 0; m < 4; ++m) { const int row = row0 + ai * 128 + m * 16; const size_t off = (size_t)row * ldc + col0; float sq = 0.f;
#pragma unroll
                for (int bj = 0; bj < 2; ++bj)
#pragma unroll
                    for (int n = 0; n < 2; ++n) { const f32x4 o = bs[m][bj][n] + acc[ai][bj][m][n]; *(f32x4*)(out + off + bj * 128 + n * 16) = o;
                        sq += (o[0] * o[0] + o[1] * o[1]) + (o[2] * o[2] + o[3] * o[3]);
                        *(u32x2*)(xb + off + bj * 128 + n * 16) = (u32x2){cvt_pk_bf16(o[0], o[1]), cvt_pk_bf16(o[2], o[3])}; }
                sq += __shfl_xor(sq, 16); sq += __shfl_xor(sq, 32);
                if (fq == 0) ssq[(size_t)row * 16 + u.pn * 4 + wc] = sq; }
            asm volatile("" ::: "memory");
        }
    }
};

__device__ __forceinline__ unsigned f2bf(float f) { unsigned u = __float_as_uint(f); return (u + 0x7fffu + ((u >> 16) & 1u)) >> 16; }
__device__ __forceinline__ unsigned pk2(float lo, float hi) { return f2bf(lo) | (f2bf(hi) << 16); }
__device__ __forceinline__ void transpose_item(const float* W, int K, int N, bf16_t* WT, int k0, int n0, int drow0, LAS float* scr, int lane, const float* kscale) {
    const float ks = kscale ? kscale[k0 + lane] : 1.f;
#pragma unroll 8
    for (int i = 0; i < 32; ++i) { const int kk = 2 * i + (lane >> 5); scr[kk * 33 + (lane & 31)] = W[(size_t)(k0 + kk) * N + n0 + (lane & 31)] * __shfl(ks, kk); }
    asm volatile("s_waitcnt lgkmcnt(0)" ::: "memory");
    const int c = lane & 7;
#pragma unroll
    for (int j = 0; j < 4; ++j) { const int n = (lane >> 3) + 8 * j; const LAS float* s = scr + (8 * c) * 33 + n;
        u32x4 o; o.x = pk2(s[0 * 33], s[1 * 33]); o.y = pk2(s[2 * 33], s[3 * 33]); o.z = pk2(s[4 * 33], s[5 * 33]); o.w = pk2(s[6 * 33], s[7 * 33]);
        *(u32x4*)(WT + (size_t)(drow0 + n) * K + k0 + 8 * c) = o; }
    asm volatile("s_waitcnt lgkmcnt(0)" ::: "memory");
}
__device__ __forceinline__ void conv_plain(const float* W, int K, int N, bf16_t* WT, int item, LAS float* scr, int lane, const float* kscale) {
    const int nblk = N / 32, kb = item / nblk, nb = item % nblk;
    transpose_item(W, K, N, WT, 64 * kb, 32 * nb, 32 * nb, scr, lane, kscale);
}
__device__ __forceinline__ void conv_gu(const float* W, bf16_t* WT, int item, int up, LAS float* scr, int lane, const float* kscale) {
    const int nblk = FF / 32, kb = item / nblk, nb = item % nblk, n0 = 32 * nb;
    transpose_item(W, DM, FF, WT, 64 * kb, n0, (n0 >> 7) * 256 + (n0 & 127) + up * 128, scr, lane, kscale);
}
__device__ __forceinline__ void xb_rows(const float* x, bf16_t* xb, float* ssq, int gw, int NGW, int lane) {
    asm volatile("" : "+v"(lane));
    f32x4 v[4], vn[4];
    if (gw < M_TOK) {
#pragma unroll
        for (int j = 0; j < 4; ++j) v[j] = *((const f32x4*)(x + (size_t)gw * DM) + lane + 64 * j);
    }
    for (int m = gw; m < M_TOK; m += NGW) {
        if (m + NGW < M_TOK) {
#pragma unroll
            for (int j = 0; j < 4; ++j) vn[j] = *((const f32x4*)(x + (size_t)(m + NGW) * DM) + lane + 64 * j);
        }
        float s = 0.f;
#pragma unroll
        for (int j = 0; j < 4; ++j) s += (v[j].x * v[j].x + v[j].y * v[j].y) + (v[j].z * v[j].z + v[j].w * v[j].w);
        s = wave_sum(s);
        if (lane < 16) ssq[(size_t)m * 16 + lane] = (lane == 0) ? s : 0.f;
        u32x2* o8 = (u32x2*)(xb + (size_t)m * DM) + lane;
#pragma unroll
        for (int j = 0; j < 4; ++j) { u32x2 p; p.x = cvt_pk_bf16(v[j].x, v[j].y); p.y = cvt_pk_bf16(v[j].z, v[j].w); o8[64 * j] = p; }
#pragma unroll
        for (int j = 0; j < 4; ++j) v[j] = vn[j];
    }
}
__device__ __forceinline__ void final_norm_rows(float* x, const float* w, const float* ssq, int gw, int NGW, int lane) {
    f32x4 wv[4], v[4], vn[4]; float rstd = 0.f, rstdn = 0.f;
#pragma unroll
    for (int j = 0; j < 4; ++j) wv[j] = *((const f32x4*)w + lane + 64 * j);
    if (gw < M_TOK) {
#pragma unroll
        for (int j = 0; j < 4; ++j) v[j] = *((const f32x4*)(x + (size_t)gw * DM) + lane + 64 * j);
        rstd = rstd_of(ssq, gw);
    }
    for (int m = gw; m < M_TOK; m += NGW) {
        if (m + NGW < M_TOK) {
#pragma unroll
            for (int j = 0; j < 4; ++j) vn[j] = *((const f32x4*)(x + (size_t)(m + NGW) * DM) + lane + 64 * j);
            rstdn = rstd_of(ssq, m + NGW);
        }
        f32x4* xr = (f32x4*)(x + (size_t)m * DM) + lane;
#pragma unroll
        for (int j = 0; j < 4; ++j) xr[64 * j] = v[j] * rstd * wv[j];
#pragma unroll
        for (int j = 0; j < 4; ++j) v[j] = vn[j];
        rstd = rstdn;
    }
}

__device__ __forceinline__ void gdn_g0(LAS unsigned char* lds, bf16_t* proj, const float* __restrict__ convw, int blk, int G, int tid, int wave, int lane) {
    asm volatile("" : "+v"(lane), "+v"(tid));
    LAS unsigned* halo = (LAS unsigned*)lds;
    for (int unit = blk; unit < NB * 32; unit += G) {
        const int b = unit >> 5, slab = unit & 31, col = slab * 128 + 2 * lane;
        const f32x4 w0 = *(const f32x4*)(convw + (size_t)col * 4), w1 = *(const f32x4*)(convw + (size_t)(col + 1) * 4);
        const float nsc = (slab < 8) ? 0.08838834764831845f : 1.f;
        const bool donorm = slab < 16;
        bf16_t* base = proj + (size_t)b * SEQ * GDN_PITCH + col;
        constexpr int RPW = 32, CH = 8 * RPW, NCH = SEQ / CH;
        unsigned x[RPW + 3], xn[RPW + 3];
#pragma unroll
        for (int j = 0; j < RPW + 3; ++j) { const int t = RPW * wave - 3 + j; x[j] = (t >= 0) ? *(const unsigned*)(base + (size_t)t * GDN_PITCH) : 0u; }
        __syncthreads();
        for (int chunk = 0; chunk < NCH; ++chunk) {
            if (chunk < NCH - 1) {
#pragma unroll
                for (int j = 0; j < RPW + 3; ++j) { const int t = RPW * wave - 3 + j; if (t >= 0) xn[j] = *(const unsigned*)(base + (size_t)((chunk + 1) * CH + t) * GDN_PITCH); }
            }
            if (wave == 7) {
#pragma unroll
                for (int j = 0; j < 3; ++j) halo[(((chunk + 1) & 1) * 3 + j) * 64 + lane] = x[RPW + j];
            }
            unsigned o[RPW];
#pragma unroll
            for (int r = 0; r < RPW; ++r) {
                float a0 = bflo(x[r]) * w0[0] + bflo(x[r + 1]) * w0[1] + bflo(x[r + 2]) * w0[2] + bflo(x[r + 3]) * w0[3];
                float a1 = bfhi(x[r]) * w1[0] + bfhi(x[r + 1]) * w1[1] + bfhi(x[r + 2]) * w1[2] + bfhi(x[r + 3]) * w1[3];
                a0 = silu_f(a0); a1 = silu_f(a1);
                if (donorm) { const float rn = nsc * __builtin_amdgcn_rsqf(wave_sum(a0 * a0 + a1 * a1) + EPS); a0 *= rn; a1 *= rn; }
                o[r] = cvt_pk_bf16(a0, a1);
            }
            __syncthreads();
            bf16_t* cb = base + (size_t)(chunk * CH + RPW * wave) * GDN_PITCH;
#pragma unroll
            for (int r = 0; r < RPW; ++r) *(unsigned*)(cb + (size_t)r * GDN_PITCH) = o[r];
            if (chunk < NCH - 1) {
#pragma unroll
                for (int j = 0; j < RPW + 3; ++j) { const int t = RPW * wave - 3 + j; x[j] = (t >= 0) ? xn[j] : halo[(((chunk + 1) & 1) * 3 + j) * 64 + lane]; }
            }
        }
        __syncthreads();
    }
}

__device__ __forceinline__ int crow(int r, int hi) { return (r & 3) + 8 * (r >> 2) + 4 * hi; }

__device__ __forceinline__ void gdn_g1(LAS unsigned char* lds, const bf16_t* __restrict__ proj, const float* gb, float* gcs, const float* __restrict__ convw,
                                        bf16_t* __restrict__ Tbuf, int gw, int NGW, int wave, int lane) {
    asm volatile("" : "+v"(lane));
    LAS float* Lw = (LAS float*)(lds + wave * 16384);
    LAS float* aux = (LAS float*)(lds + 131072 + wave * 1024);
    const int r32 = lane & 31, hi = lane >> 5;
    for (int u = gw; u < NB * 64 * 16; u += NGW) {
        const int hv = u & 15, chunk = (u >> 4) & 63, b = u >> 10, hq = hv >> 1;
        const size_t rowb = (size_t)b * SEQ + chunk * 64;
        {
            float g = gb[(rowb + lane) * 32 + 16 + hv]; const float bt = gb[(rowb + lane) * 32 + hv];
#pragma unroll
            for (int o = 1; o < 64; o <<= 1) { const float t = __shfl_up(g, o); if (lane >= o) g += t; }
            aux[lane] = g; aux[64 + lane] = bt;
            gcs[(rowb + lane) * 32 + 16 + hv] = g;
        }
        f32x16 a00 = {}, a10 = {}, a11 = {};
        {
            const bf16_t* kp = proj + (rowb + r32) * GDN_PITCH + 1024 + hq * 128 + 8 * hi;
            bf16x8 kf0[8], kf1[8];
#pragma unroll
            for (int kk = 0; kk < 8; ++kk) { kf0[kk] = *(const bf16x8*)(kp + 16 * kk); kf1[kk] = *(const bf16x8*)(kp + (size_t)32 * GDN_PITCH + 16 * kk); }
#pragma unroll
            for (int kk = 0; kk < 8; ++kk) {
                a00 = __builtin_amdgcn_mfma_f32_32x32x16_bf16(kf0[kk], kf0[kk], a00, 0, 0, 0);
                a10 = __builtin_amdgcn_mfma_f32_32x32x16_bf16(kf1[kk], kf0[kk], a10, 0, 0, 0);
                a11 = __builtin_amdgcn_mfma_f32_32x32x16_bf16(kf1[kk], kf1[kk], a11, 0, 0, 0);
            }
        }
        asm volatile("s_waitcnt lgkmcnt(0)" ::: "memory");
        {
            const float gcj0 = aux[r32], gcj1 = aux[32 + r32];
#pragma unroll
            for (int r = 0; r < 16; ++r) {
                const int i0 = crow(r, hi), i1 = 32 + i0;
                const float gi0 = aux[i0], gi1 = aux[i1], bi0 = aux[64 + i0], bi1 = aux[64 + i1];
                Lw[i0 * 64 + r32] = (i0 > r32) ? bi0 * a00[r] * __expf(gi0 - gcj0) : 0.f;
                Lw[i1 * 64 + r32] = bi1 * a10[r] * __expf(gi1 - gcj0);
                Lw[i1 * 64 + 32 + r32] = (i0 > r32) ? bi1 * a11[r] * __expf(gi1 - gcj1) : 0.f;
            }
        }
        asm volatile("s_waitcnt lgkmcnt(0)" ::: "memory");
        float X[64];
#pragma unroll
        for (int i = 0; i < 64; ++i) {
            float xi = (lane == i) ? 1.f : 0.f, xj = 0.f;
#pragma unroll
            for (int g4 = 0; g4 < (i + 3) / 4; ++g4) {
                const f32x4 l = *(const LAS f32x4*)(Lw + i * 64 + 4 * g4);
#pragma unroll
                for (int e = 0; e < 4; ++e) { const int j = 4 * g4 + e; if (j < i) { if (j & 1) xj -= l[e] * X[j]; else xi -= l[e] * X[j]; } }
            }
            X[i] = xi + xj;
            asm volatile("" ::: "memory");
        }
        bf16_t* To = Tbuf + (size_t)((b * 16 + hv) * 64 + chunk) * 4096 + lane;
#pragma unroll
        for (int i = 0; i < 64; ++i) To[i * 64] = (bf16_t)f2bf(X[i]);
        asm volatile("s_waitcnt lgkmcnt(0)" ::: "memory");
    }
}

namespace g2 {
constexpr int QN = 0, KN = 18432, KNT = 35840, VT = 54272, RT = 72704, ST = 91136, TL = 125952, ATT = 135168, AUX = 144384;
constexpr int P128 = 272, P64 = 144;
__device__ __forceinline__ f32x16 mma(f32x16 acc, LAS const unsigned char* A, int ap, LAS const unsigned char* B, int bp, int nk, int r32, int hi) {
    LAS const unsigned char* a = A + r32 * ap + 16 * hi; LAS const unsigned char* b = B + r32 * bp + 16 * hi;
#pragma unroll
    for (int kk = 0; kk < 8; ++kk) if (kk < nk) {
        const bf16x8 av = *(LAS const bf16x8*)(a + 32 * kk), bv = *(LAS const bf16x8*)(b + 32 * kk);
        acc = __builtin_amdgcn_mfma_f32_32x32x16_bf16(av, bv, acc, 0, 0, 0);
    }
    return acc;
}
}
__device__ __forceinline__ void gdn_g2(LAS unsigned char* lds, bf16_t* proj, const float* __restrict__ gb, const float* __restrict__ convw, const float* __restrict__ normw,
                                        const bf16_t* __restrict__ Tbuf, int unit0, int ustride, int tid, int wave, int lane) {
    using namespace g2;
    asm volatile("" : "+v"(lane), "+v"(tid));
    const int r32 = lane & 31, hi = lane >> 5, ti = wave & 1, tj = wave >> 1;
    LAS float* aux = (LAS float*)(lds + AUX);
    for (int unit = unit0; unit < NB * 16; unit += ustride) {
        const int b = unit >> 4, hv = unit & 15, hq = hv >> 1;
        const int colq = hq * 128 + 2 * lane, colk = 1024 + colq, colv = 2048 + hv * 128 + 2 * lane, colz = 4096 + hv * 128 + 2 * lane;
        const float nw0 = normw[2 * lane], nw1 = normw[2 * lane + 1];
        f32x16 S0 = {}, S1 = {};
        for (int i = tid; i < 34816 / 4; i += 512) ((LAS unsigned*)(lds + ST))[i] = 0u;
        unsigned xq[8], xk[8], xv[8];
#define G2_LOADX(CH) do { _Pragma("unroll") for (int r = 0; r < 8; ++r) { const bf16_t* p = proj + (size_t)((long)b * SEQ + (CH) * 64 + 8 * wave + r) * GDN_PITCH; \
            xq[r] = *(const unsigned*)(p + colq); xk[r] = *(const unsigned*)(p + colk); xv[r] = *(const unsigned*)(p + colv); } } while (0)
        G2_LOADX(0);
        for (int chunk = 0; chunk < 64; ++chunk) {
            const size_t rowb = (size_t)b * SEQ + chunk * 64;
            unsigned zreg[8]; u32x4 treg;
            {
#pragma unroll
                for (int r = 0; r < 8; ++r) zreg[r] = *(const unsigned*)(proj + (rowb + 8 * wave + r) * GDN_PITCH + colz);
                treg = *(const u32x4*)(Tbuf + (size_t)((b * 16 + hv) * 64 + chunk) * 4096 + (tid >> 3) * 64 + (tid & 7) * 8);
#pragma unroll
                for (int r = 0; r < 8; ++r) {
                    *(LAS unsigned*)(lds + QN + (8 * wave + r) * P128 + 4 * lane) = xq[r];
                    *(LAS unsigned*)(lds + KN + (8 * wave + r) * P128 + 4 * lane) = xk[r];
                }
#define PKLO(a, b) (((a) & 0xffffu) | ((b) << 16))
#define PKHI(a, b) (((a) >> 16) | ((b) & 0xffff0000u))
                *(LAS u32x4*)(lds + KNT + (2 * lane) * P64 + 16 * wave) = (u32x4){PKLO(xk[0], xk[1]), PKLO(xk[2], xk[3]), PKLO(xk[4], xk[5]), PKLO(xk[6], xk[7])};
                *(LAS u32x4*)(lds + KNT + (2 * lane + 1) * P64 + 16 * wave) = (u32x4){PKHI(xk[0], xk[1]), PKHI(xk[2], xk[3]), PKHI(xk[4], xk[5]), PKHI(xk[6], xk[7])};
                *(LAS u32x4*)(lds + VT + (2 * lane) * P64 + 16 * wave) = (u32x4){PKLO(xv[0], xv[1]), PKLO(xv[2], xv[3]), PKLO(xv[4], xv[5]), PKLO(xv[6], xv[7])};
                *(LAS u32x4*)(lds + VT + (2 * lane + 1) * P64 + 16 * wave) = (u32x4){PKHI(xv[0], xv[1]), PKHI(xv[2], xv[3]), PKHI(xv[4], xv[5]), PKHI(xv[6], xv[7])};
                if (wave == 0) {
                    const float g = gb[(rowb + lane) * 32 + 16 + hv], bt = gb[(rowb + lane) * 32 + hv];
                    const float gl = __builtin_bit_cast(float, __builtin_amdgcn_readlane(__builtin_bit_cast(int, g), 63));
                    aux[lane] = g; aux[64 + lane] = bt; aux[128 + lane] = __expf(g); aux[192 + lane] = __expf(gl - g);
                    if (lane == 0) aux[256] = __expf(gl);
                }
            }
            __syncthreads();
            if (chunk < 63) G2_LOADX(chunk + 1);
            if (wave < 4) {
                const int si = wave & 1, tq = wave >> 1;
                f32x16 p = {};
                p = mma(p, lds + KN + 32 * si * P128, P128, lds + QN + 32 * tq * P128, P128, 8, r32, hi);
                const int t = 32 * tq + r32; const float gt = aux[t];
#pragma unroll
                for (int g4 = 0; g4 < 4; ++g4) {
                    float a[4];
#pragma unroll
                    for (int e = 0; e < 4; ++e) { const int s = 32 * si + 8 * g4 + 4 * hi + e; a[e] = (s <= t) ? p[4 * g4 + e] * __expf(gt - aux[s]) : 0.f; }
                    *(LAS u32x2*)(lds + ATT + t * P64 + (32 * si + 8 * g4 + 4 * hi) * 2) = (u32x2){cvt_pk_bf16(a[0], a[1]), cvt_pk_bf16(a[2], a[3])};
                }
            }
            f32x16 o1 = {};
            {
                f32x16 acc = {};
                acc = mma(acc, lds + KN + 32 * ti * P128, P128, lds + ST + 32 * tj * P128, P128, 8, r32, hi);
                o1 = mma(o1, lds + QN + 32 * ti * P128, P128, lds + ST + 32 * tj * P128, P128, 8, r32, hi);
                const int dv = 32 * tj + r32;
#pragma unroll
                for (int g4 = 0; g4 < 4; ++g4) {
                    const int t0 = 32 * ti + 8 * g4 + 4 * hi;
                    const u32x2 vv = *(LAS const u32x2*)(lds + VT + dv * P64 + t0 * 2);
                    const float v4[4] = {bflo(vv.x), bfhi(vv.x), bflo(vv.y), bfhi(vv.y)};
                    float rr[4];
#pragma unroll
                    for (int e = 0; e < 4; ++e) { const float eg = aux[128 + t0 + e]; rr[e] = aux[64 + t0 + e] * (v4[e] - eg * acc[4 * g4 + e]); o1[4 * g4 + e] *= eg; }
                    *(LAS u32x2*)(lds + RT + dv * P64 + t0 * 2) = (u32x2){cvt_pk_bf16(rr[0], rr[1]), cvt_pk_bf16(rr[2], rr[3])};
                }
            }
            *(LAS u32x4*)(lds + TL + (tid >> 3) * P64 + (tid & 7) * 16) = treg;
            __syncthreads();
            {
                f32x16 acc = {};
                acc = mma(acc, lds + TL + 32 * ti * P64, P64, lds + RT + 32 * tj * P64, P64, 4, r32, hi);
                const int dv = 32 * tj + r32;
#pragma unroll
                for (int g4 = 0; g4 < 4; ++g4) {
                    const int t0 = 32 * ti + 8 * g4 + 4 * hi;
                    float s4[4];
#pragma unroll
                    for (int e = 0; e < 4; ++e) s4[e] = acc[4 * g4 + e] * aux[192 + t0 + e];
                    *(LAS u32x2*)(lds + VT + dv * P64 + t0 * 2) = (u32x2){cvt_pk_bf16(acc[4 * g4], acc[4 * g4 + 1]), cvt_pk_bf16(acc[4 * g4 + 2], acc[4 * g4 + 3])};
                    *(LAS u32x2*)(lds + QN + dv * P64 + t0 * 2) = (u32x2){cvt_pk_bf16(s4[0], s4[1]), cvt_pk_bf16(s4[2], s4[3])};
                }
            }
            __syncthreads();
            {
                o1 = mma(o1, lds + ATT + 32 * ti * P64, P64, lds + VT + 32 * tj * P64, P64, 4, r32, hi);
                const int dv = 32 * tj + r32;
#pragma unroll
                for (int r = 0; r < 16; ++r) { const int t = 32 * ti + crow(r, hi); *(LAS unsigned short*)(lds + RT + t * P128 + dv * 2) = (unsigned short)f2bf(o1[r]); }
                const float egl = aux[256];
                S0 = S0 * egl; S1 = S1 * egl;
                S0 = mma(S0, lds + KNT + 32 * (2 * ti) * P64, P64, lds + QN + 32 * tj * P64, P64, 4, r32, hi);
                S1 = mma(S1, lds + KNT + 32 * (2 * ti + 1) * P64, P64, lds + QN + 32 * tj * P64, P64, 4, r32, hi);
#pragma unroll
                for (int g4 = 0; g4 < 4; ++g4) {
                    const int d0 = 8 * g4 + 4 * hi;
                    *(LAS u32x2*)(lds + ST + dv * P128 + (64 * ti + d0) * 2) = (u32x2){cvt_pk_bf16(S0[4 * g4], S0[4 * g4 + 1]), cvt_pk_bf16(S0[4 * g4 + 2], S0[4 * g4 + 3])};
                    *(LAS u32x2*)(lds + ST + dv * P128 + (64 * ti + 32 + d0) * 2) = (u32x2){cvt_pk_bf16(S1[4 * g4], S1[4 * g4 + 1]), cvt_pk_bf16(S1[4 * g4 + 2], S1[4 * g4 + 3])};
                }
            }
            __syncthreads();
#pragma unroll
            for (int r = 0; r < 8; ++r) {
                const int t = 8 * wave + r;
                const unsigned ov = *(LAS const unsigned*)(lds + RT + t * P128 + 4 * lane);
                const float oa = bflo(ov), ob = bfhi(ov);
                const float rstd = __builtin_amdgcn_rsqf(wave_sum(oa * oa + ob * ob) * (1.f / 128.f) + EPS);
                bf16_t* prow = proj + (rowb + t) * GDN_PITCH;
                const unsigned zv = zreg[r];
                *(unsigned*)(prow + colv) = cvt_pk_bf16(oa * rstd * nw0 * bflo(zv), ob * rstd * nw1 * bfhi(zv));
            }
        }
        __syncthreads();
    }
}

template <bool MASK> __device__ __forceinline__ void sb_tile(LAS const unsigned char* kb, LAS const unsigned char* vb, const bf16x8 (&qr)[4], const bf16x8 (&Uf)[2],
                                                            f32x16& oT0, f32x16& oT1, float& carry, const int s0, const int tq, const int r32, const int hi) {
    constexpr int P = 144, PV = 272;
    f32x16 p0 = {}, p1 = {};
#pragma unroll
    for (int kk = 0; kk < 4; ++kk) {
        const bf16x8 k0 = *(LAS const bf16x8*)(kb + r32 * P + (16 * kk + 8 * hi) * 2), k1 = *(LAS const bf16x8*)(kb + (32 + r32) * P + (16 * kk + 8 * hi) * 2);
        p0 = __builtin_amdgcn_mfma_f32_32x32x16_bf16(k0, qr[kk], p0, 0, 0, 0);
        p1 = __builtin_amdgcn_mfma_f32_32x32x16_bf16(k1, qr[kk], p1, 0, 0, 0);
    }
    float lk0[16], lk1[16]; float cs0 = 0.f, cs1 = 0.f;
#pragma unroll
    for (int r = 0; r < 16; ++r) {
        const float y0 = p0[r], y1 = p1[r];
        const float sp0 = __builtin_amdgcn_logf(1.f + __builtin_amdgcn_exp2f(__builtin_amdgcn_fmed3f(y0, -126.f, 126.f)));
        const float sp1 = __builtin_amdgcn_logf(1.f + __builtin_amdgcn_exp2f(__builtin_amdgcn_fmed3f(y1, -126.f, 126.f)));
        if (MASK) { const int s = s0 + crow(r, hi); lk0[r] = (s < tq) ? sp0 : 0.f; lk1[r] = (s + 32 < tq) ? sp1 : 0.f; }
        else { lk0[r] = sp0; lk1[r] = sp1; }
        cs0 += lk0[r]; cs1 += lk1[r];
    }
    {
        const auto r0 = __builtin_amdgcn_permlane32_swap(__float_as_uint(cs0), __float_as_uint(cs0), false, false);
        const auto r1 = __builtin_amdgcn_permlane32_swap(__float_as_uint(cs1), __float_as_uint(cs1), false, false);
        cs0 = __uint_as_float(r0[0]) + __uint_as_float(r0[1]); cs1 = __uint_as_float(r1[0]) + __uint_as_float(r1[1]);
    }
    const float c0 = carry - cs1;
#pragma unroll
    for (int r = 0; r < 16; ++r) { p0[r] += c0; p1[r] += carry; }
#pragma unroll
    for (int kk = 0; kk < 4; ++kk) {
        u32x4 w;
        if (kk < 2) { w.x = cvt_pk_bf16(lk0[8 * kk], lk0[8 * kk + 1]); w.y = cvt_pk_bf16(lk0[8 * kk + 2], lk0[8 * kk + 3]); w.z = cvt_pk_bf16(lk0[8 * kk + 4], lk0[8 * kk + 5]); w.w = cvt_pk_bf16(lk0[8 * kk + 6], lk0[8 * kk + 7]); }
        else { const int q = 8 * (kk - 2); w.x = cvt_pk_bf16(lk1[q], lk1[q + 1]); w.y = cvt_pk_bf16(lk1[q + 2], lk1[q + 3]); w.z = cvt_pk_bf16(lk1[q + 4], lk1[q + 5]); w.w = cvt_pk_bf16(lk1[q + 6], lk1[q + 7]); }
        const bf16x8 lf = __builtin_bit_cast(bf16x8, w);
        if (kk < 2) p0 = __builtin_amdgcn_mfma_f32_32x32x16_bf16(Uf[kk], lf, p0, 0, 0, 0);
        else p1 = __builtin_amdgcn_mfma_f32_32x32x16_bf16(Uf[kk - 2], lf, p1, 0, 0, 0);
    }
    carry -= cs0 + cs1;
#pragma unroll
    for (int r = 0; r < 16; ++r) {
        float a0 = __builtin_amdgcn_exp2f(p0[r]), a1 = __builtin_amdgcn_exp2f(p1[r]);
        if (MASK) { const int s = s0 + crow(r, hi); a0 = (s < tq) ? a0 : 0.f; a1 = (s + 32 < tq) ? a1 : 0.f; }
        lk0[r] = a0; lk1[r] = a1;
    }
#pragma unroll
    for (int kk = 0; kk < 4; ++kk) {
        u32x4 w;
        if (kk < 2) { w.x = cvt_pk_bf16(lk0[8 * kk], lk0[8 * kk + 1]); w.y = cvt_pk_bf16(lk0[8 * kk + 2], lk0[8 * kk + 3]); w.z = cvt_pk_bf16(lk0[8 * kk + 4], lk0[8 * kk + 5]); w.w = cvt_pk_bf16(lk0[8 * kk + 6], lk0[8 * kk + 7]); }
        else { const int q = 8 * (kk - 2); w.x = cvt_pk_bf16(lk1[q], lk1[q + 1]); w.y = cvt_pk_bf16(lk1[q + 2], lk1[q + 3]); w.z = cvt_pk_bf16(lk1[q + 4], lk1[q + 5]); w.w = cvt_pk_bf16(lk1[q + 6], lk1[q + 7]); }
        const bf16x8 af = __builtin_bit_cast(bf16x8, w);
        const u32x2 a0 = *(LAS const u32x2*)(vb + r32 * PV + (16 * kk + 4 * hi) * 2), a1 = *(LAS const u32x2*)(vb + r32 * PV + (16 * kk + 8 + 4 * hi) * 2);
        const u32x2 b0 = *(LAS const u32x2*)(vb + (32 + r32) * PV + (16 * kk + 4 * hi) * 2), b1 = *(LAS const u32x2*)(vb + (32 + r32) * PV + (16 * kk + 8 + 4 * hi) * 2);
        const bf16x8 v0 = __builtin_bit_cast(bf16x8, (u32x4){a0.x, a0.y, a1.x, a1.y}), v1 = __builtin_bit_cast(bf16x8, (u32x4){b0.x, b0.y, b1.x, b1.y});
        oT0 = __builtin_amdgcn_mfma_f32_32x32x16_bf16(v0, af, oT0, 0, 0, 0);
        oT1 = __builtin_amdgcn_mfma_f32_32x32x16_bf16(v1, af, oT1, 0, 0, 0);
    }
}
__device__ __forceinline__ void sb_attn(LAS unsigned char* lds, bf16_t* qkv, int blk, int G, int tid, int wave, int lane) {
    constexpr int KBUF = 18432, VBUF = 17408, BUF = KBUF + VBUF, P = 144, PV = 272, LD = 3072;
    asm volatile("" : "+v"(lane), "+v"(tid));
    const int r32 = lane & 31, hi = lane >> 5;
    bf16x8 Uf[2];
#pragma unroll
    for (int kk = 0; kk < 2; ++kk)
#pragma unroll
        for (int e = 0; e < 8; ++e) { const int j = 16 * kk + 8 * (e >> 2) + 4 * hi + (e & 3); Uf[kk][e] = (j >= r32) ? (short)0xBF80 : (short)0; }
    const int srow = tid >> 3, sch = tid & 7;
    for (int u = blk; u < 2048; u += G) {
        const int i = u >> 8, jj = u & 255, bh = jj & 127, half = jj >> 7, qb = 15 - 2 * i - (half ^ (i & 1));
        const int b = bh >> 4, h = bh & 15, q0 = qb * 256;
        const size_t rowb = (size_t)b * SEQ;
        const int tq = q0 + 32 * wave + r32;
        bf16_t* qptr = qkv + (rowb + tq) * LD + h * 64;
        bf16x8 qr[4];
#pragma unroll
        for (int kk = 0; kk < 4; ++kk) qr[kk] = *(const bf16x8*)(qptr + 16 * kk + 8 * hi);
        f32x16 oT0 = {}, oT1 = {};
        float carry = 0.f;
        const int stmax = (q0 >> 7) + 1;
        const bf16_t* kbase = qkv + (rowb + srow) * LD + 1024 + h * 64 + sch * 8;
        const bf16_t* vbase = qkv + (rowb + lane) * LD + 2048 + h * 64 + wave * 8;
        u32x4 kreg0 = *(const u32x4*)(kbase + (size_t)stmax * 128 * LD), kreg1 = *(const u32x4*)(kbase + (size_t)(stmax * 128 + 64) * LD);
        u32x4 vreg0 = *(const u32x4*)(vbase + (size_t)stmax * 128 * LD), vreg1 = *(const u32x4*)(vbase + (size_t)(stmax * 128 + 64) * LD);
        int cur = 0;
        __syncthreads();
        for (int st = stmax; st >= 0; --st) {
            LAS unsigned char* kb = lds + cur * BUF; LAS unsigned char* vb = kb + KBUF;
            *(LAS u32x4*)(kb + srow * P + sch * 16) = kreg0;
            *(LAS u32x4*)(kb + (64 + srow) * P + sch * 16) = kreg1;
#pragma unroll
            for (int e = 0; e < 4; ++e) {
                *(LAS unsigned short*)(vb + (wave * 8 + 2 * e) * PV + lane * 2) = (unsigned short)(vreg0[e] & 0xffffu);
                *(LAS unsigned short*)(vb + (wave * 8 + 2 * e + 1) * PV + lane * 2) = (unsigned short)(vreg0[e] >> 16);
                *(LAS unsigned short*)(vb + (wave * 8 + 2 * e) * PV + (64 + lane) * 2) = (unsigned short)(vreg1[e] & 0xffffu);
                *(LAS unsigned short*)(vb + (wave * 8 + 2 * e + 1) * PV + (64 + lane) * 2) = (unsigned short)(vreg1[e] >> 16);
            }
            __syncthreads();
            if (st > 0) {
                kreg0 = *(const u32x4*)(kbase + (size_t)(st - 1) * 128 * LD); kreg1 = *(const u32x4*)(kbase + (size_t)((st - 1) * 128 + 64) * LD);
                vreg0 = *(const u32x4*)(vbase + (size_t)(st - 1) * 128 * LD); vreg1 = *(const u32x4*)(vbase + (size_t)((st - 1) * 128 + 64) * LD);
            }
            const int tmin = q0 + 32 * wave;
#pragma unroll
            for (int hf = 1; hf >= 0; --hf) {
                const int s0 = st * 128 + hf * 64;
                if (s0 < tmin + 31) {
                    if (s0 + 63 >= tmin) sb_tile<true>(kb + hf * 64 * P, vb + hf * 128, qr, Uf, oT0, oT1, carry, s0, tq, r32, hi);
                    else sb_tile<false>(kb + hf * 64 * P, vb + hf * 128, qr, Uf, oT0, oT1, carry, s0, tq, r32, hi);
                }
            }
            cur ^= 1;
        }
#pragma unroll
        for (int g4 = 0; g4 < 4; ++g4) {
            const int d0 = 8 * g4 + 4 * hi;
            *(u32x2*)(qptr + d0) = (u32x2){cvt_pk_bf16(oT0[4 * g4], oT0[4 * g4 + 1]), cvt_pk_bf16(oT0[4 * g4 + 2], oT0[4 * g4 + 3])};
            *(u32x2*)(qptr + 32 + d0) = (u32x2){cvt_pk_bf16(oT1[4 * g4], oT1[4 * g4 + 1]), cvt_pk_bf16(oT1[4 * g4 + 2], oT1[4 * g4 + 3])};
        }
    }
}

struct Args { const float* in[15]; float* out; unsigned char* ws; };
#define XB_TMO      128
#define XB_XCNT(j)  (256  + 64 * (j))
#define XB_XSUB(j)  (1280 + 64 * (j))
#define XB_XGEN(j)  (2304 + 64 * (j))
#define XB_TOP      3328
#define XB_TOPGEN   3392
#define XCD_BAR_WORDS 3456
#define XB_SPIN_CAP (1u << 18)

__device__ __forceinline__ unsigned xb_ld(unsigned* p)              { return __hip_atomic_load(p, __ATOMIC_RELAXED, __HIP_MEMORY_SCOPE_AGENT); }
__device__ __forceinline__ unsigned xb_add(unsigned* p, unsigned v) { return __hip_atomic_fetch_add(p, v, __ATOMIC_RELAXED, __HIP_MEMORY_SCOPE_AGENT); }
__device__ __forceinline__ unsigned xb_xcc_id() { return (unsigned)__builtin_amdgcn_s_getreg((3 << 11) | 20) & 0xFu; }
#define XB_SPIN(cond, bar) do { unsigned _sp = 0; while (cond) { __builtin_amdgcn_s_sleep(1); \
    if ((++_sp & 255u) == 0u) { if (xb_ld(&(bar)[XB_TMO])) break; if (_sp > XB_SPIN_CAP) { atomicAdd(&(bar)[XB_TMO], 1u); break; } } } } while (0)

struct XcdBarrier {
    unsigned* bar; unsigned x;
    volatile LAS unsigned* st;
};

__device__ __forceinline__ XcdBarrier xcd_barrier_post(unsigned* bar, volatile LAS unsigned* st) {
    XcdBarrier b; b.bar = bar; b.x = xb_xcc_id(); b.st = st;
    if (threadIdx.x == 0) (void)xb_add(&bar[XB_XCNT(b.x)], 1u);
    return b;
}
__device__ __forceinline__ void xcd_barrier_complete(unsigned* bar, unsigned x, unsigned& nloc, unsigned& nx) {
    const unsigned G = gridDim.x * gridDim.y * gridDim.z;
    unsigned sum, cnt, mine, sp = 0u;
    for (;;) {
        sum = 0u; cnt = 0u; mine = 0u;
#pragma unroll
        for (unsigned j = 0; j < 16; ++j) { const unsigned c = xb_ld(&bar[XB_XCNT(j)]); sum += c; cnt += (c > 0u) ? 1u : 0u; mine = (j == x) ? c : mine; }
        if (sum == G) break;
        __builtin_amdgcn_s_sleep(1);
        if ((++sp & 255u) == 0u) { if (xb_ld(&bar[XB_TMO])) break; if (sp > XB_SPIN_CAP) { atomicAdd(&bar[XB_TMO], 1u); break; } }
    }
    nloc = mine > 0u ? mine : 1u; nx = cnt > 0u ? cnt : 1u;
}

__device__ __forceinline__ void xcd_barrier(const XcdBarrier& b) {
    asm volatile("s_waitcnt vmcnt(0)" ::: "memory");
    __syncthreads();
    if (threadIdx.x == 0) {
        unsigned* bar = b.bar;
        __builtin_amdgcn_s_waitcnt(0);
        unsigned nloc = b.st[0], nx = b.st[1];
        if (nloc == 0u) { xcd_barrier_complete(bar, b.x, nloc, nx); b.st[0] = nloc; b.st[1] = nx; }
        const unsigned old = xb_add(&bar[XB_XSUB(b.x)], 1u);
        const unsigned gen = old / nloc;
        if (old + 1u == (gen + 1u) * nloc) {
            __builtin_amdgcn_fence(__ATOMIC_RELEASE, "agent");
            asm volatile("s_waitcnt vmcnt(0)" ::: "memory");
            const unsigned og = xb_add(&bar[XB_TOP], 1u);
            const unsigned tg = og / nx;
            if (og + 1u == (tg + 1u) * nx) xb_add(&bar[XB_TOPGEN], 1u);
            else XB_SPIN(xb_ld(&bar[XB_TOPGEN]) == tg, bar);
            __builtin_amdgcn_fence(__ATOMIC_ACQUIRE, "agent");
            xb_add(&bar[XB_XGEN(b.x)], 1u);
            asm volatile("s_waitcnt vmcnt(0)" ::: "memory");
        } else {
            XB_SPIN(xb_ld(&bar[XB_XGEN(b.x)]) == gen, bar);
            __builtin_amdgcn_fence(__ATOMIC_ACQUIRE, "agent");
            asm volatile("s_waitcnt vmcnt(0)" ::: "memory");
        }
    }
    __syncthreads();
}

template <bool gdn> __device__ __forceinline__ void conv_mixer_weights(const Args& a, const int layer, bf16_t* Win_t, bf16_t* Wout_t, LAS float* scr, int gw, int NGW, int lane) {
    const int j = layer >> 1;
    const float* w_in = gdn ? a.in[1] + (size_t)j * DM * GDN_N : a.in[7] + (size_t)j * DM * 3072;
    const float* w_out = gdn ? a.in[6] + (size_t)j * 2048 * DM : a.in[8] + (size_t)j * DM * DM;
    constexpr int n_in = gdn ? GDN_N : 3072, k_out = gdn ? 2048 : 1024;
    constexpr int I_in = (DM / 64) * (n_in / 32), I_out = (k_out / 64) * (DM / 32);
    for (int it = gw; it < I_in + I_out; it += NGW) {
        if (it < I_in) conv_plain(w_in, DM, n_in, Win_t, it, scr, lane, a.in[9] + layer * DM);
        else conv_plain(w_out, k_out, DM, Wout_t, it - I_in, scr, lane, nullptr);
    }
}
__device__ __forceinline__ void conv_ffn_weights(const Args& a, const int layer, bf16_t* Wgu_t, bf16_t* Wdn_t, LAS float* scr, int gw, int NGW, int lane) {
    constexpr int I_g = (DM / 64) * (FF / 32), I_d = (FF / 64) * (DM / 32);
    const float* wg = a.in[11] + (size_t)layer * DM * FF; const float* wu = a.in[12] + (size_t)layer * DM * FF; const float* wd = a.in[13] + (size_t)layer * FF * DM;
    for (int it = gw; it < 2 * I_g + I_d; it += NGW) {
        if (it < I_g) conv_gu(wg, Wgu_t, it, 0, scr, lane, a.in[10] + layer * DM);
        else if (it < 2 * I_g) conv_gu(wu, Wgu_t, it - I_g, 1, scr, lane, a.in[10] + layer * DM);
        else conv_plain(wd, FF, DM, Wdn_t, it - 2 * I_g, scr, lane, nullptr);
    }
}
__device__ __forceinline__ void conv_during_gdn_mixer(const Args& a, const int layer, LAS float* scr, int hw, int NHW, int lane) {
    conv_ffn_weights(a, layer, (bf16_t*)(a.ws + WS_WGU), (bf16_t*)(a.ws + WS_WDN), scr, hw, NHW, lane);
    conv_mixer_weights<false>(a, layer + 1, (bf16_t*)(a.ws + WS_WIN), (bf16_t*)(a.ws + WS_ALT_WOUT), scr, hw, NHW, lane);
    conv_ffn_weights(a, layer + 1, (bf16_t*)(a.ws + WS_ALT_WGU), (bf16_t*)(a.ws + WS_ALT_WDN), scr, hw, NHW, lane);
}
template <class Sched> __device__ __forceinline__ int build_rstd_table(LAS unsigned char* lds, const Sched& S, const float* ssq16, int tid) {
    int pm_lo = 1 << 30, pm_hi = -1; pg8::Unit u;
    for (int i = 0; S.next(i, u); ++i) { pm_lo = u.pm < pm_lo ? u.pm : pm_lo; pm_hi = u.pm > pm_hi ? u.pm : pm_hi; }
    const int rows = (pm_hi - pm_lo + 1) * 256;
    if (pm_hi < 0 || rows > 4096) return -1;
    LAS float* rl = (LAS float*)(lds + 131072);
    for (int r = tid; r < rows; r += 512) rl[r] = rstd_of(ssq16, pm_lo * 256 + r);
    __syncthreads();
    return pm_lo * 256;
}
__device__ __forceinline__ void zero_ssq(float* p) { int g = blockIdx.x * 512 + threadIdx.x; asm volatile("" : "+v"(g)); if (g < M_TOK) p[g] = 0.f; }

template <bool gdn> __device__ __forceinline__ void layer_body(const Args& a, const int layer, LAS unsigned char* lds, const XcdBarrier& gbar, unsigned long long& probe_acc) {
#define LB_IDS() int tid = threadIdx.x; asm volatile("" : "+v"(tid)); const int lane = tid & 63, wave = __builtin_amdgcn_readfirstlane(tid >> 6); \
        const int G = gridDim.x, blk = blockIdx.x, gw = blk * 8 + wave, NGW = G * 8; (void)lane; (void)gw; (void)NGW; (void)G; (void)blk;
#define LB_PTRS() bf16_t* Win_t = (bf16_t*)(a.ws + WS_WIN); bf16_t* Wout_t = (bf16_t*)(a.ws + (gdn ? WS_WOUT : WS_ALT_WOUT)); bf16_t* Wgu_t = (bf16_t*)(a.ws + (gdn ? WS_WGU : WS_ALT_WGU)); bf16_t* Wdn_t = (bf16_t*)(a.ws + (gdn ? WS_WDN : WS_ALT_WDN)); \
        float* gb = (float*)(a.ws + WS_GB); bf16_t* H = (bf16_t*)(a.ws + WS_H); bf16_t* PROJ = (bf16_t*)(a.ws + WS_PROJ); float* out = a.out; const float* xcur = (layer == 0) ? a.in[0] : a.out; \
        float* ssqA = (float*)(a.ws + WS_SSQ); float* ssqB = ssqA + (size_t)M_TOK * 16; \
        (void)Win_t; (void)Wout_t; (void)Wgu_t; (void)Wdn_t; (void)gb; (void)H; (void)PROJ; (void)out; (void)xcur; (void)ssqA; (void)ssqB;
        const int j = layer >> 1;
        { PH_T0(1)
        {
            LB_IDS(); LB_PTRS();
            pg8::Gemm g{H, Win_t, M_TOK, gdn ? GDN_NP : 3072, DM, DM}; pg8::StaticOrder S; S.init(M_TOK, g.N, G, blk);
            const int row_lo = build_rstd_table(lds, S, ssqA, tid);
            EpiProj E{PROJ, gdn ? GDN_PITCH : 3072, gdn ? 24 : -1, gb, a.in[3] + j * 16, a.in[4] + j * 16, gdn ? 0 : 4, 0.125f * 1.4426950408889634f, ssqA, row_lo >= 0 ? (const LAS float*)(lds + 131072) : nullptr, row_lo, gdn ? 16 : 0, gdn ? 24 : 0};
#if !defined(NO_GEMM) && !defined(NO_P2)
            pg8::gemm_phase<EpiProj, pg8::StaticOrder, true, true>(lds, g, S, E);
#endif
        }
        xcd_barrier(gbar);
        PH_T1(1) }
        if constexpr (gdn) {
            LB_IDS(); LB_PTRS();
            const float* convw = a.in[2] + (size_t)j * 4096 * 4;
            { PH_T0(2) gdn_g0(lds, PROJ, convw, blk, G, tid, wave, lane);
            xcd_barrier(gbar); PH_T1(2) }
            { PH_T0(3)
            if (G < 256) { conv_during_gdn_mixer(a, layer, (LAS float*)(lds + wave * 16384), gw, NGW, lane); __syncthreads(); }
            gdn_g1(lds, PROJ, gb, gb, convw, H, gw, NGW, wave, lane);
            xcd_barrier(gbar); PH_T1(3) }
            { PH_T0(4)
            if (G >= 256 && blk >= 128) conv_during_gdn_mixer(a, layer, (LAS float*)(lds + wave * 16384), (blk - 128) * 8 + wave, (G - 128) * 8, lane);
            gdn_g2(lds, PROJ, gb, convw, a.in[5] + j * 128, H, blk, G, tid, wave, lane);
            xcd_barrier(gbar); PH_T1(4) }
        } else {
            LB_IDS(); LB_PTRS();
            { PH_T0(5)
            sb_attn(lds, PROJ, blk, G, tid, wave, lane);
            xcd_barrier(gbar); PH_T1(5) }
        }
        { PH_T0(6)
        {
            LB_IDS(); LB_PTRS();
            pg8::Gemm g{gdn ? PROJ + 2048 : PROJ, Wout_t, M_TOK, DM, gdn ? 2048 : 1024, gdn ? GDN_PITCH : 3072}; pg8::StaticOrder S; S.init(M_TOK, DM, G, blk);
            EpiRes E{xcur, out, DM, H, ssqB};
#if !defined(NO_GEMM) && !defined(NO_P4)
            pg8::gemm_phase<EpiRes, pg8::StaticOrder, true, true>(lds, g, S, E);
#endif
        }
        xcd_barrier(gbar);
        PH_T1(6) }
        { PH_T0(7)
        {
            LB_IDS(); LB_PTRS();
            if (!gdn && layer < 3) { conv_mixer_weights<true>(a, layer + 1, (bf16_t*)(a.ws + WS_WIN), (bf16_t*)(a.ws + WS_WOUT), (LAS float*)(lds + wave * 16384), gw, NGW, lane); __syncthreads(); }
            pg8::Gemm g{H, Wgu_t, M_TOK, 2 * FF, DM, DM}; pg8::StaticOrder S; S.init(M_TOK, 2 * FF, G, blk);
            const int row_lo = build_rstd_table(lds, S, ssqB, tid);
            EpiSwiglu E{PROJ, FF, ssqB, row_lo >= 0 ? (const LAS float*)(lds + 131072) : nullptr, row_lo};
#if !defined(NO_GEMM) && !defined(NO_P6)
            pg8::gemm_phase<EpiSwiglu, pg8::StaticOrder, true, true>(lds, g, S, E);
#endif
        }
        xcd_barrier(gbar);
        PH_T1(7) }
        { PH_T0(8)
        {
            LB_IDS(); LB_PTRS();
            pg8::Gemm g{PROJ, Wdn_t, M_TOK, DM, FF, FF}; pg8::StaticOrder S; S.init(M_TOK, DM, G, blk);
            EpiRes E{out, out, DM, H, ssqA};
#if !defined(NO_GEMM) && !defined(NO_P7)
            pg8::gemm_phase<EpiRes, pg8::StaticOrder, true, true>(lds, g, S, E);
#endif
        }
        xcd_barrier(gbar);
        PH_T1(8) }
}

__global__ void __launch_bounds__(512, 2) fwd(Args a) {
    extern __shared__ __attribute__((aligned(16))) unsigned char lds_raw[];
    LAS unsigned char* lds = (LAS unsigned char*)lds_raw;
    cg::grid_group grid = cg::this_grid();
    unsigned long long probe_acc = 0;
    if (threadIdx.x < 2) ((LAS unsigned*)(lds + LDS_BARST))[threadIdx.x] = 0u;
    __syncthreads();
    { PH_T0(9)
    {
        int tid = threadIdx.x; asm volatile("" : "+v"(tid)); const int lane = tid & 63, wave = __builtin_amdgcn_readfirstlane(tid >> 6);
        const int gw = blockIdx.x * 8 + wave, NGW = gridDim.x * 8; LAS float* scr = (LAS float*)(lds + wave * 16384);
        conv_mixer_weights<true>(a, 0, (bf16_t*)(a.ws + WS_WIN), (bf16_t*)(a.ws + WS_WOUT), scr, gw, NGW, lane);
        xb_rows(a.in[0], (bf16_t*)(a.ws + WS_H), (float*)(a.ws + WS_SSQ), gw, NGW, lane);
        if (blockIdx.x == 0) for (int i = tid; i < XCD_BAR_WORDS; i += 512) __hip_atomic_store((unsigned*)a.ws + i, 0u, __ATOMIC_RELAXED, __HIP_MEMORY_SCOPE_AGENT);
    }
    grid.sync();
    PH_T1(9) }
    const XcdBarrier gbar = xcd_barrier_post((unsigned*)a.ws, (volatile LAS unsigned*)(lds + LDS_BARST));
#ifdef ONE_LAYER
    layer_body<false>(a, 1, lds, gbar, probe_acc);
#else
    for (int lp = 0; lp < 2; ++lp) {
        layer_body<true>(a, 2 * lp, lds, gbar, probe_acc);
        layer_body<false>(a, 2 * lp + 1, lds, gbar, probe_acc);
    }
#endif
    { PH_T0(10)
    { int tid = threadIdx.x; asm volatile("" : "+v"(tid)); const int lane = tid & 63, wave = __builtin_amdgcn_readfirstlane(tid >> 6); final_norm_rows(a.out, a.in[14], (const float*)(a.ws + WS_SSQ), blockIdx.x * 8 + wave, gridDim.x * 8, lane); }
    if (PROBE_ID == 10) { xcd_barrier(gbar); } PH_T1(10) }
    if (PROBE_ID != 0 && blockIdx.x == 0) { const unsigned long long t0 = __builtin_amdgcn_s_memrealtime(); while (__builtin_amdgcn_s_memrealtime() - t0 < 4ull * probe_acc) __builtin_amdgcn_s_sleep(8); }
}

extern "C" void kernel_launch(void* const* d_in, const int* in_sizes, int n_in, void* d_out, int out_size, void* d_ws, size_t ws_size, hipStream_t stream) {
    static int grid = 0;
    if (grid == 0) {
        if (n_in != 15 || out_size != M_TOK * DM || ws_size < WS_END) { fprintf(stderr, "kernel_launch: unexpected shapes (n_in %d out %d ws %zu)\n", n_in, out_size, ws_size); grid = -1; return; }
        int dev = 0, cus = 0, per_cu = 0;
        hipGetDevice(&dev); hipDeviceGetAttribute(&cus, hipDeviceAttributeMultiprocessorCount, dev);
        hipFuncSetAttribute((const void*)fwd, hipFuncAttributeMaxDynamicSharedMemorySize, LDS_BYTES);
        hipOccupancyMaxActiveBlocksPerMultiprocessor(&per_cu, (const void*)fwd, 512, LDS_BYTES);
        if (per_cu < 1) per_cu = 1;
        grid = cus * per_cu;
        (void)hipGetLastError();
    }
    if (grid < 0) return;
    Args a{};
    for (int i = 0; i < 15; ++i) a.in[i] = (const float*)d_in[i];
    a.out = (float*)d_out; a.ws = (unsigned char*)d_ws;
    void* args[] = {&a};
    hipError_t e = hipLaunchCooperativeKernel((const void*)fwd, dim3(grid), dim3(512), args, LDS_BYTES, stream);
    if (e != hipSuccess) fprintf(stderr, "cooperative launch failed: %s (grid %d)\n", hipGetErrorString(e), grid);
}
```

```cpp
#include <hip/hip_runtime.h>
#include <hip/hip_cooperative_groups.h>
#include <cstdio>
#include <cstdint>
namespace cg = cooperative_groups;
namespace pg8 {
#define PG8_LAS __attribute__((address_space(3)))
typedef unsigned short bf16_t;
typedef short bf16x8 __attribute__((ext_vector_type(8)));
typedef float f32x4 __attribute__((ext_vector_type(4)));
typedef unsigned u32x4 __attribute__((ext_vector_type(4)));
constexpr int BM = 256, BK = 64, HALF = 128, HTB = HALF * BK * 2  , STAGE_BYTES = 8 * HTB, NXCD = 8;

__host__ __device__ __forceinline__ int lds_byte(int r, int c) { const int st = (r >> 4) * 2 + (c >> 5), rr = r & 15, cc = c & 31, ob = rr * 64 + cc * 2; return st * 1024 + (ob ^ (((ob >> 9) & 1) << 5)); }
__host__ __device__ __forceinline__ void stage_rc(int b, int& R, int& C) { const int st = b / 1024, sb = b % 1024, swz = sb ^ (((sb >> 9) & 1) << 5); R = (st >> 1) * 16 + swz / 64; C = (st & 1) * 32 + (swz % 64) / 2; }
__host__ __device__ __forceinline__ int perm32(int rho) { const int n = rho >> 4, i = rho & 15; return 8 * (i >> 2) + 4 * n + (i & 3); }

struct Unit { int pm, pn; };
struct Gemm { const bf16_t* A; const bf16_t* Bt; int M, N, K, lda; };

struct StaticOrder {
    int nM, nN, nwg, G, c, WGM;
    __host__ __device__ void init(int M, int N, int G_, int c_, int wgm = 4) { nM = M / BM; nN = N / BM; nwg = nM * nN; G = G_; c = c_; WGM = wgm; }
    __host__ __device__ bool next(int i, Unit& u) const {
        const long L = (long)i * G + c; if (L >= nwg) return false;
        int wgid = (int)L; { const int q = nwg / NXCD, r = nwg % NXCD, xcd = wgid % NXCD, off = wgid / NXCD; wgid = (xcd < r ? xcd * (q + 1) : r * (q + 1) + (xcd - r) * q) + off; }
        const int nig = WGM * nN, gid = wgid / nig, fm = gid * WGM, gsz = (nM - fm) < WGM ? (nM - fm) : WGM;
        u.pm = fm + ((wgid % nig) % gsz); u.pn = (wgid % nig) / gsz; return true;
    }
    __device__ __forceinline__ void a_ready(const Unit&) const {}
    __device__ __forceinline__ void done(const Unit&) const {}
};

typedef float f32x2_cv __attribute__((ext_vector_type(2))); typedef __bf16 bf16x2_cv __attribute__((ext_vector_type(2)));
__device__ __forceinline__ unsigned cvt_pk_bf16(float lo, float hi) { const f32x2_cv v = {lo, hi}; return __builtin_bit_cast(unsigned, __builtin_convertvector(v, bf16x2_cv)); }
typedef float f32x2 __attribute__((ext_vector_type(2)));
template <class Epi, class Sched, bool ALIGN_EPI = false, bool SP2 = false>
__device__ __forceinline__ void gemm_phase(PG8_LAS unsigned char* lds, const Gemm g, const Sched& S, const Epi& E) {
    int tid_l = threadIdx.x; asm volatile("" : "+v"(tid_l));
    const int tid = tid_l, wid = __builtin_amdgcn_readfirstlane(tid >> 6), lane = tid & 63, wr = wid >> 2, wc = wid & 3, fr = lane & 15, fq = lane >> 4;
    const int K = g.K, nt = K / BK;
    unsigned voffA[2], voffB[2];
#pragma unroll
    for (int i = 0; i < 2; ++i) { int R, C; stage_rc(tid * 16 + i * 8192, R, C); const int Rb = Epi::PERM ? ((R & ~31) + perm32(R & 31)) : R;
        voffA[i] = (unsigned)(R * g.lda + C) * 2u; voffB[i] = (unsigned)(Rb * K + C) * 2u; }
    const size_t kstep = (size_t)(BK * 2);
    const size_t hstepA = (size_t)HALF * g.lda * 2, hstepB = (size_t)HALF * K * 2;
    const size_t tstepA = 2 * hstepA, tstepB = 2 * hstepB;
    const unsigned ldsw = (unsigned)wid * 1024u;
    const int aoff = lds_byte(wr * 64 + fr, fq * 8), boff = lds_byte(wc * 32 + fr, fq * 8);
#define PG8_SA(b, h) (((b) * 2 + (h)) * HTB)
#define PG8_SB(b, h) ((4 + (b) * 2 + (h)) * HTB)
#define PG8_STAGE(bufoff, gbase, voff) do { _Pragma("unroll") for (int _i = 0; _i < 2; ++_i) \
        __builtin_amdgcn_global_load_lds((const unsigned*)((const char*)(gbase) + (voff)[_i]), (PG8_LAS unsigned*)(lds + (bufoff) + ldsw + _i * 8192), 16, 0, 0); } while (0)
#define PG8_LDA(dst, b, h) do { _Pragma("unroll") for (int m = 0; m < 4; ++m) _Pragma("unroll") for (int k = 0; k < 2; ++k) dst[m][k] = *(const PG8_LAS bf16x8*)(lds + PG8_SA(b, h) + aoff + m * 2048 + k * 1024); } while (0)
#define PG8_LDB(dst, b, h) do { _Pragma("unroll") for (int n = 0; n < 2; ++n) _Pragma("unroll") for (int k = 0; k < 2; ++k) dst[n][k] = *(const PG8_LAS bf16x8*)(lds + PG8_SB(b, h) + boff + n * 2048 + k * 1024); } while (0)
#define PG8_MMA(ai, bj, At, Bt) do { __builtin_amdgcn_s_setprio(1); _Pragma("unroll") for (int m = 0; m < 4; ++m) _Pragma("unroll") for (int n = 0; n < 2; ++n) _Pragma("unroll") for (int k = 0; k < 2; ++k) \
        acc[ai][bj][m][n] = __builtin_amdgcn_mfma_f32_16x16x32_bf16(Bt[n][k], At[m][k], acc[ai][bj][m][n], 0, 0, 0); __builtin_amdgcn_s_setprio(0); } while (0)
#define PG8_WAIT_V(n) asm volatile("s_waitcnt vmcnt(" #n ")" ::: "memory")
#define PG8_WAIT_L(n) asm volatile("s_waitcnt lgkmcnt(" #n ")" ::: "memory")
#define PG8_BAR __builtin_amdgcn_s_barrier()
#define PG8_SCHED __builtin_amdgcn_sched_barrier(0)
    Unit cur, nxt; int ui = 0;
    if (!S.next(0, cur)) return;
    f32x4 acc[2][2][4][2];
#pragma unroll
    for (int a = 0; a < 2; ++a)
#pragma unroll
        for (int b = 0; b < 2; ++b)
#pragma unroll
            for (int m = 0; m < 4; ++m)
#pragma unroll
                for (int n = 0; n < 2; ++n) acc[a][b][m][n] = (f32x4){0.f, 0.f, 0.f, 0.f};
    bf16x8 At[4][2], B0[2][2], B1[2][2];
    const char* cA = (const char*)g.A + (size_t)cur.pm * tstepA; const char* cB = (const char*)g.Bt + (size_t)cur.pn * tstepB;
    S.a_ready(cur);
    if constexpr (SP2) {
        PG8_STAGE(PG8_SB(0, 0), cB, voffB); PG8_STAGE(PG8_SB(0, 1), cB + hstepB, voffB); PG8_STAGE(PG8_SA(0, 0), cA, voffA); PG8_STAGE(PG8_SA(0, 1), cA + hstepA, voffA);
        if (wr == 1) PG8_BAR;
        PG8_WAIT_V(2); PG8_BAR;
        PG8_STAGE(PG8_SB(1, 0), cB + kstep, voffB); PG8_STAGE(PG8_SA(1, 0), cA + kstep, voffA); PG8_STAGE(PG8_SB(1, 1), cB + hstepB + kstep, voffB);
        PG8_WAIT_V(6); PG8_BAR;
    } else {
        PG8_STAGE(PG8_SB(0, 0), cB, voffB); PG8_STAGE(PG8_SA(0, 0), cA, voffA); PG8_STAGE(PG8_SB(0, 1), cB + hstepB, voffB); PG8_STAGE(PG8_SA(0, 1), cA + hstepA, voffA);
        if (wr == 1) PG8_BAR;
        PG8_WAIT_V(4); PG8_BAR;
        PG8_STAGE(PG8_SB(1, 0), cB + kstep, voffB); PG8_STAGE(PG8_SA(1, 0), cA + kstep, voffA); PG8_STAGE(PG8_SB(1, 1), cB + hstepB + kstep, voffB);
        PG8_WAIT_V(6); PG8_BAR;
    }
    for (;;) {
        const bool has_next = S.next(ui + 1, nxt);
        const char* nA = has_next ? (const char*)g.A + (size_t)nxt.pm * tstepA : cA; const char* nB = has_next ? (const char*)g.Bt + (size_t)nxt.pn * tstepB : cB;
        for (int t = 0; t < nt; t += 2) {
            const bool last = (t == nt - 2);
            const char* a1 = cA + (size_t)(t + 1) * kstep;
            const char* a2 = last ? nA : cA + (size_t)(t + 2) * kstep; const char* b2 = last ? nB : cB + (size_t)(t + 2) * kstep;
            const char* a3 = a2 + kstep; const char* b3 = b2 + kstep;
            if (last && has_next) S.a_ready(nxt);
            if constexpr (SP2) {
            PG8_LDB(B0, 0, 0); PG8_LDB(B1, 0, 1); PG8_SCHED; PG8_LDA(At, 0, 0); PG8_STAGE(PG8_SA(1, 1), a1 + hstepA, voffA);
            PG8_WAIT_V(8); PG8_WAIT_L(0); PG8_BAR; PG8_MMA(0, 0, At, B0); PG8_MMA(0, 1, At, B1); PG8_BAR; PG8_SCHED;
            PG8_LDA(At, 0, 1); PG8_STAGE(PG8_SB(0, 0), b2, voffB); PG8_STAGE(PG8_SB(0, 1), b2 + hstepB, voffB); PG8_STAGE(PG8_SA(0, 0), a2, voffA);
            PG8_WAIT_V(8); PG8_WAIT_L(0); PG8_BAR; PG8_MMA(1, 0, At, B0); PG8_MMA(1, 1, At, B1); PG8_BAR; PG8_SCHED;
            PG8_LDB(B0, 1, 0); PG8_LDB(B1, 1, 1); PG8_SCHED; PG8_LDA(At, 1, 0); PG8_STAGE(PG8_SA(0, 1), a2 + hstepA, voffA);
            PG8_WAIT_V(8); PG8_WAIT_L(0); PG8_BAR; PG8_MMA(0, 0, At, B0); PG8_MMA(0, 1, At, B1); PG8_BAR; PG8_SCHED;
            PG8_LDA(At, 1, 1); PG8_STAGE(PG8_SB(1, 0), b3, voffB); PG8_STAGE(PG8_SB(1, 1), b3 + hstepB, voffB); PG8_STAGE(PG8_SA(1, 0), a3, voffA);
            PG8_WAIT_V(8); PG8_WAIT_L(0); PG8_BAR; PG8_MMA(1, 0, At, B0); PG8_MMA(1, 1, At, B1); PG8_BAR; PG8_SCHED;
            } else {
            PG8_LDB(B0, 0, 0); PG8_SCHED; PG8_LDA(At, 0, 0); PG8_STAGE(PG8_SA(1, 1), a1 + hstepA, voffA);
            PG8_WAIT_L(8); PG8_BAR; PG8_WAIT_L(0); PG8_MMA(0, 0, At, B0); PG8_BAR; PG8_SCHED;
            PG8_LDB(B1, 0, 1); PG8_STAGE(PG8_SB(0, 0), b2, voffB);
            PG8_BAR; PG8_WAIT_L(0); PG8_MMA(0, 1, At, B1); PG8_BAR;
            PG8_LDA(At, 0, 1); PG8_STAGE(PG8_SA(0, 0), a2, voffA);
            PG8_BAR; PG8_WAIT_L(0); PG8_MMA(1, 0, At, B0); PG8_BAR; PG8_SCHED;
            PG8_STAGE(PG8_SB(0, 1), b2 + hstepB, voffB);
            PG8_WAIT_V(6); PG8_BAR; PG8_MMA(1, 1, At, B1); PG8_BAR;
            PG8_LDB(B0, 1, 0); PG8_SCHED; PG8_LDA(At, 1, 0); PG8_STAGE(PG8_SA(0, 1), a2 + hstepA, voffA);
            PG8_WAIT_L(8); PG8_BAR; PG8_WAIT_L(0); PG8_MMA(0, 0, At, B0); PG8_BAR; PG8_SCHED;
            PG8_LDB(B1, 1, 1); PG8_STAGE(PG8_SB(1, 0), b3, voffB);
            PG8_BAR; PG8_WAIT_L(0); PG8_MMA(0, 1, At, B1); PG8_BAR;
            PG8_LDA(At, 1, 1); PG8_STAGE(PG8_SA(1, 0), a3, voffA);
            PG8_BAR; PG8_WAIT_L(0); PG8_MMA(1, 0, At, B0); PG8_BAR; PG8_SCHED;
            PG8_STAGE(PG8_SB(1, 1), b3 + hstepB, voffB);
            PG8_WAIT_V(6); PG8_BAR; PG8_MMA(1, 1, At, B1); PG8_BAR;
            }
        }
        if constexpr (ALIGN_EPI) { if (wr == 0) PG8_BAR; }
        if constexpr (!Epi::AFTER_DRAIN) { E(acc, cur, wr, wc, fr, fq); S.done(cur); }
        if (!has_next) break;
#pragma unroll
        for (int a = 0; a < 2; ++a)
#pragma unroll
            for (int b = 0; b < 2; ++b)
#pragma unroll
                for (int m = 0; m < 4; ++m)
#pragma unroll
                    for (int n = 0; n < 2; ++n) acc[a][b][m][n] = (f32x4){0.f, 0.f, 0.f, 0.f};
        cur = nxt; cA = nA; cB = nB; ++ui;
        if constexpr (ALIGN_EPI) { if (wr == 1) PG8_BAR; }
    }
    PG8_WAIT_V(0);
    if constexpr (!ALIGN_EPI) { if (wr == 0) PG8_BAR; }
    PG8_BAR;
    if constexpr (Epi::AFTER_DRAIN) { E.fused(acc, cur, wr, wc, fr, fq, lds, wid, lane); S.done(cur); }
#undef PG8_SA
#undef PG8_SB
#undef PG8_STAGE
#undef PG8_LDA
#undef PG8_LDB
#undef PG8_MMA
#undef PG8_WAIT_V
#undef PG8_WAIT_L
#undef PG8_BAR
#undef PG8_SCHED
}
}

constexpr int M_TOK = 32768, DM = 1024, SEQ = 4096, NB = 8;
constexpr int GDN_N = 6176, GDN_NP = 6400, GDN_PITCH = 6144, FF = 2816;
constexpr float EPS = 1e-6f;
#define LAS __attribute__((address_space(3)))
typedef unsigned short bf16_t;
typedef short bf16x8 __attribute__((ext_vector_type(8)));
typedef float f32x4 __attribute__((ext_vector_type(4)));
typedef float f32x16 __attribute__((ext_vector_type(16)));
typedef unsigned u32x4 __attribute__((ext_vector_type(4)));
typedef unsigned u32x2 __attribute__((ext_vector_type(2)));
using pg8::cvt_pk_bf16;

constexpr size_t MiB = 1u << 20;
constexpr size_t WS_WIN = 1 * MiB, WS_WOUT = 14 * MiB, WS_WGU = 18 * MiB, WS_WDN = 29 * MiB, WS_GB = 36 * MiB, WS_H = 40 * MiB, WS_PROJ = 104 * MiB, WS_SSQ = 488 * MiB, WS_ALT_WOUT = 492 * MiB, WS_ALT_WGU = 494 * MiB, WS_ALT_WDN = 505 * MiB, WS_END = 511 * MiB;
constexpr int LDS_BYTES = 147456 + 256, LDS_BARST = 147456;
#ifndef PROBE_ID
#define PROBE_ID 0
#endif
#define PH_T0(id) unsigned long long ph_t0_ = 0; if (PROBE_ID == (id)) ph_t0_ = __builtin_amdgcn_s_memrealtime();
#define PH_T1(id) if (PROBE_ID == (id)) probe_acc += __builtin_amdgcn_s_memrealtime() - ph_t0_;

__device__ __forceinline__ float bf2f(unsigned short b) { return __uint_as_float(((unsigned)b) << 16); }
__device__ __forceinline__ float bflo(unsigned u) { return __uint_as_float(u << 16); }
__device__ __forceinline__ float bfhi(unsigned u) { return __uint_as_float(u & 0xffff0000u); }
template <int CTRL> __device__ __forceinline__ float dpp_f(float v) { return __builtin_bit_cast(float, __builtin_amdgcn_update_dpp(0, __builtin_bit_cast(int, v), CTRL, 0xf, 0xf, true)); }
__device__ __forceinline__ float wave_sum(float v) {
    v += dpp_f<0xB1>(v); v += dpp_f<0x4E>(v); v += dpp_f<0x141>(v); v += dpp_f<0x140>(v);
    const int vi = __builtin_bit_cast(int, v);
    return (__builtin_bit_cast(float, __builtin_amdgcn_readlane(vi, 0)) + __builtin_bit_cast(float, __builtin_amdgcn_readlane(vi, 16))) +
           (__builtin_bit_cast(float, __builtin_amdgcn_readlane(vi, 32)) + __builtin_bit_cast(float, __builtin_amdgcn_readlane(vi, 48)));
}
__device__ __forceinline__ float silu_f(float v) { return v * __builtin_amdgcn_rcpf(1.f + __expf(-v)); }
__device__ __forceinline__ float softplus_f(float x) { return fmaxf(x, 0.f) + __logf(1.f + __expf(-fabsf(x))); }

__device__ __forceinline__ float rstd_of(const float* ssq16, int row) {
    const f32x4* p = (const f32x4*)(ssq16 + (size_t)row * 16);
    const f32x4 a = p[0], b = p[1], c = p[2], d = p[3];
    const f32x4 t = (a + b) + (c + d);
    return __builtin_amdgcn_rsqf(((t[0] + t[1]) + (t[2] + t[3])) * (1.f / DM) + EPS);
}
struct EpiProj {
    static constexpr bool PERM = true, AFTER_DRAIN = false;
    bf16_t* O; int ldc; int gate_tile; float* gb; const float* a_log; const float* dt_bias; int scale_tiles; float scale; const float* ssq; const LAS float* rl; int row_lo; int silu_lo, silu_hi;
    __device__ __forceinline__ void operator()(const f32x4 (&acc)[2][2][4][2], const pg8::Unit& u, int wr, int wc, int fr, int fq) const {
        const int row0 = u.pm * 256 + wr * 64 + fr;
#define RS_OF(ai, m) (rl ? rl[row0 + (ai) * 128 + (m) * 16 - row_lo] : rstd_of(ssq, row0 + (ai) * 128 + (m) * 16))
        if (u.pn == gate_tile) {
            if (wc == 0) {
                const int c0 = 8 * fq;
#pragma unroll
                for (int ai = 0; ai < 2; ++ai)
#pragma unroll
                    for (int m = 0; m < 4; ++m) {
                        const int row = row0 + ai * 128 + m * 16; const float rsv = RS_OF(ai, m);
#pragma unroll
                        for (int n = 0; n < 2; ++n) {
                            const f32x4 v = acc[ai][0][m][n] * rsv; f32x4 o;
                            const int c = c0 + 4 * n;
                            if (fq < 2) {
#pragma unroll
                                for (int j = 0; j < 4; ++j) o[j] = 1.f / (1.f + __expf(-v[j]));
                            } else {
                                const f32x4 al = *(const f32x4*)(a_log + c - 16), db = *(const f32x4*)(dt_bias + c - 16);
#pragma unroll
                                for (int j = 0; j < 4; ++j) o[j] = -__expf(al[j]) * softplus_f(v[j] + db[j]);
                            }
                            *(f32x4*)(gb + (size_t)row * 32 + c) = o;
                        }
                    }
            }
            return;
        }
        const int col0 = u.pn * 256 + wc * 32 + 8 * fq;
        const float sc = (u.pn < scale_tiles) ? scale : 1.f;
#pragma unroll
        for (int ai = 0; ai < 2; ++ai)
#pragma unroll
            for (int m = 0; m < 4; ++m) { bf16_t* rowp = O + (size_t)(row0 + ai * 128 + m * 16) * ldc + col0; const float sr = sc * RS_OF(ai, m);
#pragma unroll
                for (int bj = 0; bj < 2; ++bj) { f32x4 v0 = acc[ai][bj][m][0] * sr, v1 = acc[ai][bj][m][1] * sr;
                    if (u.pn >= silu_lo && u.pn < silu_hi) {
#pragma unroll
                        for (int e = 0; e < 4; ++e) { v0[e] = silu_f(v0[e]); v1[e] = silu_f(v1[e]); } }
                    u32x4 w; w.x = cvt_pk_bf16(v0[0], v0[1]); w.y = cvt_pk_bf16(v0[2], v0[3]); w.z = cvt_pk_bf16(v1[0], v1[1]); w.w = cvt_pk_bf16(v1[2], v1[3]);
                    *(u32x4*)(rowp + bj * 128) = w; } }
    }
};
struct EpiSwiglu {
    static constexpr bool PERM = true, AFTER_DRAIN = false;
    bf16_t* O; int ldc; const float* ssq; const LAS float* rl; int row_lo;
    __device__ __forceinline__ void operator()(const f32x4 (&acc)[2][2][4][2], const pg8::Unit& u, int wr, int wc, int fr, int fq) const {
        const int row0 = u.pm * 256 + wr * 64 + fr, col0 = u.pn * 128 + wc * 32 + 8 * fq;
#pragma unroll
        for (int ai = 0; ai < 2; ++ai)
#pragma unroll
            for (int m = 0; m < 4; ++m) { bf16_t* rowp = O + (size_t)(row0 + ai * 128 + m * 16) * ldc + col0;
                float r[8]; const float rsd = rl ? rl[row0 + ai * 128 + m * 16 - row_lo] : rstd_of(ssq, row0 + ai * 128 + m * 16);
#pragma unroll
                for (int n = 0; n < 2; ++n)
#pragma unroll
                    for (int j = 0; j < 4; ++j) { const float g = acc[ai][0][m][n][j] * rsd, up = acc[ai][1][m][n][j] * rsd; r[4 * n + j] = silu_f(g) * up; }
                u32x4 w; w.x = cvt_pk_bf16(r[0], r[1]); w.y = cvt_pk_bf16(r[2], r[3]); w.z = cvt_pk_bf16(r[4], r[5]); w.w = cvt_pk_bf16(r[6], r[7]);
                *(u32x4*)rowp = w; }
    }
};
struct EpiRes {
    static constexpr bool PERM = false, AFTER_DRAIN = false;
    const float* base; float* out; int ldc; bf16_t* xb; float* ssq;
    __device__ __forceinline__ void operator()(const f32x4 (&acc)[2][2][4][2], const pg8::Unit& u, int wr, int wc, int fr, int fq) const {
        const int row0 = u.pm * 256 + wr * 64 + fr, col0 = u.pn * 256 + wc * 32 + 4 * fq;
#pragma unroll
        for (int ai = 0; ai < 2; ++ai) {
            f32x4 bs[4][2][2];
#pragma unroll
            for (int m = 0; m < 4; ++m) { const size_t off = (size_t)(row0 + ai * 128 + m * 16) * ldc + col0;
#pragma unroll
                for (int bj = 0; bj < 2; ++bj)
#pragma unroll
                    for (int n = 0; n < 2; ++n) bs[m][bj][n] = *(const f32x4*)(base + off + bj * 128 + n * 16); }
#pragma unroll
            for (int m = 0; m < 4; ++m) { const int row = row0 + ai * 128 + m * 16; const size_t off = (size_t)row * ldc + col0; float sq = 0.f;
#pragma unroll
                for (int bj = 0; bj < 2; ++bj)
#pragma unroll
                    for (int n = 0; n < 2; ++n) { const f32x4 o = bs[m][bj][n] + acc[ai][bj][m][n]; *(f32x4*)(out + off + bj * 128 + n * 16) = o;
                        sq += (o[0] * o[0] + o[1] * o[1]) + (o[2] * o[2] + o[3] * o[3]);
                        *(u32x2*)(xb + off + bj * 128 + n * 16) = (u32x2){cvt_pk_bf16(o[0], o[1]), cvt_pk_bf16(o[2], o[3])}; }
                sq += __shfl_xor(sq, 16); sq += __shfl_xor(sq, 32);
                if (fq == 0) ssq[(size_t)row * 16 + u.pn * 4 + wc] = sq; }
            asm volatile("" ::: "memory");
        }
    }
};

__device__ __forceinline__ unsigned f2bf(float f) { unsigned u = __float_as_uint(f); return (u + 0x7fffu + ((u >> 16) & 1u)) >> 16; }
__device__ __forceinline__ unsigned pk2(float lo, float hi) { return f2bf(lo) | (f2bf(hi) << 16); }
__device__ __forceinline__ void transpose_item(const float* W, int K, int N, bf16_t* WT, int k0, int n0, int drow0, LAS float* scr, int lane, const float* kscale) {
    const float ks = kscale ? kscale[k0 + lane] : 1.f;
#pragma unroll 8
    for (int i = 0; i < 32; ++i) { const int kk = 2 * i + (lane >> 5); scr[kk * 33 + (lane & 31)] = W[(size_t)(k0 + kk) * N + n0 + (lane & 31)] * __shfl(ks, kk); }
    asm volatile("s_waitcnt lgkmcnt(0)" ::: "memory");
    const int c = lane & 7;
#pragma unroll
    for (int j = 0; j < 4; ++j) { const int n = (lane >> 3) + 8 * j; const LAS float* s = scr + (8 * c) * 33 + n;
        u32x4 o; o.x = pk2(s[0 * 33], s[1 * 33]); o.y = pk2(s[2 * 33], s[3 * 33]); o.z = pk2(s[4 * 33], s[5 * 33]); o.w = pk2(s[6 * 33], s[7 * 33]);
        *(u32x4*)(WT + (size_t)(drow0 + n) * K + k0 + 8 * c) = o; }
    asm volatile("s_waitcnt lgkmcnt(0)" ::: "memory");
}
__device__ __forceinline__ void conv_plain(const float* W, int K, int N, bf16_t* WT, int item, LAS float* scr, int lane, const float* kscale) {
    const int nblk = N / 32, kb = item / nblk, nb = item % nblk;
    transpose_item(W, K, N, WT, 64 * kb, 32 * nb, 32 * nb, scr, lane, kscale);
}
__device__ __forceinline__ void conv_gu(const float* W, bf16_t* WT, int item, int up, LAS float* scr, int lane, const float* kscale) {
    const int nblk = FF / 32, kb = item / nblk, nb = item % nblk, n0 = 32 * nb;
    transpose_item(W, DM, FF, WT, 64 * kb, n0, (n0 >> 7) * 256 + (n0 & 127) + up * 128, scr, lane, kscale);
}
__device__ __forceinline__ void xb_rows(const float* x, bf16_t* xb, float* ssq, int gw, int NGW, int lane) {
    asm volatile("" : "+v"(lane));
    f32x4 v[4], vn[4];
    if (gw < M_TOK) {
#pragma unroll
        for (int j = 0; j < 4; ++j) v[j] = *((const f32x4*)(x + (size_t)gw * DM) + lane + 64 * j);
    }
    for (int m = gw; m < M_TOK; m += NGW) {
        if (m + NGW < M_TOK) {
#pragma unroll
            for (int j = 0; j < 4; ++j) vn[j] = *((const f32x4*)(x + (size_t)(m + NGW) * DM) + lane + 64 * j);
        }
        float s = 0.f;
#pragma unroll
        for (int j = 0; j < 4; ++j) s += (v[j].x * v[j].x + v[j].y * v[j].y) + (v[j].z * v[j].z + v[j].w * v[j].w);
        s = wave_sum(s);
        if (lane < 16) ssq[(size_t)m * 16 + lane] = (lane == 0) ? s : 0.f;
        u32x2* o8 = (u32x2*)(xb + (size_t)m * DM) + lane;
#pragma unroll
        for (int j = 0; j < 4; ++j) { u32x2 p; p.x = cvt_pk_bf16(v[j].x, v[j].y); p.y = cvt_pk_bf16(v[j].z, v[j].w); o8[64 * j] = p; }
#pragma unroll
        for (int j = 0; j < 4; ++j) v[j] = vn[j];
    }
}
__device__ __forceinline__ void final_norm_rows(float* x, const float* w, const float* ssq, int gw, int NGW, int lane) {
    f32x4 wv[4], v[4], vn[4]; float rstd = 0.f, rstdn = 0.f;
#pragma unroll
    for (int j = 0; j < 4; ++j) wv[j] = *((const f32x4*)w + lane + 64 * j);
    if (gw < M_TOK) {
#pragma unroll
        for (int j = 0; j < 4; ++j) v[j] = *((const f32x4*)(x + (size_t)gw * DM) + lane + 64 * j);
        rstd = rstd_of(ssq, gw);
    }
    for (int m = gw; m < M_TOK; m += NGW) {
        if (m + NGW < M_TOK) {
#pragma unroll
            for (int j = 0; j < 4; ++j) vn[j] = *((const f32x4*)(x + (size_t)(m + NGW) * DM) + lane + 64 * j);
            rstdn = rstd_of(ssq, m + NGW);
        }
        f32x4* xr = (f32x4*)(x + (size_t)m * DM) + lane;
#pragma unroll
        for (int j = 0; j < 4; ++j) xr[64 * j] = v[j] * rstd * wv[j];
#pragma unroll
        for (int j = 0; j < 4; ++j) v[j] = vn[j];
        rstd = rstdn;
    }
}

__device__ __forceinline__ void gdn_g0(LAS unsigned char* lds, bf16_t* proj, const float* __restrict__ convw, int blk, int G, int tid, int wave, int lane) {
    asm volatile("" : "+v"(lane), "+v"(tid));
    LAS unsigned* halo = (LAS unsigned*)lds;
    for (int unit = blk; unit < NB * 32; unit += G) {
        const int b = unit >> 5, slab = unit & 31, col = slab * 128 + 2 * lane;
        const f32x4 w0 = *(const f32x4*)(convw + (size_t)col * 4), w1 = *(const f32x4*)(convw + (size_t)(col + 1) * 4);
        const float nsc = (slab < 8) ? 0.08838834764831845f : 1.f;
        const bool donorm = slab < 16;
        bf16_t* base = proj + (size_t)b * SEQ * GDN_PITCH + col;
        constexpr int RPW = 32, CH = 8 * RPW, NCH = SEQ / CH;
        unsigned x[RPW + 3], xn[RPW + 3];
#pragma unroll
        for (int j = 0; j < RPW + 3; ++j) { const int t = RPW * wave - 3 + j; x[j] = (t >= 0) ? *(const unsigned*)(base + (size_t)t * GDN_PITCH) : 0u; }
        __syncthreads();
        for (int chunk = 0; chunk < NCH; ++chunk) {
            if (chunk < NCH - 1) {
#pragma unroll
                for (int j = 0; j < RPW + 3; ++j) { const int t = RPW * wave - 3 + j; if (t >= 0) xn[j] = *(const unsigned*)(base + (size_t)((chunk + 1) * CH + t) * GDN_PITCH); }
            }
            if (wave == 7) {
#pragma unroll
                for (int j = 0; j < 3; ++j) halo[(((chunk + 1) & 1) * 3 + j) * 64 + lane] = x[RPW + j];
            }
            unsigned o[RPW];
#pragma unroll
            for (int r = 0; r < RPW; ++r) {
                float a0 = bflo(x[r]) * w0[0] + bflo(x[r + 1]) * w0[1] + bflo(x[r + 2]) * w0[2] + bflo(x[r + 3]) * w0[3];
                float a1 = bfhi(x[r]) * w1[0] + bfhi(x[r + 1]) * w1[1] + bfhi(x[r + 2]) * w1[2] + bfhi(x[r + 3]) * w1[3];
                a0 = silu_f(a0); a1 = silu_f(a1);
                if (donorm) { const float rn = nsc * __builtin_amdgcn_rsqf(wave_sum(a0 * a0 + a1 * a1) + EPS); a0 *= rn; a1 *= rn; }
                o[r] = cvt_pk_bf16(a0, a1);
            }
            __syncthreads();
            bf16_t* cb = base + (size_t)(chunk * CH + RPW * wave) * GDN_PITCH;
#pragma unroll
            for (int r = 0; r < RPW; ++r) *(unsigned*)(cb + (size_t)r * GDN_PITCH) = o[r];
            if (chunk < NCH - 1) {
#pragma unroll
                for (int j = 0; j < RPW + 3; ++j) { const int t = RPW * wave - 3 + j; x[j] = (t >= 0) ? xn[j] : halo[(((chunk + 1) & 1) * 3 + j) * 64 + lane]; }
            }
        }
        __syncthreads();
    }
}

__device__ __forceinline__ int crow(int r, int hi) { return (r & 3) + 8 * (r >> 2) + 4 * hi; }

__device__ __forceinline__ void gdn_g1(LAS unsigned char* lds, const bf16_t* __restrict__ proj, const float* gb, float* gcs, const float* __restrict__ convw,
                                        bf16_t* __restrict__ Tbuf, int gw, int NGW, int wave, int lane) {
    asm volatile("" : "+v"(lane));
    LAS float* Lw = (LAS float*)(lds + wave * 16384);
    LAS float* aux = (LAS float*)(lds + 131072 + wave * 1024);
    const int r32 = lane & 31, hi = lane >> 5;
    for (int u = gw; u < NB * 64 * 16; u += NGW) {
        const int hv = u & 15, chunk = (u >> 4) & 63, b = u >> 10, hq = hv >> 1;
        const size_t rowb = (size_t)b * SEQ + chunk * 64;
        {
            float g = gb[(rowb + lane) * 32 + 16 + hv]; const float bt = gb[(rowb + lane) * 32 + hv];
#pragma unroll
            for (int o = 1; o < 64; o <<= 1) { const float t = __shfl_up(g, o); if (lane >= o) g += t; }
            aux[lane] = g; aux[64 + lane] = bt;
            gcs[(rowb + lane) * 32 + 16 + hv] = g;
        }
        f32x16 a00 = {}, a10 = {}, a11 = {};
        {
            const bf16_t* kp = proj + (rowb + r32) * GDN_PITCH + 1024 + hq * 128 + 8 * hi;
            bf16x8 kf0[8], kf1[8];
#pragma unroll
            for (int kk = 0; kk < 8; ++kk) { kf0[kk] = *(const bf16x8*)(kp + 16 * kk); kf1[kk] = *(const bf16x8*)(kp + (size_t)32 * GDN_PITCH + 16 * kk); }
#pragma unroll
            for (int kk = 0; kk < 8; ++kk) {
                a00 = __builtin_amdgcn_mfma_f32_32x32x16_bf16(kf0[kk], kf0[kk], a00, 0, 0, 0);
                a10 = __builtin_amdgcn_mfma_f32_32x32x16_bf16(kf1[kk], kf0[kk], a10, 0, 0, 0);
                a11 = __builtin_amdgcn_mfma_f32_32x32x16_bf16(kf1[kk], kf1[kk], a11, 0, 0, 0);
            }
        }
        asm volatile("s_waitcnt lgkmcnt(0)" ::: "memory");
        {
            const float gcj0 = aux[r32], gcj1 = aux[32 + r32];
#pragma unroll
            for (int r = 0; r < 16; ++r) {
                const int i0 = crow(r, hi), i1 = 32 + i0;
                const float gi0 = aux[i0], gi1 = aux[i1], bi0 = aux[64 + i0], bi1 = aux[64 + i1];
                Lw[i0 * 64 + r32] = (i0 > r32) ? bi0 * a00[r] * __expf(gi0 - gcj0) : 0.f;
                Lw[i1 * 64 + r32] = bi1 * a10[r] * __expf(gi1 - gcj0);
                Lw[i1 * 64 + 32 + r32] = (i0 > r32) ? bi1 * a11[r] * __expf(gi1 - gcj1) : 0.f;
            }
        }
        asm volatile("s_waitcnt lgkmcnt(0)" ::: "memory");
        float X[64];
#pragma unroll
        for (int i = 0; i < 64; ++i) {
            float xi = (lane == i) ? 1.f : 0.f, xj = 0.f;
#pragma unroll
            for (int g4 = 0; g4 < (i + 3) / 4; ++g4) {
                const f32x4 l = *(const LAS f32x4*)(Lw + i * 64 + 4 * g4);
#pragma unroll
                for (int e = 0; e < 4; ++e) { const int j = 4 * g4 + e; if (j < i) { if (j & 1) xj -= l[e] * X[j]; else xi -= l[e] * X[j]; } }
            }
            X[i] = xi + xj;
            asm volatile("" ::: "memory");
        }
        bf16_t* To = Tbuf + (size_t)((b * 16 + hv) * 64 + chunk) * 4096 + lane;
#pragma unroll
        for (int i = 0; i < 64; ++i) To[i * 64] = (bf16_t)f2bf(X[i]);
        asm volatile("s_waitcnt lgkmcnt(0)" ::: "memory");
    }
}

namespace g2 {
constexpr int QN = 0, KN = 18432, KNT = 35840, VT = 54272, RT = 72704, ST = 91136, TL = 125952, ATT = 135168, AUX = 144384;
constexpr int P128 = 272, P64 = 144;
__device__ __forceinline__ f32x16 mma(f32x16 acc, LAS const unsigned char* A, int ap, LAS const unsigned char* B, int bp, int nk, int r32, int hi) {
    LAS const unsigned char* a = A + r32 * ap + 16 * hi; LAS const unsigned char* b = B + r32 * bp + 16 * hi;
#pragma unroll
    for (int kk = 0; kk < 8; ++kk) if (kk < nk) {
        const bf16x8 av = *(LAS const bf16x8*)(a + 32 * kk), bv = *(LAS const bf16x8*)(b + 32 * kk);
        acc = __builtin_amdgcn_mfma_f32_32x32x16_bf16(av, bv, acc, 0, 0, 0);
    }
    return acc;
}
}
__device__ __forceinline__ void gdn_g2(LAS unsigned char* lds, bf16_t* proj, const float* __restrict__ gb, const float* __restrict__ convw, const float* __restrict__ normw,
                                        const bf16_t* __restrict__ Tbuf, int unit0, int ustride, int tid, int wave, int lane) {
    using namespace g2;
    asm volatile("" : "+v"(lane), "+v"(tid));
    const int r32 = lane & 31, hi = lane >> 5, ti = wave & 1, tj = wave >> 1;
    LAS float* aux = (LAS float*)(lds + AUX);
    for (int unit = unit0; unit < NB * 16; unit += ustride) {
        const int b = unit >> 4, hv = unit & 15, hq = hv >> 1;
        const int colq = hq * 128 + 2 * lane, colk = 1024 + colq, colv = 2048 + hv * 128 + 2 * lane, colz = 4096 + hv * 128 + 2 * lane;
        const float nw0 = normw[2 * lane], nw1 = normw[2 * lane + 1];
        f32x16 S0 = {}, S1 = {};
        for (int i = tid; i < 34816 / 4; i += 512) ((LAS unsigned*)(lds + ST))[i] = 0u;
        unsigned xq[8], xk[8], xv[8];
#define G2_LOADX(CH) do { _Pragma("unroll") for (int r = 0; r < 8; ++r) { const bf16_t* p = proj + (size_t)((long)b * SEQ + (CH) * 64 + 8 * wave + r) * GDN_PITCH; \
            xq[r] = *(const unsigned*)(p + colq); xk[r] = *(const unsigned*)(p + colk); xv[r] = *(const unsigned*)(p + colv); } } while (0)
        G2_LOADX(0);
        for (int chunk = 0; chunk < 64; ++chunk) {
            const size_t rowb = (size_t)b * SEQ + chunk * 64;
            unsigned zreg[8]; u32x4 treg;
            {
#pragma unroll
                for (int r = 0; r < 8; ++r) zreg[r] = *(const unsigned*)(proj + (rowb + 8 * wave + r) * GDN_PITCH + colz);
                treg = *(const u32x4*)(Tbuf + (size_t)((b * 16 + hv) * 64 + chunk) * 4096 + (tid >> 3) * 64 + (tid & 7) * 8);
#pragma unroll
                for (int r = 0; r < 8; ++r) {
                    *(LAS unsigned*)(lds + QN + (8 * wave + r) * P128 + 4 * lane) = xq[r];
                    *(LAS unsigned*)(lds + KN + (8 * wave + r) * P128 + 4 * lane) = xk[r];
                }
#define PKLO(a, b) (((a) & 0xffffu) | ((b) << 16))
#define PKHI(a, b) (((a) >> 16) | ((b) & 0xffff0000u))
                *(LAS u32x4*)(lds + KNT + (2 * lane) * P64 + 16 * wave) = (u32x4){PKLO(xk[0], xk[1]), PKLO(xk[2], xk[3]), PKLO(xk[4], xk[5]), PKLO(xk[6], xk[7])};
                *(LAS u32x4*)(lds + KNT + (2 * lane + 1) * P64 + 16 * wave) = (u32x4){PKHI(xk[0], xk[1]), PKHI(xk[2], xk[3]), PKHI(xk[4], xk[5]), PKHI(xk[6], xk[7])};
                *(LAS u32x4*)(lds + VT + (2 * lane) * P64 + 16 * wave) = (u32x4){PKLO(xv[0], xv[1]), PKLO(xv[2], xv[3]), PKLO(xv[4], xv[5]), PKLO(xv[6], xv[7])};
                *(LAS u32x4*)(lds + VT + (2 * lane + 1) * P64 + 16 * wave) = (u32x4){PKHI(xv[0], xv[1]), PKHI(xv[2], xv[3]), PKHI(xv[4], xv[5]), PKHI(xv[6], xv[7])};
                if (wave == 0) {
                    const float g = gb[(rowb + lane) * 32 + 16 + hv], bt = gb[(rowb + lane) * 32 + hv];
                    const float gl = __builtin_bit_cast(float, __builtin_amdgcn_readlane(__builtin_bit_cast(int, g), 63));
                    aux[lane] = g; aux[64 + lane] = bt; aux[128 + lane] = __expf(g); aux[192 + lane] = __expf(gl - g);
                    if (lane == 0) aux[256] = __expf(gl);
                }
            }
            __syncthreads();
            if (chunk < 63) G2_LOADX(chunk + 1);
            if (wave < 4) {
                const int si = wave & 1, tq = wave >> 1;
                f32x16 p = {};
                p = mma(p, lds + KN + 32 * si * P128, P128, lds + QN + 32 * tq * P128, P128, 8, r32, hi);
                const int t = 32 * tq + r32; const float gt = aux[t];
#pragma unroll
                for (int g4 = 0; g4 < 4; ++g4) {
                    float a[4];
#pragma unroll
                    for (int e = 0; e < 4; ++e) { const int s = 32 * si + 8 * g4 + 4 * hi + e; a[e] = (s <= t) ? p[4 * g4 + e] * __expf(gt - aux[s]) : 0.f; }
                    *(LAS u32x2*)(lds + ATT + t * P64 + (32 * si + 8 * g4 + 4 * hi) * 2) = (u32x2){cvt_pk_bf16(a[0], a[1]), cvt_pk_bf16(a[2], a[3])};
                }
            }
            f32x16 o1 = {};
            {
                f32x16 acc = {};
                acc = mma(acc, lds + KN + 32 * ti * P128, P128, lds + ST + 32 * tj * P128, P128, 8, r32, hi);
                o1 = mma(o1, lds + QN + 32 * ti * P128, P128, lds + ST + 32 * tj * P128, P128, 8, r32, hi);
                const int dv = 32 * tj + r32;
#pragma unroll
                for (int g4 = 0; g4 < 4; ++g4) {
                    const int t0 = 32 * ti + 8 * g4 + 4 * hi;
                    const u32x2 vv = *(LAS const u32x2*)(lds + VT + dv * P64 + t0 * 2);
                    const float v4[4] = {bflo(vv.x), bfhi(vv.x), bflo(vv.y), bfhi(vv.y)};
                    float rr[4];
#pragma unroll
                    for (int e = 0; e < 4; ++e) { const float eg = aux[128 + t0 + e]; rr[e] = aux[64 + t0 + e] * (v4[e] - eg * acc[4 * g4 + e]); o1[4 * g4 + e] *= eg; }
                    *(LAS u32x2*)(lds + RT + dv * P64 + t0 * 2) = (u32x2){cvt_pk_bf16(rr[0], rr[1]), cvt_pk_bf16(rr[2], rr[3])};
                }
            }
            *(LAS u32x4*)(lds + TL + (tid >> 3) * P64 + (tid & 7) * 16) = treg;
            __syncthreads();
            {
                f32x16 acc = {};
                acc = mma(acc, lds + TL + 32 * ti * P64, P64, lds + RT + 32 * tj * P64, P64, 4, r32, hi);
                const int dv = 32 * tj + r32;
#pragma unroll
                for (int g4 = 0; g4 < 4; ++g4) {
                    const int t0 = 32 * ti + 8 * g4 + 4 * hi;
                    float s4[4];
#pragma unroll
                    for (int e = 0; e < 4; ++e) s4[e] = acc[4 * g4 + e] * aux[192 + t0 + e];
                    *(LAS u32x2*)(lds + VT + dv * P64 + t0 * 2) = (u32x2){cvt_pk_bf16(acc[4 * g4], acc[4 * g4 + 1]), cvt_pk_bf16(acc[4 * g4 + 2], acc[4 * g4 + 3])};
                    *(LAS u32x2*)(lds + QN + dv * P64 + t0 * 2) = (u32x2){cvt_pk_bf16(s4[0], s4[1]), cvt_pk_bf16(s4[2], s4[3])};
                }
            }
            __syncthreads();
            {
                o1 = mma(o1, lds + ATT + 32 * ti * P64, P64, lds + VT + 32 * tj * P64, P64, 4, r32, hi);
                const int dv = 32 * tj + r32;
#pragma unroll
                for (int r = 0; r < 16; ++r) { const int t = 32 * ti + crow(r, hi); *(LAS unsigned short*)(lds + RT + t * P128 + dv * 2) = (unsigned short)f2bf(o1[r]); }
                const float egl = aux[256];
                S0 = S0 * egl; S1 = S1 * egl;
                S0 = mma(S0, lds + KNT + 32 * (2 * ti) * P64, P64, lds + QN + 32 * tj * P64, P64, 4, r32, hi);
                S1 = mma(S1, lds + KNT + 32 * (2 * ti + 1) * P64, P64, lds + QN + 32 * tj * P64, P64, 4, r32, hi);
#pragma unroll
                for (int g4 = 0; g4 < 4; ++g4) {
                    const int d0 = 8 * g4 + 4 * hi;
                    *(LAS u32x2*)(lds + ST + dv * P128 + (64 * ti + d0) * 2) = (u32x2){cvt_pk_bf16(S0[4 * g4], S0[4 * g4 + 1]), cvt_pk_bf16(S0[4 * g4 + 2], S0[4 * g4 + 3])};
                    *(LAS u32x2*)(lds + ST + dv * P128 + (64 * ti + 32 + d0) * 2) = (u32x2){cvt_pk_bf16(S1[4 * g4], S1[4 * g4 + 1]), cvt_pk_bf16(S1[4 * g4 + 2], S1[4 * g4 + 3])};
                }
            }
            __syncthreads();
#pragma unroll
            for (int r = 0; r < 8; ++r) {
                const int t = 8 * wave + r;
                const unsigned ov = *(LAS const unsigned*)(lds + RT + t * P128 + 4 * lane);
                const float oa = bflo(ov), ob = bfhi(ov);
                const float rstd = __builtin_amdgcn_rsqf(wave_sum(oa * oa + ob * ob) * (1.f / 128.f) + EPS);
                bf16_t* prow = proj + (rowb + t) * GDN_PITCH;
                const unsigned zv = zreg[r];
                *(unsigned*)(prow + colv) = cvt_pk_bf16(oa * rstd * nw0 * bflo(zv), ob * rstd * nw1 * bfhi(zv));
            }
        }
        __syncthreads();
    }
}

template <bool MASK> __device__ __forceinline__ void sb_tile(LAS const unsigned char* kb, LAS const unsigned char* vb, const bf16x8 (&qr)[4], const bf16x8 (&Uf)[2],
                                                            f32x16& oT0, f32x16& oT1, float& carry, const int s0, const int tq, const int r32, const int hi) {
    constexpr int P = 144, PV = 272;
    f32x16 p0 = {}, p1 = {};
#pragma unroll
    for (int kk = 0; kk < 4; ++kk) {
        const bf16x8 k0 = *(LAS const bf16x8*)(kb + r32 * P + (16 * kk + 8 * hi) * 2), k1 = *(LAS const bf16x8*)(kb + (32 + r32) * P + (16 * kk + 8 * hi) * 2);
        p0 = __builtin_amdgcn_mfma_f32_32x32x16_bf16(k0, qr[kk], p0, 0, 0, 0);
        p1 = __builtin_amdgcn_mfma_f32_32x32x16_bf16(k1, qr[kk], p1, 0, 0, 0);
    }
    float lk0[16], lk1[16]; float cs0 = 0.f, cs1 = 0.f;
#pragma unroll
    for (int r = 0; r < 16; ++r) {
        const float y0 = p0[r], y1 = p1[r];
        const float sp0 = __builtin_amdgcn_logf(1.f + __builtin_amdgcn_exp2f(__builtin_amdgcn_fmed3f(y0, -126.f, 126.f)));
        const float sp1 = __builtin_amdgcn_logf(1.f + __builtin_amdgcn_exp2f(__builtin_amdgcn_fmed3f(y1, -126.f, 126.f)));
        if (MASK) { const int s = s0 + crow(r, hi); lk0[r] = (s < tq) ? sp0 : 0.f; lk1[r] = (s + 32 < tq) ? sp1 : 0.f; }
        else { lk0[r] = sp0; lk1[r] = sp1; }
        cs0 += lk0[r]; cs1 += lk1[r];
    }
    cs0 += __shfl_xor(cs0, 32); cs1 += __shfl_xor(cs1, 32);
    const float c0 = carry - cs1;
#pragma unroll
    for (int r = 0; r < 16; ++r) { p0[r] += c0; p1[r] += carry; }
#pragma unroll
    for (int kk = 0; kk < 4; ++kk) {
        u32x4 w;
        if (kk < 2) { w.x = cvt_pk_bf16(lk0[8 * kk], lk0[8 * kk + 1]); w.y = cvt_pk_bf16(lk0[8 * kk + 2], lk0[8 * kk + 3]); w.z = cvt_pk_bf16(lk0[8 * kk + 4], lk0[8 * kk + 5]); w.w = cvt_pk_bf16(lk0[8 * kk + 6], lk0[8 * kk + 7]); }
        else { const int q = 8 * (kk - 2); w.x = cvt_pk_bf16(lk1[q], lk1[q + 1]); w.y = cvt_pk_bf16(lk1[q + 2], lk1[q + 3]); w.z = cvt_pk_bf16(lk1[q + 4], lk1[q + 5]); w.w = cvt_pk_bf16(lk1[q + 6], lk1[q + 7]); }
        const bf16x8 lf = __builtin_bit_cast(bf16x8, w);
        if (kk < 2) p0 = __builtin_amdgcn_mfma_f32_32x32x16_bf16(Uf[kk], lf, p0, 0, 0, 0);
        else p1 = __builtin_amdgcn_mfma_f32_32x32x16_bf16(Uf[kk - 2], lf, p1, 0, 0, 0);
    }
    carry -= cs0 + cs1;
#pragma unroll
    for (int r = 0; r < 16; ++r) {
        float a0 = __builtin_amdgcn_exp2f(p0[r]), a1 = __builtin_amdgcn_exp2f(p1[r]);
        if (MASK) { const int s = s0 + crow(r, hi); a0 = (s < tq) ? a0 : 0.f; a1 = (s + 32 < tq) ? a1 : 0.f; }
        lk0[r] = a0; lk1[r] = a1;
    }
#pragma unroll
    for (int kk = 0; kk < 4; ++kk) {
        u32x4 w;
        if (kk < 2) { w.x = cvt_pk_bf16(lk0[8 * kk], lk0[8 * kk + 1]); w.y = cvt_pk_bf16(lk0[8 * kk + 2], lk0[8 * kk + 3]); w.z = cvt_pk_bf16(lk0[8 * kk + 4], lk0[8 * kk + 5]); w.w = cvt_pk_bf16(lk0[8 * kk + 6], lk0[8 * kk + 7]); }
        else { const int q = 8 * (kk - 2); w.x = cvt_pk_bf16(lk1[q], lk1[q + 1]); w.y = cvt_pk_bf16(lk1[q + 2], lk1[q + 3]); w.z = cvt_pk_bf16(lk1[q + 4], lk1[q + 5]); w.w = cvt_pk_bf16(lk1[q + 6], lk1[q + 7]); }
        const bf16x8 af = __builtin_bit_cast(bf16x8, w);
        const u32x2 a0 = *(LAS const u32x2*)(vb + r32 * PV + (16 * kk + 4 * hi) * 2), a1 = *(LAS const u32x2*)(vb + r32 * PV + (16 * kk + 8 + 4 * hi) * 2);
        const u32x2 b0 = *(LAS const u32x2*)(vb + (32 + r32) * PV + (16 * kk + 4 * hi) * 2), b1 = *(LAS const u32x2*)(vb + (32 + r32) * PV + (16 * kk + 8 + 4 * hi) * 2);
        const bf16x8 v0 = __builtin_bit_cast(bf16x8, (u32x4){a0.x, a0.y, a1.x, a1.y}), v1 = __builtin_bit_cast(bf16x8, (u32x4){b0.x, b0.y, b1.x, b1.y});
        oT0 = __builtin_amdgcn_mfma_f32_32x32x16_bf16(v0, af, oT0, 0, 0, 0);
        oT1 = __builtin_amdgcn_mfma_f32_32x32x16_bf16(v1, af, oT1, 0, 0, 0);
    }
}
__device__ __forceinline__ void sb_attn(LAS unsigned char* lds, bf16_t* qkv, int blk, int G, int tid, int wave, int lane) {
    constexpr int KBUF = 18432, VBUF = 17408, BUF = KBUF + VBUF, P = 144, PV = 272, LD = 3072;
    asm volatile("" : "+v"(lane), "+v"(tid));
    const int r32 = lane & 31, hi = lane >> 5;
    bf16x8 Uf[2];
#pragma unroll
    for (int kk = 0; kk < 2; ++kk)
#pragma unroll
        for (int e = 0; e < 8; ++e) { const int j = 16 * kk + 8 * (e >> 2) + 4 * hi + (e & 3); Uf[kk][e] = (j >= r32) ? (short)0xBF80 : (short)0; }
    const int srow = tid >> 3, sch = tid & 7;
    for (int u = blk; u < 2048; u += G) {
        const int i = u >> 8, jj = u & 255, bh = jj & 127, half = jj >> 7, qb = 15 - 2 * i - (half ^ (i & 1));
        const int b = bh >> 4, h = bh & 15, q0 = qb * 256;
        const size_t rowb = (size_t)b * SEQ;
        const int tq = q0 + 32 * wave + r32;
        bf16_t* qptr = qkv + (rowb + tq) * LD + h * 64;
        bf16x8 qr[4];
#pragma unroll
        for (int kk = 0; kk < 4; ++kk) qr[kk] = *(const bf16x8*)(qptr + 16 * kk + 8 * hi);
        f32x16 oT0 = {}, oT1 = {};
        float carry = 0.f;
        const int stmax = (q0 >> 7) + 1;
        const bf16_t* kbase = qkv + (rowb + srow) * LD + 1024 + h * 64 + sch * 8;
        const bf16_t* vbase = qkv + (rowb + lane) * LD + 2048 + h * 64 + wave * 8;
        u32x4 kreg0 = *(const u32x4*)(kbase + (size_t)stmax * 128 * LD), kreg1 = *(const u32x4*)(kbase + (size_t)(stmax * 128 + 64) * LD);
        u32x4 vreg0 = *(const u32x4*)(vbase + (size_t)stmax * 128 * LD), vreg1 = *(const u32x4*)(vbase + (size_t)(stmax * 128 + 64) * LD);
        int cur = 0;
        __syncthreads();
        for (int st = stmax; st >= 0; --st) {
            LAS unsigned char* kb = lds + cur * BUF; LAS unsigned char* vb = kb + KBUF;
            *(LAS u32x4*)(kb + srow * P + sch * 16) = kreg0;
            *(LAS u32x4*)(kb + (64 + srow) * P + sch * 16) = kreg1;
#pragma unroll
            for (int e = 0; e < 4; ++e) {
                *(LAS unsigned short*)(vb + (wave * 8 + 2 * e) * PV + lane * 2) = (unsigned short)(vreg0[e] & 0xffffu);
                *(LAS unsigned short*)(vb + (wave * 8 + 2 * e + 1) * PV + lane * 2) = (unsigned short)(vreg0[e] >> 16);
                *(LAS unsigned short*)(vb + (wave * 8 + 2 * e) * PV + (64 + lane) * 2) = (unsigned short)(vreg1[e] & 0xffffu);
                *(LAS unsigned short*)(vb + (wave * 8 + 2 * e + 1) * PV + (64 + lane) * 2) = (unsigned short)(vreg1[e] >> 16);
            }
            __syncthreads();
            if (st > 0) {
                kreg0 = *(const u32x4*)(kbase + (size_t)(st - 1) * 128 * LD); kreg1 = *(const u32x4*)(kbase + (size_t)((st - 1) * 128 + 64) * LD);
                vreg0 = *(const u32x4*)(vbase + (size_t)(st - 1) * 128 * LD); vreg1 = *(const u32x4*)(vbase + (size_t)((st - 1) * 128 + 64) * LD);
            }
            const int tmin = q0 + 32 * wave;
#pragma unroll
            for (int hf = 1; hf >= 0; --hf) {
                const int s0 = st * 128 + hf * 64;
                if (s0 < tmin + 31) {
                    if (s0 + 63 >= tmin) sb_tile<true>(kb + hf * 64 * P, vb + hf * 128, qr, Uf, oT0, oT1, carry, s0, tq, r32, hi);
                    else sb_tile<false>(kb + hf * 64 * P, vb + hf * 128, qr, Uf, oT0, oT1, carry, s0, tq, r32, hi);
                }
            }
            cur ^= 1;
        }
#pragma unroll
        for (int g4 = 0; g4 < 4; ++g4) {
            const int d0 = 8 * g4 + 4 * hi;
            *(u32x2*)(qptr + d0) = (u32x2){cvt_pk_bf16(oT0[4 * g4], oT0[4 * g4 + 1]), cvt_pk_bf16(oT0[4 * g4 + 2], oT0[4 * g4 + 3])};
            *(u32x2*)(qptr + 32 + d0) = (u32x2){cvt_pk_bf16(oT1[4 * g4], oT1[4 * g4 + 1]), cvt_pk_bf16(oT1[4 * g4 + 2], oT1[4 * g4 + 3])};
        }
    }
}

struct Args { const float* in[15]; float* out; unsigned char* ws; };
#define XB_TMO      128
#define XB_XCNT(j)  (256  + 64 * (j))
#define XB_XSUB(j)  (1280 + 64 * (j))
#define XB_XGEN(j)  (2304 + 64 * (j))
#define XB_TOP      3328
#define XB_TOPGEN   3392
#define XCD_BAR_WORDS 3456
#define XB_SPIN_CAP (1u << 18)

__device__ __forceinline__ unsigned xb_ld(unsigned* p)              { return __hip_atomic_load(p, __ATOMIC_RELAXED, __HIP_MEMORY_SCOPE_AGENT); }
__device__ __forceinline__ unsigned xb_add(unsigned* p, unsigned v) { return __hip_atomic_fetch_add(p, v, __ATOMIC_RELAXED, __HIP_MEMORY_SCOPE_AGENT); }
__device__ __forceinline__ unsigned xb_xcc_id() { return (unsigned)__builtin_amdgcn_s_getreg((3 << 11) | 20) & 0xFu; }
#define XB_SPIN(cond, bar) do { unsigned _sp = 0; while (cond) { __builtin_amdgcn_s_sleep(1); \
    if ((++_sp & 255u) == 0u) { if (xb_ld(&(bar)[XB_TMO])) break; if (_sp > XB_SPIN_CAP) { atomicAdd(&(bar)[XB_TMO], 1u); break; } } } } while (0)

struct XcdBarrier {
    unsigned* bar; unsigned x;
    volatile LAS unsigned* st;
};

__device__ __forceinline__ XcdBarrier xcd_barrier_post(unsigned* bar, volatile LAS unsigned* st) {
    XcdBarrier b; b.bar = bar; b.x = xb_xcc_id(); b.st = st;
    if (threadIdx.x == 0) (void)xb_add(&bar[XB_XCNT(b.x)], 1u);
    return b;
}
__device__ __forceinline__ void xcd_barrier_complete(unsigned* bar, unsigned x, unsigned& nloc, unsigned& nx) {
    const unsigned G = gridDim.x * gridDim.y * gridDim.z;
    unsigned sum, cnt, mine, sp = 0u;
    for (;;) {
        sum = 0u; cnt = 0u; mine = 0u;
#pragma unroll
        for (unsigned j = 0; j < 16; ++j) { const unsigned c = xb_ld(&bar[XB_XCNT(j)]); sum += c; cnt += (c > 0u) ? 1u : 0u; mine = (j == x) ? c : mine; }
        if (sum == G) break;
        __builtin_amdgcn_s_sleep(1);
        if ((++sp & 255u) == 0u) { if (xb_ld(&bar[XB_TMO])) break; if (sp > XB_SPIN_CAP) { atomicAdd(&bar[XB_TMO], 1u); break; } }
    }
    nloc = mine > 0u ? mine : 1u; nx = cnt > 0u ? cnt : 1u;
}

__device__ __forceinline__ void xcd_barrier(const XcdBarrier& b) {
    asm volatile("s_waitcnt vmcnt(0)" ::: "memory");
    __syncthreads();
    if (threadIdx.x == 0) {
        unsigned* bar = b.bar;
        __builtin_amdgcn_s_waitcnt(0);
        unsigned nloc = b.st[0], nx = b.st[1];
        if (nloc == 0u) { xcd_barrier_complete(bar, b.x, nloc, nx); b.st[0] = nloc; b.st[1] = nx; }
        const unsigned old = xb_add(&bar[XB_XSUB(b.x)], 1u);
        const unsigned gen = old / nloc;
        if (old + 1u == (gen + 1u) * nloc) {
            __builtin_amdgcn_fence(__ATOMIC_RELEASE, "agent");
            asm volatile("s_waitcnt vmcnt(0)" ::: "memory");
            const unsigned og = xb_add(&bar[XB_TOP], 1u);
            const unsigned tg = og / nx;
            if (og + 1u == (tg + 1u) * nx) xb_add(&bar[XB_TOPGEN], 1u);
            else XB_SPIN(xb_ld(&bar[XB_TOPGEN]) == tg, bar);
            __builtin_amdgcn_fence(__ATOMIC_ACQUIRE, "agent");
            xb_add(&bar[XB_XGEN(b.x)], 1u);
            asm volatile("s_waitcnt vmcnt(0)" ::: "memory");
        } else {
            XB_SPIN(xb_ld(&bar[XB_XGEN(b.x)]) == gen, bar);
            __builtin_amdgcn_fence(__ATOMIC_ACQUIRE, "agent");
            asm volatile("s_waitcnt vmcnt(0)" ::: "memory");
        }
    }
    __syncthreads();
}

template <bool gdn> __device__ __forceinline__ void conv_mixer_weights(const Args& a, const int layer, bf16_t* Win_t, bf16_t* Wout_t, LAS float* scr, int gw, int NGW, int lane) {
    const int j = layer >> 1;
    const float* w_in = gdn ? a.in[1] + (size_t)j * DM * GDN_N : a.in[7] + (size_t)j * DM * 3072;
    const float* w_out = gdn ? a.in[6] + (size_t)j * 2048 * DM : a.in[8] + (size_t)j * DM * DM;
    constexpr int n_in = gdn ? GDN_N : 3072, k_out = gdn ? 2048 : 1024;
    constexpr int I_in = (DM / 64) * (n_in / 32), I_out = (k_out / 64) * (DM / 32);
    for (int it = gw; it < I_in + I_out; it += NGW) {
        if (it < I_in) conv_plain(w_in, DM, n_in, Win_t, it, scr, lane, a.in[9] + layer * DM);
        else conv_plain(w_out, k_out, DM, Wout_t, it - I_in, scr, lane, nullptr);
    }
}
__device__ __forceinline__ void conv_ffn_weights(const Args& a, const int layer, bf16_t* Wgu_t, bf16_t* Wdn_t, LAS float* scr, int gw, int NGW, int lane) {
    constexpr int I_g = (DM / 64) * (FF / 32), I_d = (FF / 64) * (DM / 32);
    const float* wg = a.in[11] + (size_t)layer * DM * FF; const float* wu = a.in[12] + (size_t)layer * DM * FF; const float* wd = a.in[13] + (size_t)layer * FF * DM;
    for (int it = gw; it < 2 * I_g + I_d; it += NGW) {
        if (it < I_g) conv_gu(wg, Wgu_t, it, 0, scr, lane, a.in[10] + layer * DM);
        else if (it < 2 * I_g) conv_gu(wu, Wgu_t, it - I_g, 1, scr, lane, a.in[10] + layer * DM);
        else conv_plain(wd, FF, DM, Wdn_t, it - 2 * I_g, scr, lane, nullptr);
    }
}
__device__ __forceinline__ void conv_during_gdn_mixer(const Args& a, const int layer, LAS float* scr, int hw, int NHW, int lane) {
    conv_ffn_weights(a, layer, (bf16_t*)(a.ws + WS_WGU), (bf16_t*)(a.ws + WS_WDN), scr, hw, NHW, lane);
    conv_mixer_weights<false>(a, layer + 1, (bf16_t*)(a.ws + WS_WIN), (bf16_t*)(a.ws + WS_ALT_WOUT), scr, hw, NHW, lane);
    conv_ffn_weights(a, layer + 1, (bf16_t*)(a.ws + WS_ALT_WGU), (bf16_t*)(a.ws + WS_ALT_WDN), scr, hw, NHW, lane);
}
template <class Sched> __device__ __forceinline__ int build_rstd_table(LAS unsigned char* lds, const Sched& S, const float* ssq16, int tid) {
    int pm_lo = 1 << 30, pm_hi = -1; pg8::Unit u;
    for (int i = 0; S.next(i, u); ++i) { pm_lo = u.pm < pm_lo ? u.pm : pm_lo; pm_hi = u.pm > pm_hi ? u.pm : pm_hi; }
    const int rows = (pm_hi - pm_lo + 1) * 256;
    if (pm_hi < 0 || rows > 4096) return -1;
    LAS float* rl = (LAS float*)(lds + 131072);
    for (int r = tid; r < rows; r += 512) rl[r] = rstd_of(ssq16, pm_lo * 256 + r);
    __syncthreads();
    return pm_lo * 256;
}
__device__ __forceinline__ void zero_ssq(float* p) { int g = blockIdx.x * 512 + threadIdx.x; asm volatile("" : "+v"(g)); if (g < M_TOK) p[g] = 0.f; }

template <bool gdn> __device__ __forceinline__ void layer_body(const Args& a, const int layer, LAS unsigned char* lds, const XcdBarrier& gbar, unsigned long long& probe_acc) {
#define LB_IDS() int tid = threadIdx.x; asm volatile("" : "+v"(tid)); const int lane = tid & 63, wave = __builtin_amdgcn_readfirstlane(tid >> 6); \
        const int G = gridDim.x, blk = blockIdx.x, gw = blk * 8 + wave, NGW = G * 8; (void)lane; (void)gw; (void)NGW; (void)G; (void)blk;
#define LB_PTRS() bf16_t* Win_t = (bf16_t*)(a.ws + WS_WIN); bf16_t* Wout_t = (bf16_t*)(a.ws + (gdn ? WS_WOUT : WS_ALT_WOUT)); bf16_t* Wgu_t = (bf16_t*)(a.ws + (gdn ? WS_WGU : WS_ALT_WGU)); bf16_t* Wdn_t = (bf16_t*)(a.ws + (gdn ? WS_WDN : WS_ALT_WDN)); \
        float* gb = (float*)(a.ws + WS_GB); bf16_t* H = (bf16_t*)(a.ws + WS_H); bf16_t* PROJ = (bf16_t*)(a.ws + WS_PROJ); float* out = a.out; const float* xcur = (layer == 0) ? a.in[0] : a.out; \
        float* ssqA = (float*)(a.ws + WS_SSQ); float* ssqB = ssqA + (size_t)M_TOK * 16; \
        (void)Win_t; (void)Wout_t; (void)Wgu_t; (void)Wdn_t; (void)gb; (void)H; (void)PROJ; (void)out; (void)xcur; (void)ssqA; (void)ssqB;
        const int j = layer >> 1;
        { PH_T0(1)
        {
            LB_IDS(); LB_PTRS();
            pg8::Gemm g{H, Win_t, M_TOK, gdn ? GDN_NP : 3072, DM, DM}; pg8::StaticOrder S; S.init(M_TOK, g.N, G, blk);
            const int row_lo = build_rstd_table(lds, S, ssqA, tid);
            EpiProj E{PROJ, gdn ? GDN_PITCH : 3072, gdn ? 24 : -1, gb, a.in[3] + j * 16, a.in[4] + j * 16, gdn ? 0 : 4, 0.125f * 1.4426950408889634f, ssqA, row_lo >= 0 ? (const LAS float*)(lds + 131072) : nullptr, row_lo, gdn ? 16 : 0, gdn ? 24 : 0};
#if !defined(NO_GEMM) && !defined(NO_P2)
            pg8::gemm_phase<EpiProj, pg8::StaticOrder, true, true>(lds, g, S, E);
#endif
        }
        xcd_barrier(gbar);
        PH_T1(1) }
        if constexpr (gdn) {
            LB_IDS(); LB_PTRS();
            const float* convw = a.in[2] + (size_t)j * 4096 * 4;
            { PH_T0(2) gdn_g0(lds, PROJ, convw, blk, G, tid, wave, lane);
            xcd_barrier(gbar); PH_T1(2) }
            { PH_T0(3)
            if (G < 256) { conv_during_gdn_mixer(a, layer, (LAS float*)(lds + wave * 16384), gw, NGW, lane); __syncthreads(); }
            gdn_g1(lds, PROJ, gb, gb, convw, H, gw, NGW, wave, lane);
            xcd_barrier(gbar); PH_T1(3) }
            { PH_T0(4)
            if (G >= 256 && blk >= 128) conv_during_gdn_mixer(a, layer, (LAS float*)(lds + wave * 16384), (blk - 128) * 8 + wave, (G - 128) * 8, lane);
            gdn_g2(lds, PROJ, gb, convw, a.in[5] + j * 128, H, blk, G, tid, wave, lane);
            xcd_barrier(gbar); PH_T1(4) }
        } else {
            LB_IDS(); LB_PTRS();
            { PH_T0(5)
            sb_attn(lds, PROJ, blk, G, tid, wave, lane);
            xcd_barrier(gbar); PH_T1(5) }
        }
        { PH_T0(6)
        {
            LB_IDS(); LB_PTRS();
            pg8::Gemm g{gdn ? PROJ + 2048 : PROJ, Wout_t, M_TOK, DM, gdn ? 2048 : 1024, gdn ? GDN_PITCH : 3072}; pg8::StaticOrder S; S.init(M_TOK, DM, G, blk);
            EpiRes E{xcur, out, DM, H, ssqB};
#if !defined(NO_GEMM) && !defined(NO_P4)
            pg8::gemm_phase<EpiRes, pg8::StaticOrder, true, true>(lds, g, S, E);
#endif
        }
        xcd_barrier(gbar);
        PH_T1(6) }
        { PH_T0(7)
        {
            LB_IDS(); LB_PTRS();
            if (!gdn && layer < 3) { conv_mixer_weights<true>(a, layer + 1, (bf16_t*)(a.ws + WS_WIN), (bf16_t*)(a.ws + WS_WOUT), (LAS float*)(lds + wave * 16384), gw, NGW, lane); __syncthreads(); }
            pg8::Gemm g{H, Wgu_t, M_TOK, 2 * FF, DM, DM}; pg8::StaticOrder S; S.init(M_TOK, 2 * FF, G, blk);
            const int row_lo = build_rstd_table(lds, S, ssqB, tid);
            EpiSwiglu E{PROJ, FF, ssqB, row_lo >= 0 ? (const LAS float*)(lds + 131072) : nullptr, row_lo};
#if !defined(NO_GEMM) && !defined(NO_P6)
            pg8::gemm_phase<EpiSwiglu, pg8::StaticOrder, true, true>(lds, g, S, E);
#endif
        }
        xcd_barrier(gbar);
        PH_T1(7) }
        { PH_T0(8)
        {
            LB_IDS(); LB_PTRS();
            pg8::Gemm g{PROJ, Wdn_t, M_TOK, DM, FF, FF}; pg8::StaticOrder S; S.init(M_TOK, DM, G, blk);
            EpiRes E{out, out, DM, H, ssqA};
#if !defined(NO_GEMM) && !defined(NO_P7)
            pg8::gemm_phase<EpiRes, pg8::StaticOrder, true, true>(lds, g, S, E);
#endif
        }
        xcd_barrier(gbar);
        PH_T1(8) }
}

__global__ void __launch_bounds__(512, 2) fwd(Args a) {
    extern __shared__ __attribute__((aligned(16))) unsigned char lds_raw[];
    LAS unsigned char* lds = (LAS unsigned char*)lds_raw;
    cg::grid_group grid = cg::this_grid();
    unsigned long long probe_acc = 0;
    if (threadIdx.x < 2) ((LAS unsigned*)(lds + LDS_BARST))[threadIdx.x] = 0u;
    __syncthreads();
    const XcdBarrier gbar = xcd_barrier_post((unsigned*)a.ws, (volatile LAS unsigned*)(lds + LDS_BARST));
    { PH_T0(9)
    {
        int tid = threadIdx.x; asm volatile("" : "+v"(tid)); const int lane = tid & 63, wave = __builtin_amdgcn_readfirstlane(tid >> 6);
        const int gw = blockIdx.x * 8 + wave, NGW = gridDim.x * 8; LAS float* scr = (LAS float*)(lds + wave * 16384);
        conv_mixer_weights<true>(a, 0, (bf16_t*)(a.ws + WS_WIN), (bf16_t*)(a.ws + WS_WOUT), scr, gw, NGW, lane);
        xb_rows(a.in[0], (bf16_t*)(a.ws + WS_H), (float*)(a.ws + WS_SSQ), gw, NGW, lane);
    }
    xcd_barrier(gbar);
    if (a.ws == nullptr) grid.sync();
    PH_T1(9) }
#ifdef ONE_LAYER
    layer_body<false>(a, 1, lds, gbar, probe_acc);
#else
    for (int lp = 0; lp < 2; ++lp) {
        layer_body<true>(a, 2 * lp, lds, gbar, probe_acc);
        layer_body<false>(a, 2 * lp + 1, lds, gbar, probe_acc);
    }
#endif
    { PH_T0(10)
    { int tid = threadIdx.x; asm volatile("" : "+v"(tid)); const int lane = tid & 63, wave = __builtin_amdgcn_readfirstlane(tid >> 6); final_norm_rows(a.out, a.in[14], (const float*)(a.ws + WS_SSQ), blockIdx.x * 8 + wave, gridDim.x * 8, lane); }
    if (PROBE_ID == 10) { xcd_barrier(gbar); } PH_T1(10) }
    if (PROBE_ID != 0 && blockIdx.x == 0) { const unsigned long long t0 = __builtin_amdgcn_s_memrealtime(); while (__builtin_amdgcn_s_memrealtime() - t0 < 4ull * probe_acc) __builtin_amdgcn_s_sleep(8); }
}

extern "C" void kernel_launch(void* const* d_in, const int* in_sizes, int n_in, void* d_out, int out_size, void* d_ws, size_t ws_size, hipStream_t stream) {
    static int grid = 0;
    if (grid == 0) {
        if (n_in != 15 || out_size != M_TOK * DM || ws_size < WS_END) { fprintf(stderr, "kernel_launch: unexpected shapes (n_in %d out %d ws %zu)\n", n_in, out_size, ws_size); grid = -1; return; }
        int dev = 0, cus = 0, per_cu = 0;
        hipGetDevice(&dev); hipDeviceGetAttribute(&cus, hipDeviceAttributeMultiprocessorCount, dev);
        hipFuncSetAttribute((const void*)fwd, hipFuncAttributeMaxDynamicSharedMemorySize, LDS_BYTES);
        hipOccupancyMaxActiveBlocksPerMultiprocessor(&per_cu, (const void*)fwd, 512, LDS_BYTES);
        if (per_cu < 1) per_cu = 1;
        grid = cus * per_cu;
        (void)hipGetLastError();
    }
    if (grid < 0) return;
    Args a{};
    for (int i = 0; i < 15; ++i) a.in[i] = (const float*)d_in[i];
    a.out = (float*)d_out; a.ws = (unsigned char*)d_ws;
    (void)hipMemsetAsync(d_ws, 0, 16384, stream);
    void* args[] = {&a};
    hipError_t e = hipLaunchCooperativeKernel((const void*)fwd, dim3(grid), dim3(512), args, LDS_BYTES, stream);
    if (e != hipSuccess) fprintf(stderr, "cooperative launch failed: %s (grid %d)\n", hipGetErrorString(e), grid);
}
```

```cpp
#include <hip/hip_runtime.h>
#include <hip/hip_cooperative_groups.h>
#include <cstdio>
#include <cstdint>
namespace cg = cooperative_groups;
namespace pg8 {
#define PG8_LAS __attribute__((address_space(3)))
typedef unsigned short bf16_t;
typedef short bf16x8 __attribute__((ext_vector_type(8)));
typedef float f32x4 __attribute__((ext_vector_type(4)));
typedef unsigned u32x4 __attribute__((ext_vector_type(4)));
constexpr int BM = 256, BK = 64, HALF = 128, HTB = HALF * BK * 2  , STAGE_BYTES = 8 * HTB, NXCD = 8;

__host__ __device__ __forceinline__ int lds_byte(int r, int c) { const int st = (r >> 4) * 2 + (c >> 5), rr = r & 15, cc = c & 31, ob = rr * 64 + cc * 2; return st * 1024 + (ob ^ (((ob >> 9) & 1) << 5)); }
__host__ __device__ __forceinline__ void stage_rc(int b, int& R, int& C) { const int st = b / 1024, sb = b % 1024, swz = sb ^ (((sb >> 9) & 1) << 5); R = (st >> 1) * 16 + swz / 64; C = (st & 1) * 32 + (swz % 64) / 2; }
__host__ __device__ __forceinline__ int perm32(int rho) { const int n = rho >> 4, i = rho & 15; return 8 * (i >> 2) + 4 * n + (i & 3); }

struct Unit { int pm, pn; };
struct Gemm { const bf16_t* A; const bf16_t* Bt; int M, N, K, lda; };

struct StaticOrder {
    int nM, nN, nwg, G, c, WGM;
    __host__ __device__ void init(int M, int N, int G_, int c_, int wgm = 4) { nM = M / BM; nN = N / BM; nwg = nM * nN; G = G_; c = c_; WGM = wgm; }
    __host__ __device__ bool next(int i, Unit& u) const {
        const long L = (long)i * G + c; if (L >= nwg) return false;
        int wgid = (int)L; { const int q = nwg / NXCD, r = nwg % NXCD, xcd = wgid % NXCD, off = wgid / NXCD; wgid = (xcd < r ? xcd * (q + 1) : r * (q + 1) + (xcd - r) * q) + off; }
        const int nig = WGM * nN, gid = wgid / nig, fm = gid * WGM, gsz = (nM - fm) < WGM ? (nM - fm) : WGM;
        u.pm = fm + ((wgid % nig) % gsz); u.pn = (wgid % nig) / gsz; return true;
    }
    __device__ __forceinline__ void a_ready(const Unit&) const {}
    __device__ __forceinline__ void done(const Unit&) const {}
};

typedef float f32x2_cv __attribute__((ext_vector_type(2))); typedef __bf16 bf16x2_cv __attribute__((ext_vector_type(2)));
__device__ __forceinline__ unsigned cvt_pk_bf16(float lo, float hi) { const f32x2_cv v = {lo, hi}; return __builtin_bit_cast(unsigned, __builtin_convertvector(v, bf16x2_cv)); }
typedef float f32x2 __attribute__((ext_vector_type(2)));
template <class Epi, class Sched, bool ALIGN_EPI = false, bool SP2 = false>
__device__ __forceinline__ void gemm_phase(PG8_LAS unsigned char* lds, const Gemm g, const Sched& S, const Epi& E) {
    int tid_l = threadIdx.x; asm volatile("" : "+v"(tid_l));
    const int tid = tid_l, wid = __builtin_amdgcn_readfirstlane(tid >> 6), lane = tid & 63, wr = wid >> 2, wc = wid & 3, fr = lane & 15, fq = lane >> 4;
    const int K = g.K, nt = K / BK;
    unsigned voffA[2], voffB[2];
#pragma unroll
    for (int i = 0; i < 2; ++i) { int R, C; stage_rc(tid * 16 + i * 8192, R, C); const int Rb = Epi::PERM ? ((R & ~31) + perm32(R & 31)) : R;
        voffA[i] = (unsigned)(R * g.lda + C) * 2u; voffB[i] = (unsigned)(Rb * K + C) * 2u; }
    const size_t kstep = (size_t)(BK * 2);
    const size_t hstepA = (size_t)HALF * g.lda * 2, hstepB = (size_t)HALF * K * 2;
    const size_t tstepA = 2 * hstepA, tstepB = 2 * hstepB;
    const unsigned ldsw = (unsigned)wid * 1024u;
    const int aoff = lds_byte(wr * 64 + fr, fq * 8), boff = lds_byte(wc * 32 + fr, fq * 8);
#define PG8_SA(b, h) (((b) * 2 + (h)) * HTB)
#define PG8_SB(b, h) ((4 + (b) * 2 + (h)) * HTB)
#define PG8_STAGE(bufoff, gbase, voff) do { _Pragma("unroll") for (int _i = 0; _i < 2; ++_i) \
        __builtin_amdgcn_global_load_lds((const unsigned*)((const char*)(gbase) + (voff)[_i]), (PG8_LAS unsigned*)(lds + (bufoff) + ldsw + _i * 8192), 16, 0, 0); } while (0)
#define PG8_LDA(dst, b, h) do { _Pragma("unroll") for (int m = 0; m < 4; ++m) _Pragma("unroll") for (int k = 0; k < 2; ++k) dst[m][k] = *(const PG8_LAS bf16x8*)(lds + PG8_SA(b, h) + aoff + m * 2048 + k * 1024); } while (0)
#define PG8_LDB(dst, b, h) do { _Pragma("unroll") for (int n = 0; n < 2; ++n) _Pragma("unroll") for (int k = 0; k < 2; ++k) dst[n][k] = *(const PG8_LAS bf16x8*)(lds + PG8_SB(b, h) + boff + n * 2048 + k * 1024); } while (0)
#define PG8_MMA(ai, bj, At, Bt) do { __builtin_amdgcn_s_setprio(1); _Pragma("unroll") for (int m = 0; m < 4; ++m) _Pragma("unroll") for (int n = 0; n < 2; ++n) _Pragma("unroll") for (int k = 0; k < 2; ++k) \
        acc[ai][bj][m][n] = __builtin_amdgcn_mfma_f32_16x16x32_bf16(Bt[n][k], At[m][k], acc[ai][bj][m][n], 0, 0, 0); __builtin_amdgcn_s_setprio(0); } while (0)
#define PG8_WAIT_V(n) asm volatile("s_waitcnt vmcnt(" #n ")" ::: "memory")
#define PG8_WAIT_L(n) asm volatile("s_waitcnt lgkmcnt(" #n ")" ::: "memory")
#define PG8_BAR __builtin_amdgcn_s_barrier()
#define PG8_SCHED __builtin_amdgcn_sched_barrier(0)
    Unit cur, nxt; int ui = 0;
    if (!S.next(0, cur)) return;
    f32x4 acc[2][2][4][2];
#pragma unroll
    for (int a = 0; a < 2; ++a)
#pragma unroll
        for (int b = 0; b < 2; ++b)
#pragma unroll
            for (int m = 0; m < 4; ++m)
#pragma unroll
                for (int n = 0; n < 2; ++n) acc[a][b][m][n] = (f32x4){0.f, 0.f, 0.f, 0.f};
    bf16x8 At[4][2], B0[2][2], B1[2][2];
    const char* cA = (const char*)g.A + (size_t)cur.pm * tstepA; const char* cB = (const char*)g.Bt + (size_t)cur.pn * tstepB;
    S.a_ready(cur);
    if constexpr (SP2) {
        PG8_STAGE(PG8_SB(0, 0), cB, voffB); PG8_STAGE(PG8_SB(0, 1), cB + hstepB, voffB); PG8_STAGE(PG8_SA(0, 0), cA, voffA); PG8_STAGE(PG8_SA(0, 1), cA + hstepA, voffA);
        if (wr == 1) PG8_BAR;
        PG8_WAIT_V(2); PG8_BAR;
        PG8_STAGE(PG8_SB(1, 0), cB + kstep, voffB); PG8_STAGE(PG8_SA(1, 0), cA + kstep, voffA); PG8_STAGE(PG8_SB(1, 1), cB + hstepB + kstep, voffB);
        PG8_WAIT_V(6); PG8_BAR;
    } else {
        PG8_STAGE(PG8_SB(0, 0), cB, voffB); PG8_STAGE(PG8_SA(0, 0), cA, voffA); PG8_STAGE(PG8_SB(0, 1), cB + hstepB, voffB); PG8_STAGE(PG8_SA(0, 1), cA + hstepA, voffA);
        if (wr == 1) PG8_BAR;
        PG8_WAIT_V(4); PG8_BAR;
        PG8_STAGE(PG8_SB(1, 0), cB + kstep, voffB); PG8_STAGE(PG8_SA(1, 0), cA + kstep, voffA); PG8_STAGE(PG8_SB(1, 1), cB + hstepB + kstep, voffB);
        PG8_WAIT_V(6); PG8_BAR;
    }
    for (;;) {
        const bool has_next = S.next(ui + 1, nxt);
        const char* nA = has_next ? (const char*)g.A + (size_t)nxt.pm * tstepA : cA; const char* nB = has_next ? (const char*)g.Bt + (size_t)nxt.pn * tstepB : cB;
        for (int t = 0; t < nt; t += 2) {
            const bool last = (t == nt - 2);
            const char* a1 = cA + (size_t)(t + 1) * kstep;
            const char* a2 = last ? nA : cA + (size_t)(t + 2) * kstep; const char* b2 = last ? nB : cB + (size_t)(t + 2) * kstep;
            const char* a3 = a2 + kstep; const char* b3 = b2 + kstep;
            if (last && has_next) S.a_ready(nxt);
            if constexpr (SP2) {
            PG8_LDB(B0, 0, 0); PG8_LDB(B1, 0, 1); PG8_SCHED; PG8_LDA(At, 0, 0); PG8_STAGE(PG8_SA(1, 1), a1 + hstepA, voffA);
            PG8_WAIT_V(8); PG8_WAIT_L(0); PG8_BAR; PG8_MMA(0, 0, At, B0); PG8_MMA(0, 1, At, B1); PG8_BAR; PG8_SCHED;
            PG8_LDA(At, 0, 1); PG8_STAGE(PG8_SB(0, 0), b2, voffB); PG8_STAGE(PG8_SB(0, 1), b2 + hstepB, voffB); PG8_STAGE(PG8_SA(0, 0), a2, voffA);
            PG8_WAIT_V(8); PG8_WAIT_L(0); PG8_BAR; PG8_MMA(1, 0, At, B0); PG8_MMA(1, 1, At, B1); PG8_BAR; PG8_SCHED;
            PG8_LDB(B0, 1, 0); PG8_LDB(B1, 1, 1); PG8_SCHED; PG8_LDA(At, 1, 0); PG8_STAGE(PG8_SA(0, 1), a2 + hstepA, voffA);
            PG8_WAIT_V(8); PG8_WAIT_L(0); PG8_BAR; PG8_MMA(0, 0, At, B0); PG8_MMA(0, 1, At, B1); PG8_BAR; PG8_SCHED;
            PG8_LDA(At, 1, 1); PG8_STAGE(PG8_SB(1, 0), b3, voffB); PG8_STAGE(PG8_SB(1, 1), b3 + hstepB, voffB); PG8_STAGE(PG8_SA(1, 0), a3, voffA);
            PG8_WAIT_V(8); PG8_WAIT_L(0); PG8_BAR; PG8_MMA(1, 0, At, B0); PG8_MMA(1, 1, At, B1); PG8_BAR; PG8_SCHED;
            } else {
            PG8_LDB(B0, 0, 0); PG8_SCHED; PG8_LDA(At, 0, 0); PG8_STAGE(PG8_SA(1, 1), a1 + hstepA, voffA);
            PG8_WAIT_L(8); PG8_BAR; PG8_WAIT_L(0); PG8_MMA(0, 0, At, B0); PG8_BAR; PG8_SCHED;
            PG8_LDB(B1, 0, 1); PG8_STAGE(PG8_SB(0, 0), b2, voffB);
            PG8_BAR; PG8_WAIT_L(0); PG8_MMA(0, 1, At, B1); PG8_BAR;
            PG8_LDA(At, 0, 1); PG8_STAGE(PG8_SA(0, 0), a2, voffA);
            PG8_BAR; PG8_WAIT_L(0); PG8_MMA(1, 0, At, B0); PG8_BAR; PG8_SCHED;
            PG8_STAGE(PG8_SB(0, 1), b2 + hstepB, voffB);
            PG8_WAIT_V(6); PG8_BAR; PG8_MMA(1, 1, At, B1); PG8_BAR;
            PG8_LDB(B0, 1, 0); PG8_SCHED; PG8_LDA(At, 1, 0); PG8_STAGE(PG8_SA(0, 1), a2 + hstepA, voffA);
            PG8_WAIT_L(8); PG8_BAR; PG8_WAIT_L(0); PG8_MMA(0, 0, At, B0); PG8_BAR; PG8_SCHED;
            PG8_LDB(B1, 1, 1); PG8_STAGE(PG8_SB(1, 0), b3, voffB);
            PG8_BAR; PG8_WAIT_L(0); PG8_MMA(0, 1, At, B1); PG8_BAR;
            PG8_LDA(At, 1, 1); PG8_STAGE(PG8_SA(1, 0), a3, voffA);
            PG8_BAR; PG8_WAIT_L(0); PG8_MMA(1, 0, At, B0); PG8_BAR; PG8_SCHED;
            PG8_STAGE(PG8_SB(1, 1), b3 + hstepB, voffB);
            PG8_WAIT_V(6); PG8_BAR; PG8_MMA(1, 1, At, B1); PG8_BAR;
            }
        }
        if constexpr (ALIGN_EPI) { if (wr == 0) PG8_BAR; }
        if constexpr (!Epi::AFTER_DRAIN) { E(acc, cur, wr, wc, fr, fq); S.done(cur); }
        if (!has_next) break;
#pragma unroll
        for (int a = 0; a < 2; ++a)
#pragma unroll
            for (int b = 0; b < 2; ++b)
#pragma unroll
                for (int m = 0; m < 4; ++m)
#pragma unroll
                    for (int n = 0; n < 2; ++n) acc[a][b][m][n] = (f32x4){0.f, 0.f, 0.f, 0.f};
        cur = nxt; cA = nA; cB = nB; ++ui;
        if constexpr (ALIGN_EPI) { if (wr == 1) PG8_BAR; }
    }
    PG8_WAIT_V(0);
    if constexpr (!ALIGN_EPI) { if (wr == 0) PG8_BAR; }
    PG8_BAR;
    if constexpr (Epi::AFTER_DRAIN) { E.fused(acc, cur, wr, wc, fr, fq, lds, wid, lane); S.done(cur); }
#undef PG8_SA
#undef PG8_SB
#undef PG8_STAGE
#undef PG8_LDA
#undef PG8_LDB
#undef PG8_MMA
#undef PG8_WAIT_V
#undef PG8_WAIT_L
#undef PG8_BAR
#undef PG8_SCHED
}
}

constexpr int M_TOK = 32768, DM = 1024, SEQ = 4096, NB = 8;
constexpr int GDN_N = 6176, GDN_NP = 6400, GDN_PITCH = 6144, FF = 2816;
constexpr float EPS = 1e-6f;
#define LAS __attribute__((address_space(3)))
typedef unsigned short bf16_t;
typedef short bf16x8 __attribute__((ext_vector_type(8)));
typedef float f32x4 __attribute__((ext_vector_type(4)));
typedef float f32x16 __attribute__((ext_vector_type(16)));
typedef unsigned u32x4 __attribute__((ext_vector_type(4)));
typedef unsigned u32x2 __attribute__((ext_vector_type(2)));
using pg8::cvt_pk_bf16;

constexpr size_t MiB = 1u << 20;
constexpr size_t WS_WIN = 1 * MiB, WS_WOUT = 14 * MiB, WS_WGU = 18 * MiB, WS_WDN = 29 * MiB, WS_GB = 36 * MiB, WS_H = 40 * MiB, WS_PROJ = 104 * MiB, WS_SSQ = 488 * MiB, WS_ALT_WOUT = 492 * MiB, WS_ALT_WGU = 494 * MiB, WS_ALT_WDN = 505 * MiB, WS_END = 511 * MiB;
constexpr int LDS_BYTES = 147456 + 256, LDS_BARST = 147456;
#ifndef PROBE_ID
#define PROBE_ID 0
#endif
#define PH_T0(id) unsigned long long ph_t0_ = 0; if (PROBE_ID == (id)) ph_t0_ = __builtin_amdgcn_s_memrealtime();
#define PH_T1(id) if (PROBE_ID == (id)) probe_acc += __builtin_amdgcn_s_memrealtime() - ph_t0_;

__device__ __forceinline__ float bf2f(unsigned short b) { return __uint_as_float(((unsigned)b) << 16); }
__device__ __forceinline__ float bflo(unsigned u) { return __uint_as_float(u << 16); }
__device__ __forceinline__ float bfhi(unsigned u) { return __uint_as_float(u & 0xffff0000u); }
template <int CTRL> __device__ __forceinline__ float dpp_f(float v) { return __builtin_bit_cast(float, __builtin_amdgcn_update_dpp(0, __builtin_bit_cast(int, v), CTRL, 0xf, 0xf, true)); }
__device__ __forceinline__ float wave_sum(float v) {
    v += dpp_f<0xB1>(v); v += dpp_f<0x4E>(v); v += dpp_f<0x141>(v); v += dpp_f<0x140>(v);
    const int vi = __builtin_bit_cast(int, v);
    return (__builtin_bit_cast(float, __builtin_amdgcn_readlane(vi, 0)) + __builtin_bit_cast(float, __builtin_amdgcn_readlane(vi, 16))) +
           (__builtin_bit_cast(float, __builtin_amdgcn_readlane(vi, 32)) + __builtin_bit_cast(float, __builtin_amdgcn_readlane(vi, 48)));
}
__device__ __forceinline__ float silu_f(float v) { return v * __builtin_amdgcn_rcpf(1.f + __expf(-v)); }
__device__ __forceinline__ float softplus_f(float x) { return fmaxf(x, 0.f) + __logf(1.f + __expf(-fabsf(x))); }

__device__ __forceinline__ float rstd_of(const float* ssq16, int row) {
    const f32x4* p = (const f32x4*)(ssq16 + (size_t)row * 16);
    const f32x4 a = p[0], b = p[1], c = p[2], d = p[3];
    const f32x4 t = (a + b) + (c + d);
    return __builtin_amdgcn_rsqf(((t[0] + t[1]) + (t[2] + t[3])) * (1.f / DM) + EPS);
}
struct EpiProj {
    static constexpr bool PERM = true, AFTER_DRAIN = false;
    bf16_t* O; int ldc; int gate_tile; float* gb; const float* a_log; const float* dt_bias; int scale_tiles; float scale; const float* ssq; const LAS float* rl; int row_lo; int silu_lo, silu_hi;
    __device__ __forceinline__ void operator()(const f32x4 (&acc)[2][2][4][2], const pg8::Unit& u, int wr, int wc, int fr, int fq) const {
        const int row0 = u.pm * 256 + wr * 64 + fr;
#define RS_OF(ai, m) (rl ? rl[row0 + (ai) * 128 + (m) * 16 - row_lo] : rstd_of(ssq, row0 + (ai) * 128 + (m) * 16))
        if (u.pn == gate_tile) {
            if (wc == 0) {
                const int c0 = 8 * fq;
#pragma unroll
                for (int ai = 0; ai < 2; ++ai)
#pragma unroll
                    for (int m = 0; m < 4; ++m) {
                        const int row = row0 + ai * 128 + m * 16; const float rsv = RS_OF(ai, m);
#pragma unroll
                        for (int n = 0; n < 2; ++n) {
                            const f32x4 v = acc[ai][0][m][n] * rsv; f32x4 o;
                            const int c = c0 + 4 * n;
                            if (fq < 2) {
#pragma unroll
                                for (int j = 0; j < 4; ++j) o[j] = 1.f / (1.f + __expf(-v[j]));
                            } else {
                                const f32x4 al = *(const f32x4*)(a_log + c - 16), db = *(const f32x4*)(dt_bias + c - 16);
#pragma unroll
                                for (int j = 0; j < 4; ++j) o[j] = -__expf(al[j]) * softplus_f(v[j] + db[j]);
                            }
                            *(f32x4*)(gb + (size_t)row * 32 + c) = o;
                        }
                    }
            }
            return;
        }
        const int col0 = u.pn * 256 + wc * 32 + 8 * fq;
        const float sc = (u.pn < scale_tiles) ? scale : 1.f;
#pragma unroll
        for (int ai = 0; ai < 2; ++ai)
#pragma unroll
            for (int m = 0; m < 4; ++m) { bf16_t* rowp = O + (size_t)(row0 + ai * 128 + m * 16) * ldc + col0; const float sr = sc * RS_OF(ai, m);
#pragma unroll
                for (int bj = 0; bj < 2; ++bj) { f32x4 v0 = acc[ai][bj][m][0] * sr, v1 = acc[ai][bj][m][1] * sr;
                    if (u.pn >= silu_lo && u.pn < silu_hi) {
#pragma unroll
                        for (int e = 0; e < 4; ++e) { v0[e] = silu_f(v0[e]); v1[e] = silu_f(v1[e]); } }
                    u32x4 w; w.x = cvt_pk_bf16(v0[0], v0[1]); w.y = cvt_pk_bf16(v0[2], v0[3]); w.z = cvt_pk_bf16(v1[0], v1[1]); w.w = cvt_pk_bf16(v1[2], v1[3]);
                    *(u32x4*)(rowp + bj * 128) = w; } }
    }
};
struct EpiSwiglu {
    static constexpr bool PERM = true, AFTER_DRAIN = false;
    bf16_t* O; int ldc; const float* ssq; const LAS float* rl; int row_lo;
    __device__ __forceinline__ void operator()(const f32x4 (&acc)[2][2][4][2], const pg8::Unit& u, int wr, int wc, int fr, int fq) const {
        const int row0 = u.pm * 256 + wr * 64 + fr, col0 = u.pn * 128 + wc * 32 + 8 * fq;
#pragma unroll
        for (int ai = 0; ai < 2; ++ai)
#pragma unroll
            for (int m = 0; m < 4; ++m) { bf16_t* rowp = O + (size_t)(row0 + ai * 128 + m * 16) * ldc + col0;
                float r[8]; const float rsd = rl ? rl[row0 + ai * 128 + m * 16 - row_lo] : rstd_of(ssq, row0 + ai * 128 + m * 16);
#pragma unroll
                for (int n = 0; n < 2; ++n)
#pragma unroll
                    for (int j = 0; j < 4; ++j) { const float g = acc[ai][0][m][n][j] * rsd, up = acc[ai][1][m][n][j] * rsd; r[4 * n + j] = silu_f(g) * up; }
                u32x4 w; w.x = cvt_pk_bf16(r[0], r[1]); w.y = cvt_pk_bf16(r[2], r[3]); w.z = cvt_pk_bf16(r[4], r[5]); w.w = cvt_pk_bf16(r[6], r[7]);
                *(u32x4*)rowp = w; }
    }
};
struct EpiRes {
    static constexpr bool PERM = false, AFTER_DRAIN = false;
    const float* base; float* out; int ldc; bf16_t* xb; float* ssq;
    __device__ __forceinline__ void operator()(const f32x4 (&acc)[2][2][4][2], const pg8::Unit& u, int wr, int wc, int fr, int fq) const {
        const int row0 = u.pm * 256 + wr * 64 + fr, col0 = u.pn * 256 + wc * 32 + 4 * fq;
#pragma unroll
        for (int ai = 0; ai < 2; ++ai) {
            f32x4 bs[4][2][2];
#pragma unroll
            for (int m = 0; m < 4; ++m) { const size_t off = (size_t)(row0 + ai * 128 + m * 16) * ldc + col0;
#pragma unroll
                for (int bj = 0; bj < 2; ++bj)
#pragma unroll
                    for (int n = 0; n < 2; ++n) bs[m][bj][n] = *(const f32x4*)(base + off + bj * 128 + n * 16); }
#pragma unroll
            for (int m = 0; m < 4; ++m) { const int row = row0 + ai * 128 + m * 16; const size_t off = (size_t)row * ldc + col0; float sq = 0.f;
#pragma unroll
                for (int bj = 0; bj < 2; ++bj)
#pragma unroll
                    for (int n = 0; n < 2; ++n) { const f32x4 o = bs[m][bj][n] + acc[ai][bj][m][n]; *(f32x4*)(out + off + bj * 128 + n * 16) = o;
                        sq += (o[0] * o[0] + o[1] * o[1]) + (o[2] * o[2] + o[3] * o[3]);
                        *(u32x2*)(xb + off + bj * 128 + n * 16) = (u32x2){cvt_pk_bf16(o[0], o[1]), cvt_pk_bf16(o[2], o[3])}; }
                sq += __shfl_xor(sq, 16); sq += __shfl_xor(sq, 32);
                if (fq == 0) ssq[(size_t)row * 16 + u.pn * 4 + wc] = sq; }
            asm volatile("" ::: "memory");
        }
    }
};

__device__ __forceinline__ unsigned f2bf(float f) { unsigned u = __float_as_uint(f); return (u + 0x7fffu + ((u >> 16) & 1u)) >> 16; }
__device__ __forceinline__ unsigned pk2(float lo, float hi) { return f2bf(lo) | (f2bf(hi) << 16); }
__device__ __forceinline__ void transpose_item(const float* W, int K, int N, bf16_t* WT, int k0, int n0, int drow0, LAS float* scr, int lane, const float* kscale) {
    const float ks = kscale ? kscale[k0 + lane] : 1.f;
#pragma unroll 8
    for (int i = 0; i < 32; ++i) { const int kk = 2 * i + (lane >> 5); scr[kk * 33 + (lane & 31)] = W[(size_t)(k0 + kk) * N + n0 + (lane & 31)] * __shfl(ks, kk); }
    asm volatile("s_waitcnt lgkmcnt(0)" ::: "memory");
    const int c = lane & 7;
#pragma unroll
    for (int j = 0; j < 4; ++j) { const int n = (lane >> 3) + 8 * j; const LAS float* s = scr + (8 * c) * 33 + n;
        u32x4 o; o.x = pk2(s[0 * 33], s[1 * 33]); o.y = pk2(s[2 * 33], s[3 * 33]); o.z = pk2(s[4 * 33], s[5 * 33]); o.w = pk2(s[6 * 33], s[7 * 33]);
        *(u32x4*)(WT + (size_t)(drow0 + n) * K + k0 + 8 * c) = o; }
    asm volatile("s_waitcnt lgkmcnt(0)" ::: "memory");
}
__device__ __forceinline__ void conv_plain(const float* W, int K, int N, bf16_t* WT, int item, LAS float* scr, int lane, const float* kscale) {
    const int nblk = N / 32, kb = item / nblk, nb = item % nblk;
    transpose_item(W, K, N, WT, 64 * kb, 32 * nb, 32 * nb, scr, lane, kscale);
}
__device__ __forceinline__ void conv_gu(const float* W, bf16_t* WT, int item, int up, LAS float* scr, int lane, const float* kscale) {
    const int nblk = FF / 32, kb = item / nblk, nb = item % nblk, n0 = 32 * nb;
    transpose_item(W, DM, FF, WT, 64 * kb, n0, (n0 >> 7) * 256 + (n0 & 127) + up * 128, scr, lane, kscale);
}
__device__ __forceinline__ void xb_rows(const float* x, bf16_t* xb, float* ssq, int gw, int NGW, int lane) {
    asm volatile("" : "+v"(lane));
    f32x4 v[4], vn[4];
    if (gw < M_TOK) {
#pragma unroll
        for (int j = 0; j < 4; ++j) v[j] = *((const f32x4*)(x + (size_t)gw * DM) + lane + 64 * j);
    }
    for (int m = gw; m < M_TOK; m += NGW) {
        if (m + NGW < M_TOK) {
#pragma unroll
            for (int j = 0; j < 4; ++j) vn[j] = *((const f32x4*)(x + (size_t)(m + NGW) * DM) + lane + 64 * j);
        }
        float s = 0.f;
#pragma unroll
        for (int j = 0; j < 4; ++j) s += (v[j].x * v[j].x + v[j].y * v[j].y) + (v[j].z * v[j].z + v[j].w * v[j].w);
        s = wave_sum(s);
        if (lane < 16) ssq[(size_t)m * 16 + lane] = (lane == 0) ? s : 0.f;
        u32x2* o8 = (u32x2*)(xb + (size_t)m * DM) + lane;
#pragma unroll
        for (int j = 0; j < 4; ++j) { u32x2 p; p.x = cvt_pk_bf16(v[j].x, v[j].y); p.y = cvt_pk_bf16(v[j].z, v[j].w); o8[64 * j] = p; }
#pragma unroll
        for (int j = 0; j < 4; ++j) v[j] = vn[j];
    }
}
__device__ __forceinline__ void final_norm_rows(float* x, const float* w, const float* ssq, int gw, int NGW, int lane) {
    f32x4 wv[4], v[4], vn[4]; float rstd = 0.f, rstdn = 0.f;
#pragma unroll
    for (int j = 0; j < 4; ++j) wv[j] = *((const f32x4*)w + lane + 64 * j);
    if (gw < M_TOK) {
#pragma unroll
        for (int j = 0; j < 4; ++j) v[j] = *((const f32x4*)(x + (size_t)gw * DM) + lane + 64 * j);
        rstd = rstd_of(ssq, gw);
    }
    for (int m = gw; m < M_TOK; m += NGW) {
        if (m + NGW < M_TOK) {
#pragma unroll
            for (int j = 0; j < 4; ++j) vn[j] = *((const f32x4*)(x + (size_t)(m + NGW) * DM) + lane + 64 * j);
            rstdn = rstd_of(ssq, m + NGW);
        }
        f32x4* xr = (f32x4*)(x + (size_t)m * DM) + lane;
#pragma unroll
        for (int j = 0; j < 4; ++j) xr[64 * j] = v[j] * rstd * wv[j];
#pragma unroll
        for (int j = 0; j < 4; ++j) v[j] = vn[j];
        rstd = rstdn;
    }
}

__device__ __forceinline__ void gdn_g0(LAS unsigned char* lds, bf16_t* proj, const float* __restrict__ convw, int blk, int G, int tid, int wave, int lane) {
    asm volatile("" : "+v"(lane), "+v"(tid));
    LAS unsigned* halo = (LAS unsigned*)lds;
    for (int unit = blk; unit < NB * 32; unit += G) {
        const int b = unit >> 5, slab = unit & 31, col = slab * 128 + 2 * lane;
        const f32x4 w0 = *(const f32x4*)(convw + (size_t)col * 4), w1 = *(const f32x4*)(convw + (size_t)(col + 1) * 4);
        const float nsc = (slab < 8) ? 0.08838834764831845f : 1.f;
        const bool donorm = slab < 16;
        bf16_t* base = proj + (size_t)b * SEQ * GDN_PITCH + col;
        constexpr int RPW = 32, CH = 8 * RPW, NCH = SEQ / CH;
        unsigned x[RPW + 3], xn[RPW + 3];
#pragma unroll
        for (int j = 0; j < RPW + 3; ++j) { const int t = RPW * wave - 3 + j; x[j] = (t >= 0) ? *(const unsigned*)(base + (size_t)t * GDN_PITCH) : 0u; }
        __syncthreads();
        for (int chunk = 0; chunk < NCH; ++chunk) {
            if (chunk < NCH - 1) {
#pragma unroll
                for (int j = 0; j < RPW + 3; ++j) { const int t = RPW * wave - 3 + j; if (t >= 0) xn[j] = *(const unsigned*)(base + (size_t)((chunk + 1) * CH + t) * GDN_PITCH); }
            }
            if (wave == 7) {
#pragma unroll
                for (int j = 0; j < 3; ++j) halo[(((chunk + 1) & 1) * 3 + j) * 64 + lane] = x[RPW + j];
            }
            unsigned o[RPW];
#pragma unroll
            for (int r = 0; r < RPW; ++r) {
                float a0 = bflo(x[r]) * w0[0] + bflo(x[r + 1]) * w0[1] + bflo(x[r + 2]) * w0[2] + bflo(x[r + 3]) * w0[3];
                float a1 = bfhi(x[r]) * w1[0] + bfhi(x[r + 1]) * w1[1] + bfhi(x[r + 2]) * w1[2] + bfhi(x[r + 3]) * w1[3];
                a0 = silu_f(a0); a1 = silu_f(a1);
                if (donorm) { const float rn = nsc * __builtin_amdgcn_rsqf(wave_sum(a0 * a0 + a1 * a1) + EPS); a0 *= rn; a1 *= rn; }
                o[r] = cvt_pk_bf16(a0, a1);
            }
            __syncthreads();
            bf16_t* cb = base + (size_t)(chunk * CH + RPW * wave) * GDN_PITCH;
#pragma unroll
            for (int r = 0; r < RPW; ++r) *(unsigned*)(cb + (size_t)r * GDN_PITCH) = o[r];
            if (chunk < NCH - 1) {
#pragma unroll
                for (int j = 0; j < RPW + 3; ++j) { const int t = RPW * wave - 3 + j; x[j] = (t >= 0) ? xn[j] : halo[(((chunk + 1) & 1) * 3 + j) * 64 + lane]; }
            }
        }
        __syncthreads();
    }
}

__device__ __forceinline__ int crow(int r, int hi) { return (r & 3) + 8 * (r >> 2) + 4 * hi; }

__device__ __forceinline__ void gdn_g1(LAS unsigned char* lds, const bf16_t* __restrict__ proj, const float* gb, float* gcs, const float* __restrict__ convw,
                                        bf16_t* __restrict__ Tbuf, int gw, int NGW, int wave, int lane) {
    asm volatile("" : "+v"(lane));
    LAS float* Lw = (LAS float*)(lds + wave * 16384);
    LAS float* aux = (LAS float*)(lds + 131072 + wave * 1024);
    const int r32 = lane & 31, hi = lane >> 5;
    for (int u = gw; u < NB * 64 * 16; u += NGW) {
        const int hv = u & 15, chunk = (u >> 4) & 63, b = u >> 10, hq = hv >> 1;
        const size_t rowb = (size_t)b * SEQ + chunk * 64;
        {
            float g = gb[(rowb + lane) * 32 + 16 + hv]; const float bt = gb[(rowb + lane) * 32 + hv];
#pragma unroll
            for (int o = 1; o < 64; o <<= 1) { const float t = __shfl_up(g, o); if (lane >= o) g += t; }
            aux[lane] = g; aux[64 + lane] = bt;
            gcs[(rowb + lane) * 32 + 16 + hv] = g;
        }
        f32x16 a00 = {}, a10 = {}, a11 = {};
        {
            const bf16_t* kp = proj + (rowb + r32) * GDN_PITCH + 1024 + hq * 128 + 8 * hi;
            bf16x8 kf0[8], kf1[8];
#pragma unroll
            for (int kk = 0; kk < 8; ++kk) { kf0[kk] = *(const bf16x8*)(kp + 16 * kk); kf1[kk] = *(const bf16x8*)(kp + (size_t)32 * GDN_PITCH + 16 * kk); }
#pragma unroll
            for (int kk = 0; kk < 8; ++kk) {
                a00 = __builtin_amdgcn_mfma_f32_32x32x16_bf16(kf0[kk], kf0[kk], a00, 0, 0, 0);
                a10 = __builtin_amdgcn_mfma_f32_32x32x16_bf16(kf1[kk], kf0[kk], a10, 0, 0, 0);
                a11 = __builtin_amdgcn_mfma_f32_32x32x16_bf16(kf1[kk], kf1[kk], a11, 0, 0, 0);
            }
        }
        asm volatile("s_waitcnt lgkmcnt(0)" ::: "memory");
        {
            const float gcj0 = aux[r32], gcj1 = aux[32 + r32];
#pragma unroll
            for (int r = 0; r < 16; ++r) {
                const int i0 = crow(r, hi), i1 = 32 + i0;
                const float gi0 = aux[i0], gi1 = aux[i1], bi0 = aux[64 + i0], bi1 = aux[64 + i1];
                Lw[i0 * 64 + r32] = (i0 > r32) ? bi0 * a00[r] * __expf(gi0 - gcj0) : 0.f;
                Lw[i1 * 64 + r32] = bi1 * a10[r] * __expf(gi1 - gcj0);
                Lw[i1 * 64 + 32 + r32] = (i0 > r32) ? bi1 * a11[r] * __expf(gi1 - gcj1) : 0.f;
            }
        }
        asm volatile("s_waitcnt lgkmcnt(0)" ::: "memory");
        float X[64];
#pragma unroll
        for (int i = 0; i < 64; ++i) {
            float xi = (lane == i) ? 1.f : 0.f, xj = 0.f;
#pragma unroll
            for (int g4 = 0; g4 < (i + 3) / 4; ++g4) {
                const f32x4 l = *(const LAS f32x4*)(Lw + i * 64 + 4 * g4);
#pragma unroll
                for (int e = 0; e < 4; ++e) { const int j = 4 * g4 + e; if (j < i) { if (j & 1) xj -= l[e] * X[j]; else xi -= l[e] * X[j]; } }
            }
            X[i] = xi + xj;
            if ((i & 3) == 3) asm volatile("" ::: "memory");
        }
        bf16_t* To = Tbuf + (size_t)((b * 16 + hv) * 64 + chunk) * 4096 + lane;
#pragma unroll
        for (int i = 0; i < 64; ++i) To[i * 64] = (bf16_t)f2bf(X[i]);
        asm volatile("s_waitcnt lgkmcnt(0)" ::: "memory");
    }
}

namespace g2 {
constexpr int QN = 0, KN = 18432, KNT = 35840, VT = 54272, RT = 72704, ST = 91136, TL = 125952, ATT = 135168, AUX = 144384;
constexpr int P128 = 272, P64 = 144;
__device__ __forceinline__ f32x16 mma(f32x16 acc, LAS const unsigned char* A, int ap, LAS const unsigned char* B, int bp, int nk, int r32, int hi) {
    LAS const unsigned char* a = A + r32 * ap + 16 * hi; LAS const unsigned char* b = B + r32 * bp + 16 * hi;
#pragma unroll
    for (int kk = 0; kk < 8; ++kk) if (kk < nk) {
        const bf16x8 av = *(LAS const bf16x8*)(a + 32 * kk), bv = *(LAS const bf16x8*)(b + 32 * kk);
        acc = __builtin_amdgcn_mfma_f32_32x32x16_bf16(av, bv, acc, 0, 0, 0);
    }
    return acc;
}
}
__device__ __forceinline__ void gdn_g2(LAS unsigned char* lds, bf16_t* proj, const float* __restrict__ gb, const float* __restrict__ convw, const float* __restrict__ normw,
                                        const bf16_t* __restrict__ Tbuf, int unit0, int ustride, int tid, int wave, int lane) {
    using namespace g2;
    asm volatile("" : "+v"(lane), "+v"(tid));
    const int r32 = lane & 31, hi = lane >> 5, ti = wave & 1, tj = wave >> 1;
    LAS float* aux = (LAS float*)(lds + AUX);
    for (int unit = unit0; unit < NB * 16; unit += ustride) {
        const int b = unit >> 4, hv = unit & 15, hq = hv >> 1;
        const int colq = hq * 128 + 2 * lane, colk = 1024 + colq, colv = 2048 + hv * 128 + 2 * lane, colz = 4096 + hv * 128 + 2 * lane;
        const float nw0 = normw[2 * lane], nw1 = normw[2 * lane + 1];
        f32x16 S0 = {}, S1 = {};
        for (int i = tid; i < 34816 / 4; i += 512) ((LAS unsigned*)(lds + ST))[i] = 0u;
        unsigned xq[8], xk[8], xv[8];
#define G2_LOADX(CH) do { _Pragma("unroll") for (int r = 0; r < 8; ++r) { const bf16_t* p = proj + (size_t)((long)b * SEQ + (CH) * 64 + 8 * wave + r) * GDN_PITCH; \
            xq[r] = *(const unsigned*)(p + colq); xk[r] = *(const unsigned*)(p + colk); xv[r] = *(const unsigned*)(p + colv); } } while (0)
        G2_LOADX(0);
        for (int chunk = 0; chunk < 64; ++chunk) {
            const size_t rowb = (size_t)b * SEQ + chunk * 64;
            unsigned zreg[8]; u32x4 treg;
            {
#pragma unroll
                for (int r = 0; r < 8; ++r) zreg[r] = *(const unsigned*)(proj + (rowb + 8 * wave + r) * GDN_PITCH + colz);
                treg = *(const u32x4*)(Tbuf + (size_t)((b * 16 + hv) * 64 + chunk) * 4096 + (tid >> 3) * 64 + (tid & 7) * 8);
#pragma unroll
                for (int r = 0; r < 8; ++r) {
                    *(LAS unsigned*)(lds + QN + (8 * wave + r) * P128 + 4 * lane) = xq[r];
                    *(LAS unsigned*)(lds + KN + (8 * wave + r) * P128 + 4 * lane) = xk[r];
                }
#define PKLO(a, b) (((a) & 0xffffu) | ((b) << 16))
#define PKHI(a, b) (((a) >> 16) | ((b) & 0xffff0000u))
                *(LAS u32x4*)(lds + KNT + (2 * lane) * P64 + 16 * wave) = (u32x4){PKLO(xk[0], xk[1]), PKLO(xk[2], xk[3]), PKLO(xk[4], xk[5]), PKLO(xk[6], xk[7])};
                *(LAS u32x4*)(lds + KNT + (2 * lane + 1) * P64 + 16 * wave) = (u32x4){PKHI(xk[0], xk[1]), PKHI(xk[2], xk[3]), PKHI(xk[4], xk[5]), PKHI(xk[6], xk[7])};
                *(LAS u32x4*)(lds + VT + (2 * lane) * P64 + 16 * wave) = (u32x4){PKLO(xv[0], xv[1]), PKLO(xv[2], xv[3]), PKLO(xv[4], xv[5]), PKLO(xv[6], xv[7])};
                *(LAS u32x4*)(lds + VT + (2 * lane + 1) * P64 + 16 * wave) = (u32x4){PKHI(xv[0], xv[1]), PKHI(xv[2], xv[3]), PKHI(xv[4], xv[5]), PKHI(xv[6], xv[7])};
                if (wave == 0) {
                    const float g = gb[(rowb + lane) * 32 + 16 + hv], bt = gb[(rowb + lane) * 32 + hv];
                    const float gl = __builtin_bit_cast(float, __builtin_amdgcn_readlane(__builtin_bit_cast(int, g), 63));
                    aux[lane] = g; aux[64 + lane] = bt; aux[128 + lane] = __expf(g); aux[192 + lane] = __expf(gl - g);
                    if (lane == 0) aux[256] = __expf(gl);
                }
            }
            __syncthreads();
            if (chunk < 63) G2_LOADX(chunk + 1);
            if (wave < 4) {
                const int si = wave & 1, tq = wave >> 1;
                f32x16 p = {};
                p = mma(p, lds + KN + 32 * si * P128, P128, lds + QN + 32 * tq * P128, P128, 8, r32, hi);
                const int t = 32 * tq + r32; const float gt = aux[t];
#pragma unroll
                for (int g4 = 0; g4 < 4; ++g4) {
                    float a[4];
#pragma unroll
                    for (int e = 0; e < 4; ++e) { const int s = 32 * si + 8 * g4 + 4 * hi + e; a[e] = (s <= t) ? p[4 * g4 + e] * __expf(gt - aux[s]) : 0.f; }
                    *(LAS u32x2*)(lds + ATT + t * P64 + (32 * si + 8 * g4 + 4 * hi) * 2) = (u32x2){cvt_pk_bf16(a[0], a[1]), cvt_pk_bf16(a[2], a[3])};
                }
            }
            f32x16 o1 = {};
            {
                f32x16 acc = {};
                acc = mma(acc, lds + KN + 32 * ti * P128, P128, lds + ST + 32 * tj * P128, P128, 8, r32, hi);
                o1 = mma(o1, lds + QN + 32 * ti * P128, P128, lds + ST + 32 * tj * P128, P128, 8, r32, hi);
                const int dv = 32 * tj + r32;
#pragma unroll
                for (int g4 = 0; g4 < 4; ++g4) {
                    const int t0 = 32 * ti + 8 * g4 + 4 * hi;
                    const u32x2 vv = *(LAS const u32x2*)(lds + VT + dv * P64 + t0 * 2);
                    const float v4[4] = {bflo(vv.x), bfhi(vv.x), bflo(vv.y), bfhi(vv.y)};
                    float rr[4];
#pragma unroll
                    for (int e = 0; e < 4; ++e) { const float eg = aux[128 + t0 + e]; rr[e] = aux[64 + t0 + e] * (v4[e] - eg * acc[4 * g4 + e]); o1[4 * g4 + e] *= eg; }
                    *(LAS u32x2*)(lds + RT + dv * P64 + t0 * 2) = (u32x2){cvt_pk_bf16(rr[0], rr[1]), cvt_pk_bf16(rr[2], rr[3])};
                }
            }
            *(LAS u32x4*)(lds + TL + (tid >> 3) * P64 + (tid & 7) * 16) = treg;
            __syncthreads();
            {
                f32x16 acc = {};
                acc = mma(acc, lds + TL + 32 * ti * P64, P64, lds + RT + 32 * tj * P64, P64, 4, r32, hi);
                const int dv = 32 * tj + r32;
#pragma unroll
                for (int g4 = 0; g4 < 4; ++g4) {
                    const int t0 = 32 * ti + 8 * g4 + 4 * hi;
                    float s4[4];
#pragma unroll
                    for (int e = 0; e < 4; ++e) s4[e] = acc[4 * g4 + e] * aux[192 + t0 + e];
                    *(LAS u32x2*)(lds + VT + dv * P64 + t0 * 2) = (u32x2){cvt_pk_bf16(acc[4 * g4], acc[4 * g4 + 1]), cvt_pk_bf16(acc[4 * g4 + 2], acc[4 * g4 + 3])};
                    *(LAS u32x2*)(lds + QN + dv * P64 + t0 * 2) = (u32x2){cvt_pk_bf16(s4[0], s4[1]), cvt_pk_bf16(s4[2], s4[3])};
                }
            }
            __syncthreads();
            {
                o1 = mma(o1, lds + ATT + 32 * ti * P64, P64, lds + VT + 32 * tj * P64, P64, 4, r32, hi);
                const int dv = 32 * tj + r32;
#pragma unroll
                for (int r = 0; r < 16; ++r) { const int t = 32 * ti + crow(r, hi); *(LAS unsigned short*)(lds + RT + t * P128 + dv * 2) = (unsigned short)f2bf(o1[r]); }
                const float egl = aux[256];
                S0 = S0 * egl; S1 = S1 * egl;
                S0 = mma(S0, lds + KNT + 32 * (2 * ti) * P64, P64, lds + QN + 32 * tj * P64, P64, 4, r32, hi);
                S1 = mma(S1, lds + KNT + 32 * (2 * ti + 1) * P64, P64, lds + QN + 32 * tj * P64, P64, 4, r32, hi);
#pragma unroll
                for (int g4 = 0; g4 < 4; ++g4) {
                    const int d0 = 8 * g4 + 4 * hi;
                    *(LAS u32x2*)(lds + ST + dv * P128 + (64 * ti + d0) * 2) = (u32x2){cvt_pk_bf16(S0[4 * g4], S0[4 * g4 + 1]), cvt_pk_bf16(S0[4 * g4 + 2], S0[4 * g4 + 3])};
                    *(LAS u32x2*)(lds + ST + dv * P128 + (64 * ti + 32 + d0) * 2) = (u32x2){cvt_pk_bf16(S1[4 * g4], S1[4 * g4 + 1]), cvt_pk_bf16(S1[4 * g4 + 2], S1[4 * g4 + 3])};
                }
            }
            __syncthreads();
#pragma unroll
            for (int r = 0; r < 8; ++r) {
                const int t = 8 * wave + r;
                const unsigned ov = *(LAS const unsigned*)(lds + RT + t * P128 + 4 * lane);
                const float oa = bflo(ov), ob = bfhi(ov);
                const float rstd = __builtin_amdgcn_rsqf(wave_sum(oa * oa + ob * ob) * (1.f / 128.f) + EPS);
                bf16_t* prow = proj + (rowb + t) * GDN_PITCH;
                const unsigned zv = zreg[r];
                *(unsigned*)(prow + colv) = cvt_pk_bf16(oa * rstd * nw0 * bflo(zv), ob * rstd * nw1 * bfhi(zv));
            }
        }
        __syncthreads();
    }
}

template <bool MASK> __device__ __forceinline__ void sb_tile(LAS const unsigned char* kb, LAS const unsigned char* vb, const bf16x8 (&qr)[4], const bf16x8 (&Uf)[2],
                                                            f32x16& oT0, f32x16& oT1, float& carry, const int s0, const int tq, const int r32, const int hi) {
    constexpr int P = 144, PV = 272;
    f32x16 p0 = {}, p1 = {};
#pragma unroll
    for (int kk = 0; kk < 4; ++kk) {
        const bf16x8 k0 = *(LAS const bf16x8*)(kb + r32 * P + (16 * kk + 8 * hi) * 2), k1 = *(LAS const bf16x8*)(kb + (32 + r32) * P + (16 * kk + 8 * hi) * 2);
        p0 = __builtin_amdgcn_mfma_f32_32x32x16_bf16(k0, qr[kk], p0, 0, 0, 0);
        p1 = __builtin_amdgcn_mfma_f32_32x32x16_bf16(k1, qr[kk], p1, 0, 0, 0);
    }
    float lk0[16], lk1[16]; float cs0 = 0.f, cs1 = 0.f;
#pragma unroll
    for (int r = 0; r < 16; ++r) {
        const float y0 = p0[r], y1 = p1[r];
        const float sp0 = __builtin_amdgcn_logf(1.f + __builtin_amdgcn_exp2f(__builtin_amdgcn_fmed3f(y0, -126.f, 126.f)));
        const float sp1 = __builtin_amdgcn_logf(1.f + __builtin_amdgcn_exp2f(__builtin_amdgcn_fmed3f(y1, -126.f, 126.f)));
        if (MASK) { const int s = s0 + crow(r, hi); lk0[r] = (s < tq) ? sp0 : 0.f; lk1[r] = (s + 32 < tq) ? sp1 : 0.f; }
        else { lk0[r] = sp0; lk1[r] = sp1; }
        cs0 += lk0[r]; cs1 += lk1[r];
    }
    {
        const auto r0 = __builtin_amdgcn_permlane32_swap(__float_as_uint(cs0), __float_as_uint(cs0), false, false);
        const auto r1 = __builtin_amdgcn_permlane32_swap(__float_as_uint(cs1), __float_as_uint(cs1), false, false);
        cs0 = __uint_as_float(r0[0]) + __uint_as_float(r0[1]); cs1 = __uint_as_float(r1[0]) + __uint_as_float(r1[1]);
    }
    const float c0 = carry - cs1;
#pragma unroll
    for (int r = 0; r < 16; ++r) { p0[r] += c0; p1[r] += carry; }
#pragma unroll
    for (int kk = 0; kk < 4; ++kk) {
        u32x4 w;
        if (kk < 2) { w.x = cvt_pk_bf16(lk0[8 * kk], lk0[8 * kk + 1]); w.y = cvt_pk_bf16(lk0[8 * kk + 2], lk0[8 * kk + 3]); w.z = cvt_pk_bf16(lk0[8 * kk + 4], lk0[8 * kk + 5]); w.w = cvt_pk_bf16(lk0[8 * kk + 6], lk0[8 * kk + 7]); }
        else { const int q = 8 * (kk - 2); w.x = cvt_pk_bf16(lk1[q], lk1[q + 1]); w.y = cvt_pk_bf16(lk1[q + 2], lk1[q + 3]); w.z = cvt_pk_bf16(lk1[q + 4], lk1[q + 5]); w.w = cvt_pk_bf16(lk1[q + 6], lk1[q + 7]); }
        const bf16x8 lf = __builtin_bit_cast(bf16x8, w);
        if (kk < 2) p0 = __builtin_amdgcn_mfma_f32_32x32x16_bf16(Uf[kk], lf, p0, 0, 0, 0);
        else p1 = __builtin_amdgcn_mfma_f32_32x32x16_bf16(Uf[kk - 2], lf, p1, 0, 0, 0);
    }
    carry -= cs0 + cs1;
#pragma unroll
    for (int r = 0; r < 16; ++r) {
        float a0 = __builtin_amdgcn_exp2f(p0[r]), a1 = __builtin_amdgcn_exp2f(p1[r]);
        if (MASK) { const int s = s0 + crow(r, hi); a0 = (s < tq) ? a0 : 0.f; a1 = (s + 32 < tq) ? a1 : 0.f; }
        lk0[r] = a0; lk1[r] = a1;
    }
#pragma unroll
    for (int kk = 0; kk < 4; ++kk) {
        u32x4 w;
        if (kk < 2) { w.x = cvt_pk_bf16(lk0[8 * kk], lk0[8 * kk + 1]); w.y = cvt_pk_bf16(lk0[8 * kk + 2], lk0[8 * kk + 3]); w.z = cvt_pk_bf16(lk0[8 * kk + 4], lk0[8 * kk + 5]); w.w = cvt_pk_bf16(lk0[8 * kk + 6], lk0[8 * kk + 7]); }
        else { const int q = 8 * (kk - 2); w.x = cvt_pk_bf16(lk1[q], lk1[q + 1]); w.y = cvt_pk_bf16(lk1[q + 2], lk1[q + 3]); w.z = cvt_pk_bf16(lk1[q + 4], lk1[q + 5]); w.w = cvt_pk_bf16(lk1[q + 6], lk1[q + 7]); }
        const bf16x8 af = __builtin_bit_cast(bf16x8, w);
        const u32x2 a0 = *(LAS const u32x2*)(vb + r32 * PV + (16 * kk + 4 * hi) * 2), a1 = *(LAS const u32x2*)(vb + r32 * PV + (16 * kk + 8 + 4 * hi) * 2);
        const u32x2 b0 = *(LAS const u32x2*)(vb + (32 + r32) * PV + (16 * kk + 4 * hi) * 2), b1 = *(LAS const u32x2*)(vb + (32 + r32) * PV + (16 * kk + 8 + 4 * hi) * 2);
        const bf16x8 v0 = __builtin_bit_cast(bf16x8, (u32x4){a0.x, a0.y, a1.x, a1.y}), v1 = __builtin_bit_cast(bf16x8, (u32x4){b0.x, b0.y, b1.x, b1.y});
        oT0 = __builtin_amdgcn_mfma_f32_32x32x16_bf16(v0, af, oT0, 0, 0, 0);
        oT1 = __builtin_amdgcn_mfma_f32_32x32x16_bf16(v1, af, oT1, 0, 0, 0);
    }
}
__device__ __forceinline__ void sb_attn(LAS unsigned char* lds, bf16_t* qkv, int blk, int G, int tid, int wave, int lane) {
    constexpr int KBUF = 18432, VBUF = 17408, BUF = KBUF + VBUF, P = 144, PV = 272, LD = 3072;
    asm volatile("" : "+v"(lane), "+v"(tid));
    const int r32 = lane & 31, hi = lane >> 5;
    bf16x8 Uf[2];
#pragma unroll
    for (int kk = 0; kk < 2; ++kk)
#pragma unroll
        for (int e = 0; e < 8; ++e) { const int j = 16 * kk + 8 * (e >> 2) + 4 * hi + (e & 3); Uf[kk][e] = (j >= r32) ? (short)0xBF80 : (short)0; }
    const int srow = tid >> 3, sch = tid & 7;
    for (int u = blk; u < 2048; u += G) {
        const int i = u >> 8, jj = u & 255, bh = jj & 127, half = jj >> 7, qb = 15 - 2 * i - (half ^ (i & 1));
        const int b = bh >> 4, h = bh & 15, q0 = qb * 256;
        const size_t rowb = (size_t)b * SEQ;
        const int tq = q0 + 32 * wave + r32;
        bf16_t* qptr = qkv + (rowb + tq) * LD + h * 64;
        bf16x8 qr[4];
#pragma unroll
        for (int kk = 0; kk < 4; ++kk) qr[kk] = *(const bf16x8*)(qptr + 16 * kk + 8 * hi);
        f32x16 oT0 = {}, oT1 = {};
        float carry = 0.f;
        const int stmax = (q0 >> 7) + 1;
        const bf16_t* kbase = qkv + (rowb + srow) * LD + 1024 + h * 64 + sch * 8;
        const bf16_t* vbase = qkv + (rowb + lane) * LD + 2048 + h * 64 + wave * 8;
        u32x4 kreg0 = *(const u32x4*)(kbase + (size_t)stmax * 128 * LD), kreg1 = *(const u32x4*)(kbase + (size_t)(stmax * 128 + 64) * LD);
        u32x4 vreg0 = *(const u32x4*)(vbase + (size_t)stmax * 128 * LD), vreg1 = *(const u32x4*)(vbase + (size_t)(stmax * 128 + 64) * LD);
        int cur = 0;
        __syncthreads();
        for (int st = stmax; st >= 0; --st) {
            LAS unsigned char* kb = lds + cur * BUF; LAS unsigned char* vb = kb + KBUF;
            *(LAS u32x4*)(kb + srow * P + sch * 16) = kreg0;
            *(LAS u32x4*)(kb + (64 + srow) * P + sch * 16) = kreg1;
#pragma unroll
            for (int e = 0; e < 4; ++e) {
                *(LAS unsigned short*)(vb + (wave * 8 + 2 * e) * PV + lane * 2) = (unsigned short)(vreg0[e] & 0xffffu);
                *(LAS unsigned short*)(vb + (wave * 8 + 2 * e + 1) * PV + lane * 2) = (unsigned short)(vreg0[e] >> 16);
                *(LAS unsigned short*)(vb + (wave * 8 + 2 * e) * PV + (64 + lane) * 2) = (unsigned short)(vreg1[e] & 0xffffu);
                *(LAS unsigned short*)(vb + (wave * 8 + 2 * e + 1) * PV + (64 + lane) * 2) = (unsigned short)(vreg1[e] >> 16);
            }
            __syncthreads();
            if (st > 0) {
                kreg0 = *(const u32x4*)(kbase + (size_t)(st - 1) * 128 * LD); kreg1 = *(const u32x4*)(kbase + (size_t)((st - 1) * 128 + 64) * LD);
                vreg0 = *(const u32x4*)(vbase + (size_t)(st - 1) * 128 * LD); vreg1 = *(const u32x4*)(vbase + (size_t)((st - 1) * 128 + 64) * LD);
            }
            const int tmin = q0 + 32 * wave;
#pragma unroll
            for (int hf = 1; hf >= 0; --hf) {
                const int s0 = st * 128 + hf * 64;
                if (s0 < tmin + 31) {
                    if (s0 + 63 >= tmin) sb_tile<true>(kb + hf * 64 * P, vb + hf * 128, qr, Uf, oT0, oT1, carry, s0, tq, r32, hi);
                    else sb_tile<false>(kb + hf * 64 * P, vb + hf * 128, qr, Uf, oT0, oT1, carry, s0, tq, r32, hi);
                }
            }
            cur ^= 1;
        }
#pragma unroll
        for (int g4 = 0; g4 < 4; ++g4) {
            const int d0 = 8 * g4 + 4 * hi;
            *(u32x2*)(qptr + d0) = (u32x2){cvt_pk_bf16(oT0[4 * g4], oT0[4 * g4 + 1]), cvt_pk_bf16(oT0[4 * g4 + 2], oT0[4 * g4 + 3])};
            *(u32x2*)(qptr + 32 + d0) = (u32x2){cvt_pk_bf16(oT1[4 * g4], oT1[4 * g4 + 1]), cvt_pk_bf16(oT1[4 * g4 + 2], oT1[4 * g4 + 3])};
        }
    }
}

struct Args { const float* in[15]; float* out; unsigned char* ws; };
#define XB_TMO      128
#define XB_XCNT(j)  (256  + 64 * (j))
#define XB_XSUB(j)  (1280 + 64 * (j))
#define XB_XGEN(j)  (2304 + 64 * (j))
#define XB_TOP      3328
#define XB_TOPGEN   3392
#define XCD_BAR_WORDS 3456
#define XB_SPIN_CAP (1u << 18)

__device__ __forceinline__ unsigned xb_ld(unsigned* p)              { return __hip_atomic_load(p, __ATOMIC_RELAXED, __HIP_MEMORY_SCOPE_AGENT); }
__device__ __forceinline__ unsigned xb_add(unsigned* p, unsigned v) { return __hip_atomic_fetch_add(p, v, __ATOMIC_RELAXED, __HIP_MEMORY_SCOPE_AGENT); }
__device__ __forceinline__ unsigned xb_xcc_id() { return (unsigned)__builtin_amdgcn_s_getreg((3 << 11) | 20) & 0xFu; }
#define XB_SPIN(cond, bar) do { unsigned _sp = 0; while (cond) { __builtin_amdgcn_s_sleep(1); \
    if ((++_sp & 255u) == 0u) { if (xb_ld(&(bar)[XB_TMO])) break; if (_sp > XB_SPIN_CAP) { atomicAdd(&(bar)[XB_TMO], 1u); break; } } } } while (0)

struct XcdBarrier {
    unsigned* bar; unsigned x;
    volatile LAS unsigned* st;
};

__device__ __forceinline__ XcdBarrier xcd_barrier_post(unsigned* bar, volatile LAS unsigned* st) {
    XcdBarrier b; b.bar = bar; b.x = xb_xcc_id(); b.st = st;
    if (threadIdx.x == 0) (void)xb_add(&bar[XB_XCNT(b.x)], 1u);
    return b;
}
__device__ __forceinline__ void xcd_barrier_complete(unsigned* bar, unsigned x, unsigned& nloc, unsigned& nx) {
    const unsigned G = gridDim.x * gridDim.y * gridDim.z;
    unsigned sum, cnt, mine, sp = 0u;
    for (;;) {
        sum = 0u; cnt = 0u; mine = 0u;
#pragma unroll
        for (unsigned j = 0; j < 16; ++j) { const unsigned c = xb_ld(&bar[XB_XCNT(j)]); sum += c; cnt += (c > 0u) ? 1u : 0u; mine = (j == x) ? c : mine; }
        if (sum == G) break;
        __builtin_amdgcn_s_sleep(1);
        if ((++sp & 255u) == 0u) { if (xb_ld(&bar[XB_TMO])) break; if (sp > XB_SPIN_CAP) { atomicAdd(&bar[XB_TMO], 1u); break; } }
    }
    nloc = mine > 0u ? mine : 1u; nx = cnt > 0u ? cnt : 1u;
}

__device__ __forceinline__ void xcd_barrier(const XcdBarrier& b) {
    asm volatile("s_waitcnt vmcnt(0)" ::: "memory");
    __syncthreads();
    if (threadIdx.x == 0) {
        unsigned* bar = b.bar;
        __builtin_amdgcn_s_waitcnt(0);
        unsigned nloc = b.st[0], nx = b.st[1];
        if (nloc == 0u) { xcd_barrier_complete(bar, b.x, nloc, nx); b.st[0] = nloc; b.st[1] = nx; }
        const unsigned old = xb_add(&bar[XB_XSUB(b.x)], 1u);
        const unsigned gen = old / nloc;
        if (old + 1u == (gen + 1u) * nloc) {
            __builtin_amdgcn_fence(__ATOMIC_RELEASE, "agent");
            asm volatile("s_waitcnt vmcnt(0)" ::: "memory");
            const unsigned og = xb_add(&bar[XB_TOP], 1u);
            const unsigned tg = og / nx;
            if (og + 1u == (tg + 1u) * nx) xb_add(&bar[XB_TOPGEN], 1u);
            else XB_SPIN(xb_ld(&bar[XB_TOPGEN]) == tg, bar);
            __builtin_amdgcn_fence(__ATOMIC_ACQUIRE, "agent");
            xb_add(&bar[XB_XGEN(b.x)], 1u);
            asm volatile("s_waitcnt vmcnt(0)" ::: "memory");
        } else {
            XB_SPIN(xb_ld(&bar[XB_XGEN(b.x)]) == gen, bar);
            __builtin_amdgcn_fence(__ATOMIC_ACQUIRE, "agent");
            asm volatile("s_waitcnt vmcnt(0)" ::: "memory");
        }
    }
    __syncthreads();
}

template <bool gdn> __device__ __forceinline__ void conv_mixer_weights(const Args& a, const int layer, bf16_t* Win_t, bf16_t* Wout_t, LAS float* scr, int gw, int NGW, int lane) {
    const int j = layer >> 1;
    const float* w_in = gdn ? a.in[1] + (size_t)j * DM * GDN_N : a.in[7] + (size_t)j * DM * 3072;
    const float* w_out = gdn ? a.in[6] + (size_t)j * 2048 * DM : a.in[8] + (size_t)j * DM * DM;
    constexpr int n_in = gdn ? GDN_N : 3072, k_out = gdn ? 2048 : 1024;
    constexpr int I_in = (DM / 64) * (n_in / 32), I_out = (k_out / 64) * (DM / 32);
    for (int it = gw; it < I_in + I_out; it += NGW) {
        if (it < I_in) conv_plain(w_in, DM, n_in, Win_t, it, scr, lane, a.in[9] + layer * DM);
        else conv_plain(w_out, k_out, DM, Wout_t, it - I_in, scr, lane, nullptr);
    }
}
__device__ __forceinline__ void conv_ffn_weights(const Args& a, const int layer, bf16_t* Wgu_t, bf16_t* Wdn_t, LAS float* scr, int gw, int NGW, int lane) {
    constexpr int I_g = (DM / 64) * (FF / 32), I_d = (FF / 64) * (DM / 32);
    const float* wg = a.in[11] + (size_t)layer * DM * FF; const float* wu = a.in[12] + (size_t)layer * DM * FF; const float* wd = a.in[13] + (size_t)layer * FF * DM;
    for (int it = gw; it < 2 * I_g + I_d; it += NGW) {
        if (it < I_g) conv_gu(wg, Wgu_t, it, 0, scr, lane, a.in[10] + layer * DM);
        else if (it < 2 * I_g) conv_gu(wu, Wgu_t, it - I_g, 1, scr, lane, a.in[10] + layer * DM);
        else conv_plain(wd, FF, DM, Wdn_t, it - 2 * I_g, scr, lane, nullptr);
    }
}
__device__ __forceinline__ void conv_during_gdn_mixer(const Args& a, const int layer, LAS float* scr, int hw, int NHW, int lane) {
    conv_ffn_weights(a, layer, (bf16_t*)(a.ws + WS_WGU), (bf16_t*)(a.ws + WS_WDN), scr, hw, NHW, lane);
    conv_mixer_weights<false>(a, layer + 1, (bf16_t*)(a.ws + WS_WIN), (bf16_t*)(a.ws + WS_ALT_WOUT), scr, hw, NHW, lane);
    conv_ffn_weights(a, layer + 1, (bf16_t*)(a.ws + WS_ALT_WGU), (bf16_t*)(a.ws + WS_ALT_WDN), scr, hw, NHW, lane);
}
template <class Sched> __device__ __forceinline__ int build_rstd_table(LAS unsigned char* lds, const Sched& S, const float* ssq16, int tid) {
    int pm_lo = 1 << 30, pm_hi = -1; pg8::Unit u;
    for (int i = 0; S.next(i, u); ++i) { pm_lo = u.pm < pm_lo ? u.pm : pm_lo; pm_hi = u.pm > pm_hi ? u.pm : pm_hi; }
    const int rows = (pm_hi - pm_lo + 1) * 256;
    if (pm_hi < 0 || rows > 4096) return -1;
    LAS float* rl = (LAS float*)(lds + 131072);
    for (int r = tid; r < rows; r += 512) rl[r] = rstd_of(ssq16, pm_lo * 256 + r);
    __syncthreads();
    return pm_lo * 256;
}
__device__ __forceinline__ void zero_ssq(float* p) { int g = blockIdx.x * 512 + threadIdx.x; asm volatile("" : "+v"(g)); if (g < M_TOK) p[g] = 0.f; }

template <bool gdn> __device__ __forceinline__ void layer_body(const Args& a, const int layer, LAS unsigned char* lds, const XcdBarrier& gbar, unsigned long long& probe_acc) {
#define LB_IDS() int tid = threadIdx.x; asm volatile("" : "+v"(tid)); const int lane = tid & 63, wave = __builtin_amdgcn_readfirstlane(tid >> 6); \
        const int G = gridDim.x, blk = blockIdx.x, gw = blk * 8 + wave, NGW = G * 8; (void)lane; (void)gw; (void)NGW; (void)G; (void)blk;
#define LB_PTRS() bf16_t* Win_t = (bf16_t*)(a.ws + WS_WIN); bf16_t* Wout_t = (bf16_t*)(a.ws + (gdn ? WS_WOUT : WS_ALT_WOUT)); bf16_t* Wgu_t = (bf16_t*)(a.ws + (gdn ? WS_WGU : WS_ALT_WGU)); bf16_t* Wdn_t = (bf16_t*)(a.ws + (gdn ? WS_WDN : WS_ALT_WDN)); \
        float* gb = (float*)(a.ws + WS_GB); bf16_t* H = (bf16_t*)(a.ws + WS_H); bf16_t* PROJ = (bf16_t*)(a.ws + WS_PROJ); float* out = a.out; const float* xcur = (layer == 0) ? a.in[0] : a.out; \
        float* ssqA = (float*)(a.ws + WS_SSQ); float* ssqB = ssqA + (size_t)M_TOK * 16; \
        (void)Win_t; (void)Wout_t; (void)Wgu_t; (void)Wdn_t; (void)gb; (void)H; (void)PROJ; (void)out; (void)xcur; (void)ssqA; (void)ssqB;
        const int j = layer >> 1;
        { PH_T0(1)
        {
            LB_IDS(); LB_PTRS();
            pg8::Gemm g{H, Win_t, M_TOK, gdn ? GDN_NP : 3072, DM, DM}; pg8::StaticOrder S; S.init(M_TOK, g.N, G, blk);
            const int row_lo = build_rstd_table(lds, S, ssqA, tid);
            EpiProj E{PROJ, gdn ? GDN_PITCH : 3072, gdn ? 24 : -1, gb, a.in[3] + j * 16, a.in[4] + j * 16, gdn ? 0 : 4, 0.125f * 1.4426950408889634f, ssqA, row_lo >= 0 ? (const LAS float*)(lds + 131072) : nullptr, row_lo, gdn ? 16 : 0, gdn ? 24 : 0};
#if !defined(NO_GEMM) && !defined(NO_P2)
            pg8::gemm_phase<EpiProj, pg8::StaticOrder, true, true>(lds, g, S, E);
#endif
        }
        xcd_barrier(gbar);
        PH_T1(1) }
        if constexpr (gdn) {
            LB_IDS(); LB_PTRS();
            const float* convw = a.in[2] + (size_t)j * 4096 * 4;
            { PH_T0(2) gdn_g0(lds, PROJ, convw, blk, G, tid, wave, lane);
            xcd_barrier(gbar); PH_T1(2) }
            { PH_T0(3)
            if (G < 256) { conv_during_gdn_mixer(a, layer, (LAS float*)(lds + wave * 16384), gw, NGW, lane); __syncthreads(); }
            gdn_g1(lds, PROJ, gb, gb, convw, H, gw, NGW, wave, lane);
            xcd_barrier(gbar); PH_T1(3) }
            { PH_T0(4)
            if (G >= 256 && blk >= 128) conv_during_gdn_mixer(a, layer, (LAS float*)(lds + wave * 16384), (blk - 128) * 8 + wave, (G - 128) * 8, lane);
            gdn_g2(lds, PROJ, gb, convw, a.in[5] + j * 128, H, blk, G, tid, wave, lane);
            xcd_barrier(gbar); PH_T1(4) }
        } else {
            LB_IDS(); LB_PTRS();
            { PH_T0(5)
            sb_attn(lds, PROJ, blk, G, tid, wave, lane);
            xcd_barrier(gbar); PH_T1(5) }
        }
        { PH_T0(6)
        {
            LB_IDS(); LB_PTRS();
            pg8::Gemm g{gdn ? PROJ + 2048 : PROJ, Wout_t, M_TOK, DM, gdn ? 2048 : 1024, gdn ? GDN_PITCH : 3072}; pg8::StaticOrder S; S.init(M_TOK, DM, G, blk);
            EpiRes E{xcur, out, DM, H, ssqB};
#if !defined(NO_GEMM) && !defined(NO_P4)
            pg8::gemm_phase<EpiRes, pg8::StaticOrder, true, true>(lds, g, S, E);
#endif
        }
        xcd_barrier(gbar);
        PH_T1(6) }
        { PH_T0(7)
        {
            LB_IDS(); LB_PTRS();
            if (!gdn && layer < 3) { conv_mixer_weights<true>(a, layer + 1, (bf16_t*)(a.ws + WS_WIN), (bf16_t*)(a.ws + WS_WOUT), (LAS float*)(lds + wave * 16384), gw, NGW, lane); __syncthreads(); }
            pg8::Gemm g{H, Wgu_t, M_TOK, 2 * FF, DM, DM}; pg8::StaticOrder S; S.init(M_TOK, 2 * FF, G, blk);
            const int row_lo = build_rstd_table(lds, S, ssqB, tid);
            EpiSwiglu E{PROJ, FF, ssqB, row_lo >= 0 ? (const LAS float*)(lds + 131072) : nullptr, row_lo};
#if !defined(NO_GEMM) && !defined(NO_P6)
            pg8::gemm_phase<EpiSwiglu, pg8::StaticOrder, true, true>(lds, g, S, E);
#endif
        }
        xcd_barrier(gbar);
        PH_T1(7) }
        { PH_T0(8)
        {
            LB_IDS(); LB_PTRS();
            pg8::Gemm g{PROJ, Wdn_t, M_TOK, DM, FF, FF}; pg8::StaticOrder S; S.init(M_TOK, DM, G, blk);
            EpiRes E{out, out, DM, H, ssqA};
#if !defined(NO_GEMM) && !defined(NO_P7)
            pg8::gemm_phase<EpiRes, pg8::StaticOrder, true, true>(lds, g, S, E);
#endif
        }
        xcd_barrier(gbar);
        PH_T1(8) }
}

__global__ void __launch_bounds__(512, 2) fwd(Args a) {
    extern __shared__ __attribute__((aligned(16))) unsigned char lds_raw[];
    LAS unsigned char* lds = (LAS unsigned char*)lds_raw;
    cg::grid_group grid = cg::this_grid();
    unsigned long long probe_acc = 0;
    if (threadIdx.x < 2) ((LAS unsigned*)(lds + LDS_BARST))[threadIdx.x] = 0u;
    __syncthreads();
    const XcdBarrier gbar = xcd_barrier_post((unsigned*)a.ws, (volatile LAS unsigned*)(lds + LDS_BARST));
    { PH_T0(9)
    {
        int tid = threadIdx.x; asm volatile("" : "+v"(tid)); const int lane = tid & 63, wave = __builtin_amdgcn_readfirstlane(tid >> 6);
        const int gw = blockIdx.x * 8 + wave, NGW = gridDim.x * 8; LAS float* scr = (LAS float*)(lds + wave * 16384);
        conv_mixer_weights<true>(a, 0, (bf16_t*)(a.ws + WS_WIN), (bf16_t*)(a.ws + WS_WOUT), scr, gw, NGW, lane);
        xb_rows(a.in[0], (bf16_t*)(a.ws + WS_H), (float*)(a.ws + WS_SSQ), gw, NGW, lane);
    }
    xcd_barrier(gbar);
    if (a.ws == nullptr) grid.sync();
    PH_T1(9) }
#ifdef ONE_LAYER
    layer_body<false>(a, 1, lds, gbar, probe_acc);
#else
    for (int lp = 0; lp < 2; ++lp) {
        layer_body<true>(a, 2 * lp, lds, gbar, probe_acc);
        layer_body<false>(a, 2 * lp + 1, lds, gbar, probe_acc);
    }
#endif
    { PH_T0(10)
    { int tid = threadIdx.x; asm volatile("" : "+v"(tid)); const int lane = tid & 63, wave = __builtin_amdgcn_readfirstlane(tid >> 6); final_norm_rows(a.out, a.in[14], (const float*)(a.ws + WS_SSQ), blockIdx.x * 8 + wave, gridDim.x * 8, lane); }
    if (PROBE_ID == 10) { xcd_barrier(gbar); } PH_T1(10) }
    if (PROBE_ID != 0 && blockIdx.x == 0) { const unsigned long long t0 = __builtin_amdgcn_s_memrealtime(); while (__builtin_amdgcn_s_memrealtime() - t0 < 4ull * probe_acc) __builtin_amdgcn_s_sleep(8); }
}

extern "C" void kernel_launch(void* const* d_in, const int* in_sizes, int n_in, void* d_out, int out_size, void* d_ws, size_t ws_size, hipStream_t stream) {
    static int grid = 0;
    if (grid == 0) {
        if (n_in != 15 || out_size != M_TOK * DM || ws_size < WS_END) { fprintf(stderr, "kernel_launch: unexpected shapes (n_in %d out %d ws %zu)\n", n_in, out_size, ws_size); grid = -1; return; }
        int dev = 0, cus = 0, per_cu = 0;
        hipGetDevice(&dev); hipDeviceGetAttribute(&cus, hipDeviceAttributeMultiprocessorCount, dev);
        hipFuncSetAttribute((const void*)fwd, hipFuncAttributeMaxDynamicSharedMemorySize, LDS_BYTES);
        hipOccupancyMaxActiveBlocksPerMultiprocessor(&per_cu, (const void*)fwd, 512, LDS_BYTES);
        if (per_cu < 1) per_cu = 1;
        grid = cus * per_cu;
        (void)hipGetLastError();
    }
    if (grid < 0) return;
    Args a{};
    for (int i = 0; i < 15; ++i) a.in[i] = (const float*)d_in[i];
    a.out = (float*)d_out; a.ws = (unsigned char*)d_ws;
    (void)hipMemsetAsync(d_ws, 0, 16384, stream);
    void* args[] = {&a};
    hipError_t e = hipLaunchCooperativeKernel((const void*)fwd, dim3(grid), dim3(512), args, LDS_BYTES, stream);
    if (e != hipSuccess) fprintf(stderr, "cooperative launch failed: %s (grid %d)\n", hipGetErrorString(e), grid);
}
```
